# Optimizing an MI355X kernel written in HIP

```python
import jax, jax.numpy as jnp
from jax import lax
import numpy as np

D_MODEL = 1024
BATCH = 32
SEQ = 2048
DEPTH = 2

CTX_LEN = 256
GRID_W = 64
EPS = 1e-6
D_HGRN = 512
HGRN_HEADS = 4
HGRN_DK = D_HGRN // HGRN_HEADS
HGRN_DV = D_HGRN // HGRN_HEADS
HGRN_SCALE = HGRN_DK ** -0.5
CHUNK = 64
D_POOL = 512
POOL_WINDOWS = (2, 4, 8, 16)
POOL_GROUP = D_POOL // len(POOL_WINDOWS)
IN_COLS = 5 * D_HGRN + D_POOL + 2 * D_MODEL
SPLIT_IDX = (D_HGRN, 2 * D_HGRN, 3 * D_HGRN, 4 * D_HGRN, 5 * D_HGRN, 5 * D_HGRN + D_POOL, 5 * D_HGRN + D_POOL + D_MODEL)
D_FF = 2816
N_EXPERTS = 8
TOP_K = 2
D_EXPERT = 3584
N_DENSE = (DEPTH + 1) // 2
N_MOE = DEPTH // 2

kernel_name = "hybrid_hgrn2_pool_moe_diffusion_trunk"


def rms_norm(x, gain):
    xf = x.astype(jnp.float32)
    y = xf * lax.rsqrt(jnp.mean(xf * xf, axis=-1, keepdims=True) + EPS)
    return (y * gain.astype(jnp.float32)).astype(x.dtype)


def head_rms_norm(o, gain):
    b, n, _ = o.shape
    oh = o.reshape(b, n, HGRN_HEADS, HGRN_DV).astype(jnp.float32)
    oh = oh * lax.rsqrt(jnp.mean(oh * oh, axis=-1, keepdims=True) + EPS)
    return oh.reshape(b, n, D_HGRN) * gain.astype(jnp.float32)


def to_heads(a):
    b, n, _ = a.shape
    return a.reshape(b, n, HGRN_HEADS, -1).transpose(0, 2, 1, 3)


def from_heads(a):
    b, h, n, d = a.shape
    return a.transpose(0, 2, 1, 3).reshape(b, n, h * d)


def flip_seq(a):
    return jnp.flip(a, axis=2)


def forget_gate(z, lb):
    zf = z.astype(jnp.float32)
    lbf = lb.astype(jnp.float32)
    log_f = jnp.logaddexp(jnp.log(lbf), jnp.log1p(-lbf) + jax.nn.log_sigmoid(zf))
    k = (1.0 - lbf) * jax.nn.sigmoid(-zf)
    return log_f, k


def recurrence_inputs(f_fwd, f_bwd, i, lb):
    lf_f, k_f = forget_gate(f_fwd, lb[0])
    lf_b, k_b = forget_gate(f_bwd, lb[1])
    return to_heads(k_f), to_heads(lf_f), to_heads(k_b), to_heads(lf_b), to_heads(i)


def gla_scan(q, k, v, log_f, s0):
    b, h, n, dk = q.shape
    nc = n // CHUNK

    def to_chunks(a):
        return jnp.moveaxis(a.reshape(b, h, nc, CHUNK, a.shape[-1]), 2, 0)

    causal = jnp.tril(jnp.ones((CHUNK, CHUNK), dtype=bool))[:, :, None]

    def step(s, inp):
        qc, kc, vc, gc = inp
        cum = jnp.cumsum(gc.astype(jnp.float32), axis=2)
        o_inter = jnp.einsum('bhtk,bhkv->bhtv', qc * jnp.exp(cum), s)
        diff = cum[:, :, :, None, :] - cum[:, :, None, :, :]
        decay = jnp.exp(jnp.where(causal, diff, -jnp.inf))
        att = jnp.einsum('bhtk,bhsk,bhtsk->bhts', qc, kc, decay)
        o = o_inter + jnp.einsum('bhts,bhsv->bhtv', att, vc)
        last = cum[:, :, -1:, :]
        s_new = jnp.exp(last[:, :, 0, :])[..., None] * s + jnp.einsum('bhsk,bhsv->bhkv', kc * jnp.exp(last - cum), vc)
        return s_new, o

    s_fin, o = lax.scan(step, s0, (to_chunks(q), to_chunks(k), to_chunks(v), to_chunks(log_f)))
    o = jnp.moveaxis(o, 0, 2).reshape(b, h, n, v.shape[-1])
    return o, s_fin


def final_state(k, v, log_f):
    cum = jnp.cumsum(log_f.astype(jnp.float32), axis=2)
    w = jnp.exp(cum[:, :, -1:, :] - cum)
    return jnp.einsum('bhnk,bhnv->bhkv', k * w, v)


def box_mean(x, w, axis):
    length = x.shape[axis]
    cs = jnp.cumsum(x.astype(jnp.float32), axis=axis)
    zero = jnp.zeros_like(lax.slice_in_dim(cs, 0, 1, axis=axis))
    cs = jnp.concatenate([zero, cs], axis=axis)
    pos = jnp.arange(length)
    lo = jnp.clip(pos - w // 2, 0, length)
    hi = jnp.clip(pos - w // 2 + w, 0, length)
    s = jnp.take(cs, hi, axis=axis) - jnp.take(cs, lo, axis=axis)
    cnt = (hi - lo).astype(jnp.float32).reshape((length,) + (1,) * (x.ndim - axis - 1))
    return (s / cnt).astype(x.dtype)


def pool_branch(u, pool_w, pool_scale, on_grid):
    b, n, _ = u.shape
    if on_grid:
        rows = n // GRID_W
        u = u.reshape(b, rows, GRID_W, D_POOL)
    outs = []
    for gi, w in enumerate(POOL_WINDOWS):
        ug = u[..., gi * POOL_GROUP:(gi + 1) * POOL_GROUP]
        m = box_mean(ug, w, 1)
        if on_grid:
            m = box_mean(m, w, 2)
        outs.append(jnp.einsum('...c,ce->...e', m - ug, pool_w[gi]))
    y = jnp.concatenate(outs, axis=-1) * pool_scale
    return y.reshape(b, n, D_POOL)


def token_mixer(h, w_in, lb, o_gain, pool_w, pool_scale, w_br_rec, w_br_pool, w_out, s0_f, s0_b, on_grid):
    p = jnp.einsum('bnd,de->bne', h, w_in)
    q, f_fwd, f_bwd, i, g, u, ga, gb = jnp.split(p, SPLIT_IDX, axis=-1)
    k_f, lf_f, k_b, lf_b, v = recurrence_inputs(f_fwd, f_bwd, i, lb)
    qh = to_heads(jax.nn.silu(q)) * HGRN_SCALE
    o_f, s_f = gla_scan(qh, k_f, v, lf_f, s0_f)
    o_b, s_b = gla_scan(flip_seq(qh), flip_seq(k_b), flip_seq(v), flip_seq(lf_b), s0_b)
    o = from_heads(o_f + flip_seq(o_b))
    y_rec = (head_rms_norm(o, o_gain) * jax.nn.silu(g.astype(jnp.float32))).astype(h.dtype)
    y_pool = pool_branch(u, pool_w, pool_scale, on_grid)
    merged = (jax.nn.sigmoid(ga) * jnp.einsum('bnc,cd->bnd', y_rec, w_br_rec)
              + jax.nn.sigmoid(gb) * jnp.einsum('bnc,cd->bnd', y_pool, w_br_pool))
    return jnp.einsum('bnd,de->bne', merged, w_out), s_f, s_b


def context_states(h, w_in, lb):
    p = jnp.einsum('bnd,de->bne', h, w_in[:, D_HGRN:4 * D_HGRN])
    f_fwd, f_bwd, i = jnp.split(p, 3, axis=-1)
    k_f, lf_f, k_b, lf_b, v = recurrence_inputs(f_fwd, f_bwd, i, lb)
    s_f = final_state(k_f, v, lf_f)
    s_b = final_state(flip_seq(k_b), flip_seq(v), flip_seq(lf_b))
    return s_f, s_b


def swiglu(h, wg, wu, wd):
    return jnp.einsum('bnf,fd->bnd', jax.nn.silu(jnp.einsum('bnd,df->bnf', h, wg)) * jnp.einsum('bnd,df->bnf', h, wu), wd)


def moe_swiglu(h, router, wg, wu, wd):
    logits = jnp.einsum('bnd,de->bne', h, router).astype(jnp.float32)
    top_v, top_i = lax.top_k(logits, TOP_K)
    probs = jax.nn.softmax(top_v, axis=-1)
    gates = jnp.sum(jax.nn.one_hot(top_i, N_EXPERTS, dtype=jnp.float32) * probs[..., None], axis=-2).astype(h.dtype)
    y = jnp.zeros_like(h)
    for e in range(N_EXPERTS):
        y = y + gates[..., e:e + 1] * swiglu(h, wg[e], wu[e], wd[e])
    return y


def channel_mixer(h, l, ffn_w_gate, ffn_w_up, ffn_w_down, moe_router, moe_w_gate, moe_w_up, moe_w_down):
    if l % 2 == 0:
        j = l // 2
        return swiglu(h, ffn_w_gate[j], ffn_w_up[j], ffn_w_down[j])
    j = l // 2
    return moe_swiglu(h, moe_router[j], moe_w_gate[j], moe_w_up[j], moe_w_down[j])


def setup_inputs(seed: int = 0) -> dict:
    key = jax.random.key(seed)
    ks = jax.random.split(key, 32)
    f32 = jnp.float32

    def nrm(k, shape, scale):
        return jax.random.normal(k, shape, f32) * scale

    def gain(k, shape):
        return 1.0 + 0.05 * jax.random.normal(k, shape, f32)

    D = D_MODEL
    return {
        "x": nrm(ks[0], (BATCH, SEQ, D), 1.0),
        "c": nrm(ks[1], (BATCH, D), 1.0),
        "ctx": nrm(ks[2], (BATCH, CTX_LEN, D), 1.0),
        "c_ctx": nrm(ks[3], (D,), 1.0),
        "ada_w": nrm(ks[4], (DEPTH, D, 6 * D), D ** -0.5),
        "ada_b": nrm(ks[5], (DEPTH, 6 * D), 0.02),
        "mix_pre": gain(ks[6], (DEPTH, D)),
        "mix_post": gain(ks[7], (DEPTH, D)),
        "ffn_pre": gain(ks[8], (DEPTH, D)),
        "ffn_post": gain(ks[9], (DEPTH, D)),
        "w_in": nrm(ks[10], (DEPTH, D, IN_COLS), D ** -0.5),
        "hgrn_lb": nrm(ks[11], (DEPTH, 2, D_HGRN), 0.5),
        "hgrn_gain": gain(ks[12], (DEPTH, D_HGRN)),
        "pool_w": nrm(ks[13], (DEPTH, len(POOL_WINDOWS), POOL_GROUP, POOL_GROUP), POOL_GROUP ** -0.5),
        "pool_scale": gain(ks[14], (DEPTH, D_POOL)),
        "w_branch_rec": nrm(ks[15], (DEPTH, D_HGRN, D), D_HGRN ** -0.5),
        "w_branch_pool": nrm(ks[16], (DEPTH, D_POOL, D), D_POOL ** -0.5),
        "w_out": nrm(ks[17], (DEPTH, D, D), D ** -0.5),
        "ffn_w_gate": nrm(ks[18], (N_DENSE, D, D_FF), D ** -0.5),
        "ffn_w_up": nrm(ks[19], (N_DENSE, D, D_FF), D ** -0.5),
        "ffn_w_down": nrm(ks[20], (N_DENSE, D_FF, D), D_FF ** -0.5),
        "moe_router": nrm(ks[21], (N_MOE, D, N_EXPERTS), D ** -0.5),
        "moe_w_gate": nrm(ks[22], (N_MOE, N_EXPERTS, D, D_EXPERT), D ** -0.5),
        "moe_w_up": nrm(ks[23], (N_MOE, N_EXPERTS, D, D_EXPERT), D ** -0.5),
        "moe_w_down": nrm(ks[24], (N_MOE, N_EXPERTS, D_EXPERT, D), D_EXPERT ** -0.5),
    }


def reference(x, c, ctx, c_ctx, ada_w, ada_b, mix_pre, mix_post, ffn_pre, ffn_post, w_in, hgrn_lb, hgrn_gain,
              pool_w, pool_scale, w_branch_rec, w_branch_pool, w_out, ffn_w_gate, ffn_w_up, ffn_w_down,
              moe_router, moe_w_gate, moe_w_up, moe_w_down):
    lb_all = jnp.cumsum(jax.nn.softmax(hgrn_lb.astype(jnp.float32), axis=0), axis=0)
    lb_all = lb_all - lb_all[0:1]
    cx = ctx
    b = x.shape[0]
    for l in range(DEPTH):
        last = l == DEPTH - 1
        mod_x = (jnp.einsum('bd,de->be', jax.nn.silu(c), ada_w[l]) + ada_b[l])[:, None, :]
        sh1, sc1, g1, sh2, sc2, g2 = jnp.split(mod_x, 6, axis=-1)
        mod_c = jnp.einsum('d,de->e', jax.nn.silu(c_ctx), ada_w[l]) + ada_b[l]
        csh1, csc1, cg1, csh2, csc2, cg2 = jnp.split(mod_c, 6, axis=-1)
        mix_params = (w_in[l], lb_all[l], hgrn_gain[l], pool_w[l], pool_scale[l],
                      w_branch_rec[l], w_branch_pool[l], w_out[l])
        ffn_params = (ffn_w_gate, ffn_w_up, ffn_w_down, moe_router, moe_w_gate, moe_w_up, moe_w_down)

        hc = rms_norm(cx, mix_pre[l]) * (1.0 + csc1) + csh1
        if last:
            s_f, s_b = context_states(hc, w_in[l], lb_all[l])
        else:
            s0 = jnp.zeros((b, HGRN_HEADS, HGRN_DK, HGRN_DV), jnp.float32)
            yc, s_f, s_b = token_mixer(hc, *mix_params, s0, s0, False)
            cx = cx + cg1 * rms_norm(yc, mix_post[l])
        hx = rms_norm(x, mix_pre[l]) * (1.0 + sc1) + sh1
        yx, _, _ = token_mixer(hx, *mix_params, s_f, s_b, True)
        x = x + g1 * rms_norm(yx, mix_post[l])

        hx2 = rms_norm(x, ffn_pre[l]) * (1.0 + sc2) + sh2
        x = x + g2 * rms_norm(channel_mixer(hx2, l, *ffn_params), ffn_post[l])
        if not last:
            hc2 = rms_norm(cx, ffn_pre[l]) * (1.0 + csc2) + csh2
            cx = cx + cg2 * rms_norm(channel_mixer(hc2, l, *ffn_params), ffn_post[l])
    return x
```

```cpp
#include <hip/hip_runtime.h>
#include <cstdio>
#include <cstdint>

#ifndef MK_PER_PHASE
#define MK_PER_PHASE 0
#endif

#ifndef DUP_MASK
#define DUP_MASK 0
#endif
#define REP(k) for (int rep_ = 0; rep_ < 1 + (((DUP_MASK) >> (k)) & 1); ++rep_)
#define GAS __attribute__((address_space(1)))
#define LAS __attribute__((address_space(3)))
#define DI __device__ __forceinline__
typedef unsigned short bf16;
typedef unsigned v4u __attribute__((ext_vector_type(4)));
typedef unsigned v2u __attribute__((ext_vector_type(2)));
typedef float f32x4 __attribute__((ext_vector_type(4)));
typedef float f32x2 __attribute__((ext_vector_type(2)));
typedef float f32x16 __attribute__((ext_vector_type(16)));
typedef short bf16x8 __attribute__((ext_vector_type(8)));
typedef int i32x2 __attribute__((ext_vector_type(2)));

constexpr int D = 1024, BATCH = 32, SEQ = 2048, CTX = 256, GW = 64;
constexpr int NX = BATCH * SEQ, NC = BATCH * CTX, MALL = NX + NC;
constexpr int DH = 512, DK = 128, INC = 5120, DFF = 2816, NE = 8, DEX = 3584;
constexpr int C_Q = 0, C_FF = 512, C_FB = 1024, C_V = 1536, C_G = 2048, C_U = 2560, C_GA = 3072, C_GB = 4096;
constexpr float EPS = 1e-6f;
constexpr int NSLICE = 3, SL1 = 21848, SL2 = 43696, NGRP = NSLICE * NE;
constexpr int SLICE_ROWS = 45824;
DI int slice_of(int r) { return (r >= SL1 ? 1 : 0) + (r >= SL2 ? 1 : 0); }
DI int slice_start(int s) { return s == 0 ? 0 : s == 1 ? SL1 : s == 2 ? SL2 : NX; }
constexpr int NWAVES = 8, NTHR = 512;

constexpr size_t MiB = 1u << 20;
constexpr size_t al256(size_t x) { return (x + 255) & ~(size_t)255; }
constexpr size_t WS_CTL = 0, CTL_BYTES = 1 * MiB;
constexpr size_t WS_MOD = WS_CTL + CTL_BYTES;
constexpr size_t WS_LB = WS_MOD + al256((size_t)2 * 33 * 6144 * 4);
constexpr size_t WS_WIN = WS_LB + al256(2 * 2 * 512 * 4);
constexpr size_t WS_WR = WS_WIN + (size_t)2 * INC * D * 2;
constexpr size_t WS_WP = WS_WR + (size_t)2 * D * DH * 2;
constexpr size_t WS_WO = WS_WP + (size_t)2 * D * DH * 2;
constexpr size_t WS_WGU = WS_WO + (size_t)2 * D * D * 2;
constexpr size_t WS_WD = WS_WGU + (size_t)2 * DFF * D * 2;
constexpr size_t WS_H = WS_WD + (size_t)D * DFF * 2;
constexpr size_t WS_CX = WS_H + (size_t)MALL * D * 2;
constexpr size_t WS_RTOP = WS_CX + (size_t)NC * D * 2;
constexpr size_t WS_RPROB = WS_RTOP + (size_t)NX * 8;
constexpr size_t WS_RRANK = WS_RPROB + (size_t)NX * 8;
constexpr size_t WS_RPOS = WS_RRANK + (size_t)NX * 8;
constexpr size_t WS_RGATE = WS_RPOS + (size_t)NX * 8;
constexpr size_t WS_P = WS_RGATE + al256((size_t)SLICE_ROWS * 4);
constexpr size_t P_BYTES = (size_t)MALL * INC * 2;
constexpr size_t WS_MGU = WS_P + P_BYTES;
constexpr size_t WS_MD = WS_MGU + (size_t)NE * 2 * DEX * D;
constexpr size_t WS_END = WS_MD + (size_t)NE * D * DEX;
constexpr size_t WS_HH0 = WS_P;
constexpr size_t WS_H8 = WS_P;
constexpr size_t WS_AS = WS_H8 + (size_t)NX * D;
constexpr size_t WS_YS = WS_AS + (size_t)SLICE_ROWS * D;
constexpr size_t WS_HHS = WS_YS + (size_t)SLICE_ROWS * D * 2;
static_assert(WS_HHS + (size_t)SLICE_ROWS * DEX <= WS_P + P_BYTES, "moe overlay");
static_assert((size_t)MALL * DFF * 2 <= P_BYTES, "ffn overlay");
constexpr int CW_BAR = 0;
constexpr int CW_GCOUNT = 4096;
constexpr int CW_CMAX_FG = 18432, CW_CMAX_FU = 21248;
constexpr int CW_CMAX_IN = 8192;
constexpr size_t WS_RS = WS_CTL + 524288;
constexpr int LDS_BYTES = 159744, MISC_OFF = 158720;

typedef __bf16 bf16x2_t __attribute__((ext_vector_type(2)));
DI unsigned pk2(float lo, float hi) { bf16x2_t v = {(__bf16)lo, (__bf16)hi}; return __builtin_bit_cast(unsigned, v); }
DI float bflo(unsigned w) { return __uint_as_float(w << 16); }
DI float bfhi(unsigned w) { return __uint_as_float(w & 0xffff0000u); }
DI float wave_sum(float v) {
#pragma unroll
    for (int o = 1; o < 64; o <<= 1) v += __shfl_xor(v, o);
    return v;
}
DI float sat8(float x) { return __builtin_amdgcn_fmed3f(x, -448.f, 448.f); }
DI unsigned pk4_fp8(float a, float b, float c, float d) { int p = __builtin_amdgcn_cvt_pk_fp8_f32(sat8(a), sat8(b), 0, false); p = __builtin_amdgcn_cvt_pk_fp8_f32(sat8(c), sat8(d), p, true); return (unsigned)p; }
DI float wave_max(float v) {
#pragma unroll
    for (int o = 1; o < 64; o <<= 1) v = fmaxf(v, __shfl_xor(v, o));
    return v;
}
DI unsigned pk4_i8(float a, float b, float c, float d) {
    const int qa = (int)rintf(a), qb = (int)rintf(b), qc = (int)rintf(c), qd = (int)rintf(d);
    return (unsigned)(qa & 0xff) | ((unsigned)(qb & 0xff) << 8) | ((unsigned)(qc & 0xff) << 16) | ((unsigned)qd << 24);
}
DI float sigmoidf_(float a) { return __builtin_amdgcn_rcpf(1.0f + __builtin_amdgcn_exp2f(a * -1.4426950408889634f)); }
DI float siluf_(float a) { return a * sigmoidf_(a); }
#define LDS_WAIT() asm volatile("s_waitcnt lgkmcnt(0)" ::: "memory")
#define VM_WAIT() asm volatile("s_waitcnt vmcnt(0)" ::: "memory")

#define XB_TMO      128
#define XB_XCNT(j)  (256  + 64 * (j))
#define XB_XSUB(j)  (1280 + 64 * (j))
#define XB_XGEN(j)  (2304 + 64 * (j))
#define XB_TOP      3328
#define XB_TOPGEN   3392
#define XCD_BAR_WORDS 3456
#define XB_SPIN_CAP (1u << 20)

__device__ __forceinline__ unsigned xb_ld(unsigned* p)              { return __hip_atomic_load(p, __ATOMIC_RELAXED, __HIP_MEMORY_SCOPE_AGENT); }
__device__ __forceinline__ unsigned xb_add(unsigned* p, unsigned v) { return __hip_atomic_fetch_add(p, v, __ATOMIC_RELAXED, __HIP_MEMORY_SCOPE_AGENT); }
__device__ __forceinline__ unsigned xb_xcc_id() { return (unsigned)__builtin_amdgcn_s_getreg((3 << 11) | 20) & 0xFu; }
#define XB_SPIN(cond, bar) do { unsigned _sp = 0; while (cond) { __builtin_amdgcn_s_sleep(1); \
    if ((++_sp & 255u) == 0u) { if (xb_ld(&(bar)[XB_TMO])) break; if (_sp > XB_SPIN_CAP) { atomicAdd(&(bar)[XB_TMO], 1u); break; } } } } while (0)

struct XcdBarrier { unsigned* bar; unsigned x; volatile LAS unsigned* st; };

__device__ __forceinline__ XcdBarrier xcd_barrier_post(unsigned* bar, volatile LAS unsigned* st) {
    XcdBarrier b; b.bar = bar; b.x = xb_xcc_id(); b.st = st;
    if (threadIdx.x == 0) (void)xb_add(&bar[XB_XCNT(b.x)], 1u);
    return b;
}
__device__ __forceinline__ void xcd_barrier_complete(unsigned* bar, unsigned x, unsigned& nloc, unsigned& nx) {
    const unsigned G = gridDim.x * gridDim.y * gridDim.z;
    unsigned sum, cnt, mine, sp = 0u;
    for (;;) {
        sum = 0u; cnt = 0u; mine = 0u;
#pragma unroll
        for (unsigned j = 0; j < 16; ++j) { const unsigned c = xb_ld(&bar[XB_XCNT(j)]); sum += c; cnt += (c > 0u) ? 1u : 0u; mine = (j == x) ? c : mine; }
        if (sum == G) break;
        __builtin_amdgcn_s_sleep(1);
        if ((++sp & 255u) == 0u) { if (xb_ld(&bar[XB_TMO])) break; if (sp > XB_SPIN_CAP) { atomicAdd(&bar[XB_TMO], 1u); break; } }
    }
    nloc = mine > 0u ? mine : 1u; nx = cnt > 0u ? cnt : 1u;
}
__device__ __forceinline__ void xcd_barrier(const XcdBarrier& b) {
    asm volatile("s_waitcnt vmcnt(0)" ::: "memory");
    __syncthreads();
    if (threadIdx.x == 0) {
        unsigned* bar = b.bar;
        __builtin_amdgcn_s_waitcnt(0);
        unsigned nloc = b.st[0], nx = b.st[1];
        if (nloc == 0u) { xcd_barrier_complete(bar, b.x, nloc, nx); b.st[0] = nloc; b.st[1] = nx; }
        const unsigned old = xb_add(&bar[XB_XSUB(b.x)], 1u);
        const unsigned gen = old / nloc;
        if (old + 1u == (gen + 1u) * nloc) {
            __builtin_amdgcn_fence(__ATOMIC_RELEASE, "agent");
            asm volatile("s_waitcnt vmcnt(0)" ::: "memory");
            const unsigned og = xb_add(&bar[XB_TOP], 1u);
            const unsigned tg = og / nx;
            if (og + 1u == (tg + 1u) * nx) xb_add(&bar[XB_TOPGEN], 1u);
            else XB_SPIN(xb_ld(&bar[XB_TOPGEN]) == tg, bar);
            __builtin_amdgcn_fence(__ATOMIC_ACQUIRE, "agent");
            xb_add(&bar[XB_XGEN(b.x)], 1u);
            asm volatile("s_waitcnt vmcnt(0)" ::: "memory");
        } else {
            XB_SPIN(xb_ld(&bar[XB_XGEN(b.x)]) == gen, bar);
            __builtin_amdgcn_fence(__ATOMIC_ACQUIRE, "agent");
            asm volatile("s_waitcnt vmcnt(0)" ::: "memory");
        }
    }
    __syncthreads();
}

namespace pg8 {
constexpr int BM = 256, BK = 64, HALF = 128, HTB = HALF * BK * 2, STAGE_BYTES = 8 * HTB, NXCD = 8, WGM = 4;
__host__ __device__ __forceinline__ int lds_byte(int r, int c) { const int st = (r >> 4) * 2 + (c >> 5), rr = r & 15, cc = c & 31, ob = rr * 64 + cc * 2; return st * 1024 + (ob ^ (((ob >> 9) & 1) << 5)); }
__host__ __device__ __forceinline__ void stage_rc(int b, int& R, int& C) { const int st = b / 1024, sb = b % 1024, swz = sb ^ (((sb >> 9) & 1) << 5); R = (st >> 1) * 16 + swz / 64; C = (st & 1) * 32 + (swz % 64) / 2; }
__host__ __device__ __forceinline__ int perm32(int rho) { const int n = rho >> 4, i = rho & 15; return 8 * (i >> 2) + 4 * n + (i & 3); }

struct Unit { int arow, brow, pn, aux; };
struct Gemm { const GAS bf16* A; const GAS bf16* Bt; int lda, ldb, K; };
typedef int v8i __attribute__((ext_vector_type(8))); typedef int v4i __attribute__((ext_vector_type(4)));
DI v8i cat16(bf16x8 a, bf16x8 b) { const v4i x = __builtin_bit_cast(v4i, a), y = __builtin_bit_cast(v4i, b); return __builtin_shufflevector(x, y, 0, 1, 2, 3, 4, 5, 6, 7); }

DI void tile_order(int L, int nM, int nN, int& pm, int& pn) {
    const int nwg = nM * nN;
    int wgid = L; { const int q = nwg / NXCD, r = nwg % NXCD, xcd = wgid % NXCD, off = wgid / NXCD; wgid = (xcd < r ? xcd * (q + 1) : r * (q + 1) + (xcd - r) * q) + off; }
    const int nig = WGM * nN, gid = wgid / nig, fm = gid * WGM, gsz = (nM - fm) < WGM ? (nM - fm) : WGM;
    pm = fm + ((wgid % nig) % gsz); pn = (wgid % nig) / gsz;
}
struct StaticSched {
    int nM, nN, G, c, arow0;
    DI void init(int nM_, int nN_, int G_, int c_, int arow0_) { nM = nM_; nN = nN_; G = G_; c = c_; arow0 = arow0_; }
    DI bool next(int i, Unit& u) const {
        const long L = (long)i * G + c; if (L >= (long)nM * nN) return false;
        int pm, pn; tile_order((int)L, nM, nN, pm, pn);
        u.arow = arow0 + pm * BM; u.brow = pn * BM; u.pn = pn; u.aux = 0; return true;
    }
};
struct InSched {
    int G, c; bool last;
    DI bool next(int i, Unit& u) const {
        const int L = i * G + c; int pm, pn;
        if (!last) { if (L >= (MALL / 256) * (INC / 256)) return false; tile_order(L, MALL / 256, INC / 256, pm, pn); }
        else if (L < (NX / 256) * (INC / 256)) tile_order(L, NX / 256, INC / 256, pm, pn);
        else { const int L2 = L - (NX / 256) * (INC / 256); if (L2 >= (NC / 256) * 6) return false; pm = NX / 256 + L2 % (NC / 256); pn = 2 + L2 / (NC / 256); }
        u.arow = pm * BM; u.brow = pn * BM; u.pn = pn; u.aux = 0; return true;
    }
};
struct MoeSched {
    int nM, nN, G, c, nrow_e; int toff[9];
    DI bool next(int i, Unit& u) const {
        const long L = (long)i * G + c; if (L >= (long)nM * nN) return false;
        int pm, pn; tile_order((int)L, nM, nN, pm, pn);
        int e = 0;
#pragma unroll
        for (int j = 1; j < 8; ++j) e += (pm >= toff[j]) ? 1 : 0;
        u.arow = pm * BM; u.brow = e * nrow_e + pn * BM; u.pn = pn; u.aux = e; return true;
    }
};

template <class Epi, class Sched, bool FP8 = false, int WSC = 127, bool I8 = false>
DI void gemm_phase(LAS unsigned char* lds, const Gemm g, const Sched& S, const Epi& E) {
    int tid = threadIdx.x; asm volatile("" : "+v"(tid));
    const int wid = __builtin_amdgcn_readfirstlane(tid >> 6), lane = tid & 63, wr = wid >> 2, wc = wid & 3, fr = lane & 15, fq = lane >> 4;
    const int K = g.K, nt = K / BK;
    unsigned voffA[2], voffB[2];
#pragma unroll
    for (int i = 0; i < 2; ++i) { int R, C; stage_rc(tid * 16 + i * 8192, R, C); const int Rb = Epi::PERM ? ((R & ~31) + perm32(R & 31)) : R;
        voffA[i] = (unsigned)(R * g.lda + C) * 2u; voffB[i] = (unsigned)(Rb * g.ldb + C) * 2u; }
    const size_t kstep = (size_t)(BK * 2);
    const size_t hstepA = (size_t)HALF * g.lda * 2, hstepB = (size_t)HALF * g.ldb * 2;
    const size_t rowA = (size_t)g.lda * 2, rowB = (size_t)g.ldb * 2;
    const unsigned ldsw = (unsigned)wid * 1024u;
    const int aoff = lds_byte(wr * 64 + fr, fq * 8), boff = lds_byte(wc * 32 + fr, fq * 8);
#define PG8_SA(b, h) (((b) * 2 + (h)) * HTB)
#define PG8_SB(b, h) ((4 + (b) * 2 + (h)) * HTB)
#define PG8_STAGE(bufoff, gbase, voff) do { _Pragma("unroll") for (int _i = 0; _i < 2; ++_i) \
        __builtin_amdgcn_global_load_lds((const GAS unsigned*)((const GAS char*)(gbase) + (voff)[_i]), (LAS unsigned*)(lds + (bufoff) + ldsw + _i * 8192), 16, 0, 0); } while (0)
#define PG8_LDA(dst, b, h) do { _Pragma("unroll") for (int m = 0; m < 4; ++m) { if constexpr (FP8) dst##8[m] = cat16(*(const LAS bf16x8*)(lds + PG8_SA(b, h) + aoff + m * 2048), *(const LAS bf16x8*)(lds + PG8_SA(b, h) + aoff + m * 2048 + 1024)); \
        else { _Pragma("unroll") for (int k = 0; k < 2; ++k) dst[m][k] = *(const LAS bf16x8*)(lds + PG8_SA(b, h) + aoff + m * 2048 + k * 1024); } } } while (0)
#define PG8_LDB(dst, b, h) do { _Pragma("unroll") for (int n = 0; n < 2; ++n) { if constexpr (FP8) dst##8[n] = cat16(*(const LAS bf16x8*)(lds + PG8_SB(b, h) + boff + n * 2048), *(const LAS bf16x8*)(lds + PG8_SB(b, h) + boff + n * 2048 + 1024)); \
        else { _Pragma("unroll") for (int k = 0; k < 2; ++k) dst[n][k] = *(const LAS bf16x8*)(lds + PG8_SB(b, h) + boff + n * 2048 + k * 1024); } } } while (0)
#define PG8_MMA(ai, bj, At, Bt) do { __builtin_amdgcn_s_setprio(1); _Pragma("unroll") for (int m = 0; m < 4; ++m) _Pragma("unroll") for (int n = 0; n < 2; ++n) { \
        if constexpr (FP8) asm volatile("v_mfma_scale_f32_16x16x128_f8f6f4 %0, %1, %2, %0, %3, %4 op_sel_hi:[0,0,0]" : "+v"(acc[ai][bj][m][n]) : "v"(Bt##8[n]), "v"(At##8[m]), "v"(sc_w), "v"(sc_a)); \
        else if constexpr (I8) { _Pragma("unroll") for (int k = 0; k < 2; ++k) acc[ai][bj][m][n] = __builtin_bit_cast(f32x4, __builtin_amdgcn_mfma_i32_16x16x64_i8(__builtin_bit_cast(v4i, Bt[n][k]), __builtin_bit_cast(v4i, At[m][k]), __builtin_bit_cast(v4i, acc[ai][bj][m][n]), 0, 0, 0)); } \
        else { _Pragma("unroll") for (int k = 0; k < 2; ++k) acc[ai][bj][m][n] = __builtin_amdgcn_mfma_f32_16x16x32_bf16(Bt[n][k], At[m][k], acc[ai][bj][m][n], 0, 0, 0); } } \
        __builtin_amdgcn_s_setprio(0); } while (0)
#define PG8_WAIT_V(n) asm volatile("s_waitcnt vmcnt(" #n ")" ::: "memory")
#define PG8_WAIT_L(n) asm volatile("s_waitcnt lgkmcnt(" #n ")" ::: "memory")
#define PG8_BAR __builtin_amdgcn_s_barrier()
#define PG8_SCHED __builtin_amdgcn_sched_barrier(0)
    Unit cur, nxt; int ui = 0;
    if (!S.next(0, cur)) return;
    f32x4 acc[2][2][4][2];
#pragma unroll
    for (int a = 0; a < 2; ++a)
#pragma unroll
        for (int b = 0; b < 2; ++b)
#pragma unroll
            for (int m = 0; m < 4; ++m)
#pragma unroll
                for (int n = 0; n < 2; ++n) acc[a][b][m][n] = (f32x4){0.f, 0.f, 0.f, 0.f};
    const int sc_w = WSC * 0x01010101, sc_a = 0x7f7f7f7f;
    bf16x8 At[4][2], B0[2][2], B1[2][2]; v8i At8[4], B08[2], B18[2];
    const GAS char* cA = (const GAS char*)g.A + (size_t)cur.arow * rowA; const GAS char* cB = (const GAS char*)g.Bt + (size_t)cur.brow * rowB;
    PG8_STAGE(PG8_SB(0, 0), cB, voffB); PG8_STAGE(PG8_SB(0, 1), cB + hstepB, voffB); PG8_STAGE(PG8_SA(0, 0), cA, voffA); PG8_STAGE(PG8_SA(0, 1), cA + hstepA, voffA);
    if (wr == 1) PG8_BAR;
    PG8_WAIT_V(2); PG8_BAR;
    PG8_STAGE(PG8_SB(1, 0), cB + kstep, voffB); PG8_STAGE(PG8_SA(1, 0), cA + kstep, voffA); PG8_STAGE(PG8_SB(1, 1), cB + hstepB + kstep, voffB);
    PG8_WAIT_V(6); PG8_BAR;
    for (;;) {
        const bool has_next = S.next(ui + 1, nxt);
        const GAS char* nA = has_next ? (const GAS char*)g.A + (size_t)nxt.arow * rowA : cA; const GAS char* nB = has_next ? (const GAS char*)g.Bt + (size_t)nxt.brow * rowB : cB;
        for (int t = 0; t < nt; t += 2) {
            const bool last = (t == nt - 2);
            const GAS char* a1 = cA + (size_t)(t + 1) * kstep;
            const GAS char* a2 = last ? nA : cA + (size_t)(t + 2) * kstep; const GAS char* b2 = last ? nB : cB + (size_t)(t + 2) * kstep;
            const GAS char* a3 = a2 + kstep; const GAS char* b3 = b2 + kstep;
            PG8_LDB(B0, 0, 0); PG8_LDB(B1, 0, 1); PG8_SCHED; PG8_LDA(At, 0, 0); PG8_STAGE(PG8_SA(1, 1), a1 + hstepA, voffA);
            PG8_WAIT_V(8); PG8_WAIT_L(0); PG8_BAR; PG8_MMA(0, 0, At, B0); PG8_MMA(0, 1, At, B1); PG8_BAR; PG8_SCHED;
            PG8_LDA(At, 0, 1); PG8_STAGE(PG8_SB(0, 0), b2, voffB); PG8_STAGE(PG8_SB(0, 1), b2 + hstepB, voffB); PG8_STAGE(PG8_SA(0, 0), a2, voffA);
            PG8_WAIT_V(8); PG8_WAIT_L(0); PG8_BAR; PG8_MMA(1, 0, At, B0); PG8_MMA(1, 1, At, B1); PG8_BAR; PG8_SCHED;
            PG8_LDB(B0, 1, 0); PG8_LDB(B1, 1, 1); PG8_SCHED; PG8_LDA(At, 1, 0); PG8_STAGE(PG8_SA(0, 1), a2 + hstepA, voffA);
            PG8_WAIT_V(8); PG8_WAIT_L(0); PG8_BAR; PG8_MMA(0, 0, At, B0); PG8_MMA(0, 1, At, B1); PG8_BAR; PG8_SCHED;
            PG8_LDA(At, 1, 1); PG8_STAGE(PG8_SB(1, 0), b3, voffB); PG8_STAGE(PG8_SB(1, 1), b3 + hstepB, voffB); PG8_STAGE(PG8_SA(1, 0), a3, voffA);
            PG8_WAIT_V(8); PG8_WAIT_L(0); PG8_BAR; PG8_MMA(1, 0, At, B0); PG8_MMA(1, 1, At, B1); PG8_BAR; PG8_SCHED;
        }
        if (wr == 0) PG8_BAR;
        if constexpr (FP8) asm volatile("s_nop 15\n\ts_nop 15\n\ts_nop 15\n\ts_nop 15" ::: "memory");
        if constexpr (Epi::HAS_PRE) {
            const auto pre = E.preload(cur, wr, fr);
            if constexpr (I8) {
#pragma unroll
                for (int a = 0; a < 2; ++a)
#pragma unroll
                    for (int b = 0; b < 2; ++b)
#pragma unroll
                        for (int m = 0; m < 4; ++m)
#pragma unroll
                            for (int n = 0; n < 2; ++n) { const v4i t = __builtin_bit_cast(v4i, acc[a][b][m][n]); acc[a][b][m][n] = (f32x4){(float)t.x, (float)t.y, (float)t.z, (float)t.w}; } }
            E(acc, cur, wr, wc, fr, fq, pre);
        } else {
        if constexpr (I8) {
#pragma unroll
            for (int a = 0; a < 2; ++a)
#pragma unroll
                for (int b = 0; b < 2; ++b)
#pragma unroll
                    for (int m = 0; m < 4; ++m)
#pragma unroll
                        for (int n = 0; n < 2; ++n) { const v4i t = __builtin_bit_cast(v4i, acc[a][b][m][n]); acc[a][b][m][n] = (f32x4){(float)t.x, (float)t.y, (float)t.z, (float)t.w}; } }
        E(acc, cur, wr, wc, fr, fq);
        }
        if (!has_next) break;
#pragma unroll
        for (int a = 0; a < 2; ++a)
#pragma unroll
            for (int b = 0; b < 2; ++b)
#pragma unroll
                for (int m = 0; m < 4; ++m)
#pragma unroll
                    for (int n = 0; n < 2; ++n) acc[a][b][m][n] = (f32x4){0.f, 0.f, 0.f, 0.f};
        cur = nxt; cA = nA; cB = nB; ++ui;
        if (wr == 1) PG8_BAR;
    }
    PG8_WAIT_V(0);
    PG8_BAR;
#undef PG8_SA
#undef PG8_SB
#undef PG8_STAGE
#undef PG8_LDA
#undef PG8_LDB
#undef PG8_MMA
#undef PG8_WAIT_V
#undef PG8_WAIT_L
#undef PG8_BAR
#undef PG8_SCHED
}

DI f32x2 ex2p(f32x2 x) { return (f32x2){__builtin_amdgcn_exp2f(x.x), __builtin_amdgcn_exp2f(x.y)}; }
DI f32x2 rcpp(f32x2 x) { return (f32x2){__builtin_amdgcn_rcpf(x.x), __builtin_amdgcn_rcpf(x.y)}; }
DI f32x2 lo2(f32x4 v) { return __builtin_shufflevector(v, v, 0, 1); }
DI f32x2 hi2(f32x4 v) { return __builtin_shufflevector(v, v, 2, 3); }
DI v4u pack8p(const f32x2 (&o)[4]) { v4u w; w.x = pk2(o[0].x, o[0].y); w.y = pk2(o[1].x, o[1].y); w.z = pk2(o[2].x, o[2].y); w.w = pk2(o[3].x, o[3].y); return w; }
DI v4u pack8f(const float (&o)[8]) { v4u w; w.x = pk2(o[0], o[1]); w.y = pk2(o[2], o[3]); w.z = pk2(o[4], o[5]); w.w = pk2(o[6], o[7]); return w; }
template <bool LBZ> struct EpiIn {
    static constexpr bool PERM = true; static constexpr bool HAS_PRE = true;
    GAS bf16* P; const GAS float* LB;
    static constexpr bool lbz = LBZ;
    const GAS float* rs; const LAS float* cmax;
    template <int T> DI static void act8(float (&v)[8], const float (&lb)[8]) {
        const float L2E = 1.4426950408889634f, LN2 = 0.6931471805599453f;
        if (T == 2) return;
        if (T == 0 || T == 3 || T == 4) {
            f32x2 a2[4] = {{v[0], v[1]}, {v[2], v[3]}, {v[4], v[5]}, {v[6], v[7]}}, e2[4];
#pragma unroll
            for (int p = 0; p < 4; ++p) e2[p] = ex2p(a2[p] * (f32x2){-L2E, -L2E});
#pragma unroll
            for (int p = 0; p < 4; ++p) { e2[p] = e2[p] + (f32x2){1.0f, 1.0f}; if (T == 0) a2[p] = a2[p] * (f32x2){0.08838834764831845f, 0.08838834764831845f}; }
#pragma unroll
            for (int p = 0; p < 4; ++p) e2[p] = rcpp(e2[p]);
#pragma unroll
            for (int p = 0; p < 4; ++p) { const f32x2 o = (T == 4) ? e2[p] : a2[p] * e2[p]; v[2 * p] = o.x; v[2 * p + 1] = o.y; }
            return;
        }
        f32x2 a2[4] = {{v[0], v[1]}, {v[2], v[3]}, {v[4], v[5]}, {v[6], v[7]}}, t2[4], m2[4];
#pragma unroll
        for (int p = 0; p < 4; ++p) { m2[p] = __builtin_elementwise_min(a2[p], (f32x2){0.f, 0.f}); t2[p] = (a2[p] - m2[p] - m2[p]) * (f32x2){-L2E, -L2E}; }
#pragma unroll
        for (int p = 0; p < 4; ++p) t2[p] = ex2p(t2[p]);
        if constexpr (LBZ) {
#pragma unroll
            for (int p = 0; p < 4; ++p) t2[p] = t2[p] + (f32x2){1.0f, 1.0f};
#pragma unroll
            for (int p = 0; p < 4; ++p) t2[p] = (f32x2){__builtin_amdgcn_logf(t2[p].x), __builtin_amdgcn_logf(t2[p].y)};
#pragma unroll
            for (int p = 0; p < 4; ++p) { const f32x2 o = m2[p] - t2[p] * (f32x2){LN2, LN2}; v[2 * p] = o.x; v[2 * p + 1] = o.y; }
        } else {
            f32x2 r2[4];
#pragma unroll
            for (int p = 0; p < 4; ++p) r2[p] = rcpp(t2[p] + (f32x2){1.0f, 1.0f});
#pragma unroll
            for (int p = 0; p < 4; ++p) { const f32x2 num = (f32x2){a2[p].x >= 0.f ? 1.0f : t2[p].x, a2[p].y >= 0.f ? 1.0f : t2[p].y};
                const f32x2 lbp = (f32x2){lb[2 * p], lb[2 * p + 1]}; r2[p] = lbp + ((f32x2){1.0f, 1.0f} - lbp) * (num * r2[p]); }
#pragma unroll
            for (int p = 0; p < 4; ++p) { v[2 * p] = __builtin_amdgcn_logf(r2[p].x) * LN2; v[2 * p + 1] = __builtin_amdgcn_logf(r2[p].y) * LN2; }
        }
    }
    struct Pre { float r[2][4]; };
    DI Pre preload(const Unit& u, int wr, int fr) const { Pre p; asm volatile("" : "+v"(fr)); const int row0 = u.arow + wr * 64 + fr;
#pragma unroll
        for (int ai = 0; ai < 2; ++ai)
#pragma unroll
            for (int m = 0; m < 4; ++m) p.r[ai][m] = rs[row0 + ai * 128 + m * 16];
        return p; }
    template <int T> DI void run(const f32x4 (&acc)[2][2][4][2], const Unit& u, int wr, int wc, int fr, int fq, const Pre& pre) const {
        const int row0 = u.arow + wr * 64 + fr, colt = u.pn * 256 + wc * 32 + 8 * fq;
        float rsr[2][4];
#pragma unroll
        for (int ai = 0; ai < 2; ++ai)
#pragma unroll
            for (int m = 0; m < 4; ++m) rsr[ai][m] = pre.r[ai][m];
#pragma unroll
        for (int bj = 0; bj < 2; ++bj) {
            float lb[8];
#pragma unroll
            for (int j = 0; j < 8; ++j) lb[j] = (T == 1 && !lbz) ? LB[colt - 512 + bj * 128 + j] : 0.f;
            const f32x4 c0 = *(const LAS f32x4*)(cmax + colt + bj * 128) * (1.0f / 127.0f), c1 = *(const LAS f32x4*)(cmax + colt + bj * 128 + 4) * (1.0f / 127.0f);
#pragma unroll
            for (int ai = 0; ai < 2; ++ai)
#pragma unroll
                for (int m = 0; m < 4; ++m) { GAS bf16* rowp = P + (size_t)(row0 + ai * 128 + m * 16) * INC + colt;
                    const f32x4 w0 = acc[ai][bj][m][0] * (c0 * rsr[ai][m]), w1 = acc[ai][bj][m][1] * (c1 * rsr[ai][m]);
                    float v[8] = {w0[0], w0[1], w0[2], w0[3], w1[0], w1[1], w1[2], w1[3]};
                    act8<T>(v, lb);
                    *(GAS v4u*)(rowp + bj * 128) = pack8f(v);
                    __builtin_amdgcn_sched_barrier(0); }
        }
    }
    DI void operator()(const f32x4 (&acc)[2][2][4][2], const Unit& u, int wr, int wc, int fr, int fq, const Pre& pre) const {
        const int t = u.pn >> 1;
        if (t == 0) run<0>(acc, u, wr, wc, fr, fq, pre);
        else if (t == 1 || t == 2) run<1>(acc, u, wr, wc, fr, fq, pre);
        else if (t == 3 || t == 5) run<2>(acc, u, wr, wc, fr, fq, pre);
        else if (t == 4) run<3>(acc, u, wr, wc, fr, fq, pre);
        else run<4>(acc, u, wr, wc, fr, fq, pre);
    }
};
template <int MODE> struct EpiRow {
    static constexpr bool PERM = true; static constexpr bool HAS_PRE = false;
    GAS bf16* O; int ldc; const GAS float* colscale; int g2off;
    DI void operator()(const f32x4 (&acc)[2][2][4][2], const Unit& u, int wr, int wc, int fr, int fq) const {
        const int row0 = u.arow + wr * 64 + fr, colt = u.pn * 256 + wc * 32 + 8 * fq;
        if constexpr (MODE == 0) {
            float cs[2][8];
#pragma unroll
            for (int bj = 0; bj < 2; ++bj)
#pragma unroll
                for (int j = 0; j < 8; ++j) cs[bj][j] = colscale ? colscale[colt + bj * 128 + j] : 1.f;
#pragma unroll
            for (int ai = 0; ai < 2; ++ai)
#pragma unroll
                for (int m = 0; m < 4; ++m) { GAS bf16* rowp = O + (size_t)(row0 + ai * 128 + m * 16) * ldc + colt;
#pragma unroll
                    for (int bj = 0; bj < 2; ++bj) { const f32x4 v0 = acc[ai][bj][m][0], v1 = acc[ai][bj][m][1];
                        float o[8] = {v0[0], v0[1], v0[2], v0[3], v1[0], v1[1], v1[2], v1[3]};
#pragma unroll
                        for (int j = 0; j < 8; ++j) o[j] *= cs[bj][j];
                        v4u w; w.x = pk2(o[0], o[1]); w.y = pk2(o[2], o[3]); w.z = pk2(o[4], o[5]); w.w = pk2(o[6], o[7]);
                        *(GAS v4u*)(rowp + bj * 128) = w; } }
        } else if constexpr (MODE == 1) {
            v4u gq[2][4], r0[2][4];
#pragma unroll
            for (int ai = 0; ai < 2; ++ai)
#pragma unroll
                for (int m = 0; m < 4; ++m) gq[ai][m] = *(const GAS v4u*)(O + (size_t)(row0 + ai * 128 + m * 16) * ldc + colt);
#pragma unroll
            for (int ai = 0; ai < 2; ++ai)
#pragma unroll
                for (int m = 0; m < 4; ++m) { const f32x4 v0 = acc[ai][0][m][0], v1 = acc[ai][0][m][1]; const v4u g = gq[ai][m];
                    v4u w; w.x = pk2(v0[0] * bflo(g.x), v0[1] * bfhi(g.x)); w.y = pk2(v0[2] * bflo(g.y), v0[3] * bfhi(g.y)); w.z = pk2(v1[0] * bflo(g.z), v1[1] * bfhi(g.z)); w.w = pk2(v1[2] * bflo(g.w), v1[3] * bfhi(g.w));
                    r0[ai][m] = w; }
            __builtin_amdgcn_sched_barrier(0);
#pragma unroll
            for (int ai = 0; ai < 2; ++ai)
#pragma unroll
                for (int m = 0; m < 4; ++m) gq[ai][m] = *(const GAS v4u*)(O + (size_t)(row0 + ai * 128 + m * 16) * ldc + colt + 128);
            __builtin_amdgcn_sched_barrier(0);
#pragma unroll
            for (int ai = 0; ai < 2; ++ai)
#pragma unroll
                for (int m = 0; m < 4; ++m) *(GAS v4u*)(O + (size_t)(row0 + ai * 128 + m * 16) * ldc + colt) = r0[ai][m];
            __builtin_amdgcn_sched_barrier(0);
#pragma unroll
            for (int ai = 0; ai < 2; ++ai)
#pragma unroll
                for (int m = 0; m < 4; ++m) { const f32x4 v0 = acc[ai][1][m][0], v1 = acc[ai][1][m][1]; const v4u g = gq[ai][m];
                    v4u w; w.x = pk2(v0[0] * bflo(g.x), v0[1] * bfhi(g.x)); w.y = pk2(v0[2] * bflo(g.y), v0[3] * bfhi(g.y)); w.z = pk2(v1[0] * bflo(g.z), v1[1] * bfhi(g.z)); w.w = pk2(v1[2] * bflo(g.w), v1[3] * bfhi(g.w));
                    *(GAS v4u*)(O + (size_t)(row0 + ai * 128 + m * 16) * ldc + colt + 128) = w; }
        } else {
            v4u gq[2][4], pq[2][4], rq[4];
            auto LD = [&](int q, int slot) {
#pragma unroll
                for (int m = 0; m < 4; ++m) { const GAS bf16* rp = O + (size_t)(row0 + (q & 1) * 128 + m * 16) * ldc + colt + (q >> 1) * 128; gq[slot][m] = *(const GAS v4u*)(rp + g2off); pq[slot][m] = *(const GAS v4u*)rp; } };
            auto CP = [&](int q, int slot) {
#pragma unroll
                for (int m = 0; m < 4; ++m) { const f32x4 v0 = acc[q & 1][q >> 1][m][0], v1 = acc[q & 1][q >> 1][m][1]; const v4u g = gq[slot][m], t = pq[slot][m];
                    v4u w; w.x = pk2(bflo(t.x) + v0[0] * bflo(g.x), bfhi(t.x) + v0[1] * bfhi(g.x)); w.y = pk2(bflo(t.y) + v0[2] * bflo(g.y), bfhi(t.y) + v0[3] * bfhi(g.y));
                    w.z = pk2(bflo(t.z) + v1[0] * bflo(g.z), bfhi(t.z) + v1[1] * bfhi(g.z)); w.w = pk2(bflo(t.w) + v1[2] * bflo(g.w), bfhi(t.w) + v1[3] * bfhi(g.w));
                    rq[m] = w; } };
            auto ST = [&](int q) {
#pragma unroll
                for (int m = 0; m < 4; ++m) *(GAS v4u*)(O + (size_t)(row0 + (q & 1) * 128 + m * 16) * ldc + colt + (q >> 1) * 128) = rq[m]; };
            LD(0, 0); LD(1, 1); __builtin_amdgcn_sched_barrier(0);
            CP(0, 0); __builtin_amdgcn_sched_barrier(0); LD(2, 0); __builtin_amdgcn_sched_barrier(0); ST(0); __builtin_amdgcn_sched_barrier(0);
            CP(1, 1); __builtin_amdgcn_sched_barrier(0); LD(3, 1); __builtin_amdgcn_sched_barrier(0); ST(1); __builtin_amdgcn_sched_barrier(0);
            CP(2, 0); ST(2); __builtin_amdgcn_sched_barrier(0);
            CP(3, 1); ST(3);
        }
    }
};
template <bool OUT8> struct EpiSwiGLU {
    static constexpr bool PERM = true; static constexpr bool HAS_PRE = true;
    GAS bf16* Hh; int ldc; const GAS float* rowgate;
    const GAS float* rs; const LAS float* cmg; const LAS float* cmu;
    struct Pre { float r[2][4]; };
    DI Pre preload(const Unit& u, int wr, int fr) const { Pre p; asm volatile("" : "+v"(fr)); const int row0 = u.arow + wr * 64 + fr;
#pragma unroll
        for (int ai = 0; ai < 2; ++ai)
#pragma unroll
            for (int m = 0; m < 4; ++m) p.r[ai][m] = rs[row0 + ai * 128 + m * 16];
        return p; }
    DI void operator()(const f32x4 (&acc)[2][2][4][2], const Unit& u, int wr, int wc, int fr, int fq, const Pre& pre) const {
        const int row0 = u.arow + wr * 64 + fr, col0 = u.pn * 128 + wc * 32 + 8 * fq;
        const f32x4 sg4[2] = {*(const LAS f32x4*)(cmg + col0) * (1.0f / 127.0f), *(const LAS f32x4*)(cmg + col0 + 4) * (1.0f / 127.0f)}, su4[2] = {*(const LAS f32x4*)(cmu + col0) * (1.0f / 127.0f), *(const LAS f32x4*)(cmu + col0 + 4) * (1.0f / 127.0f)};
        float rsv[2][4], rgv[2][4];
#pragma unroll
        for (int ai = 0; ai < 2; ++ai)
#pragma unroll
            for (int m = 0; m < 4; ++m) { rsv[ai][m] = pre.r[ai][m]; rgv[ai][m] = rowgate ? rowgate[row0 + ai * 128 + m * 16] : 1.f; }
#pragma unroll
        for (int ai = 0; ai < 2; ++ai)
#pragma unroll
            for (int m = 0; m < 4; ++m) { const int row = row0 + ai * 128 + m * 16; const float rg = rgv[ai][m];
                const f32x4 g0 = acc[ai][0][m][0], g1 = acc[ai][0][m][1], u0 = acc[ai][1][m][0], u1 = acc[ai][1][m][1];
                const float rsr = rsv[ai][m];
                const f32x4 a0 = g0 * (sg4[0] * rsr), a1 = g1 * (sg4[1] * rsr), b0 = u0 * (su4[0] * (rsr * rg)), b1 = u1 * (su4[1] * (rsr * rg));
                f32x2 g2[4] = {lo2(a0), hi2(a0), lo2(a1), hi2(a1)}, u2[4] = {lo2(b0), hi2(b0), lo2(b1), hi2(b1)}, e2[4];
#pragma unroll
                for (int p = 0; p < 4; ++p) e2[p] = ex2p(g2[p] * (f32x2){-1.4426950408889634f, -1.4426950408889634f});
#pragma unroll
                for (int p = 0; p < 4; ++p) e2[p] = e2[p] + (f32x2){1.0f, 1.0f};
#pragma unroll
                for (int p = 0; p < 4; ++p) e2[p] = rcpp(e2[p]);
#pragma unroll
                for (int p = 0; p < 4; ++p) g2[p] = g2[p] * u2[p];
#pragma unroll
                for (int p = 0; p < 4; ++p) g2[p] = g2[p] * e2[p];
                if constexpr (OUT8) { v2u w; w.x = pk4_fp8(g2[0].x, g2[0].y, g2[1].x, g2[1].y); w.y = pk4_fp8(g2[2].x, g2[2].y, g2[3].x, g2[3].y);
                    *(GAS v2u*)((GAS unsigned char*)Hh + (size_t)row * ldc + col0) = w; }
                else *(GAS v4u*)(Hh + (size_t)row * ldc + col0) = pack8p(g2); }
    }
};
template <class E> struct EpiDry { static constexpr bool PERM = E::PERM; static constexpr bool HAS_PRE = false; E e; bool never;
    DI void operator()(const f32x4 (&acc)[2][2][4][2], const Unit& u, int wr, int wc, int fr, int fq) const { if (never) e(acc, u, wr, wc, fr, fq); } };
struct EpiSwiGLU8 {
    static constexpr bool PERM = true; static constexpr bool HAS_PRE = false;
    GAS unsigned char* Hh; int ldc; const GAS float* rowgate;
    DI void operator()(const f32x4 (&acc)[2][2][4][2], const Unit& u, int wr, int wc, int fr, int fq) const {
        const int row0 = u.arow + wr * 64 + fr, col0 = u.pn * 128 + wc * 32 + 8 * fq;
        float rgv[2][4];
#pragma unroll
        for (int ai = 0; ai < 2; ++ai)
#pragma unroll
            for (int m = 0; m < 4; ++m) rgv[ai][m] = rowgate ? rowgate[row0 + ai * 128 + m * 16] : 1.f;
#pragma unroll
        for (int ai = 0; ai < 2; ++ai)
#pragma unroll
            for (int m = 0; m < 4; ++m) { const int row = row0 + ai * 128 + m * 16; const float rg = rgv[ai][m];
                const f32x4 g0 = acc[ai][0][m][0], g1 = acc[ai][0][m][1], u0 = acc[ai][1][m][0], u1 = acc[ai][1][m][1];
                f32x2 g2[4] = {lo2(g0), hi2(g0), lo2(g1), hi2(g1)}, u2[4] = {lo2(u0), hi2(u0), lo2(u1), hi2(u1)}, e2[4];
#pragma unroll
                for (int p = 0; p < 4; ++p) e2[p] = ex2p(g2[p] * (f32x2){-1.4426950408889634f, -1.4426950408889634f});
#pragma unroll
                for (int p = 0; p < 4; ++p) { e2[p] = e2[p] + (f32x2){1.0f, 1.0f}; u2[p] = u2[p] * (f32x2){rg, rg}; }
#pragma unroll
                for (int p = 0; p < 4; ++p) e2[p] = rcpp(e2[p]);
#pragma unroll
                for (int p = 0; p < 4; ++p) g2[p] = g2[p] * u2[p];
#pragma unroll
                for (int p = 0; p < 4; ++p) g2[p] = g2[p] * e2[p];
                v2u w; w.x = pk4_fp8(g2[0].x, g2[0].y, g2[1].x, g2[1].y); w.y = pk4_fp8(g2[2].x, g2[2].y, g2[3].x, g2[3].y);
                *(GAS v2u*)(Hh + (size_t)row * ldc + col0) = w; }
    }
};
}

struct Args { const float* in[25]; float* out; unsigned char* ws; int ph_lo, ph_hi; };
struct Frame {
    LAS unsigned char* lds; int tid, lane, wave, G, gw, NGW; bool never;
    GAS float* out; GAS unsigned char* ws;
};
DI Frame fresh(const Frame& F0) { Frame F = F0; asm volatile("" : "+v"(F.tid)); F.lane = F.tid & 63; asm volatile("" : "+s"(F.ws), "+s"(F.out)); return F; }
enum { I_X = 0, I_C, I_CTX, I_CCTX, I_ADAW, I_ADAB, I_MIXPRE, I_MIXPOST, I_FFNPRE, I_FFNPOST, I_WIN, I_LB, I_GAIN, I_POOLW, I_POOLS, I_WBR, I_WBP, I_WOUT, I_FG, I_FU, I_FD, I_ROUTER, I_MG, I_MU, I_MD };

DI void tr_item(const GAS float* W, int K, int N, GAS bf16* WT, int ldk, int koff, int row_off, int nb, int nstride, LAS float* scr, int item, int lane) {
    const int nblk = N / 32, kb = item / nblk, nbi = item % nblk, k0 = 64 * kb, n0 = 32 * nbi;
    f32x4 ld[8];
#pragma unroll
    for (int i = 0; i < 8; ++i) ld[i] = *(const GAS f32x4*)(W + (size_t)(k0 + (lane >> 3) + 8 * i) * N + n0 + 4 * (lane & 7));
#pragma unroll
    for (int i = 0; i < 8; ++i) { LAS float* d = scr + ((lane >> 3) + 8 * i) * 33 + 4 * (lane & 7); d[0] = ld[i].x; d[1] = ld[i].y; d[2] = ld[i].z; d[3] = ld[i].w; }
    LDS_WAIT(); asm volatile("" ::: "memory");
    const int c = lane & 7;
#pragma unroll
    for (int j = 0; j < 4; ++j) { const int n = (lane >> 3) + 8 * j; const LAS float* s = scr + (8 * c) * 33 + n;
        v4u o; o.x = pk2(s[0 * 33], s[1 * 33]); o.y = pk2(s[2 * 33], s[3 * 33]); o.z = pk2(s[4 * 33], s[5 * 33]); o.w = pk2(s[6 * 33], s[7 * 33]);
        const int ng = n0 + n, drow = row_off + (ng / nb) * nstride + (ng % nb);
        *(GAS v4u*)(WT + (size_t)drow * ldk + koff + k0 + 8 * c) = o; }
    LDS_WAIT(); asm volatile("" ::: "memory");
}

DI void tr_item8(const GAS float* W, int K, int N, GAS unsigned char* WT, int ldk, int row_off, int nb, int nstride, float qs, LAS float* scr, int item, int lane) {
    const int nblk = N / 32, kb = item / nblk, nbi = item % nblk, k0 = 64 * kb, n0 = 32 * nbi;
    f32x4 ld[8];
#pragma unroll
    for (int i = 0; i < 8; ++i) ld[i] = *(const GAS f32x4*)(W + (size_t)(k0 + (lane >> 3) + 8 * i) * N + n0 + 4 * (lane & 7));
#pragma unroll
    for (int i = 0; i < 8; ++i) { LAS float* d = scr + ((lane >> 3) + 8 * i) * 33 + 4 * (lane & 7); d[0] = ld[i].x; d[1] = ld[i].y; d[2] = ld[i].z; d[3] = ld[i].w; }
    LDS_WAIT(); asm volatile("" ::: "memory");
    const int c = lane & 7;
#pragma unroll
    for (int j = 0; j < 4; ++j) { const int n = (lane >> 3) + 8 * j; const LAS float* sp = scr + (8 * c) * 33 + n;
        v2u o; o.x = pk4_fp8(sp[0 * 33] * qs, sp[1 * 33] * qs, sp[2 * 33] * qs, sp[3 * 33] * qs); o.y = pk4_fp8(sp[4 * 33] * qs, sp[5 * 33] * qs, sp[6 * 33] * qs, sp[7 * 33] * qs);
        const int ng = n0 + n, drow = row_off + (ng / nb) * nstride + (ng % nb);
        *(GAS v2u*)(WT + (size_t)drow * ldk + k0 + 8 * c) = o; }
    LDS_WAIT(); asm volatile("" ::: "memory");
}

DI void absmax_item(const GAS float* W, int N, GAS unsigned* cmaxbits, int item, int lane) {
    const int nblk = N / 256, kb = item / nblk, nbi = item % nblk;
    const GAS float* p = W + (size_t)(64 * kb) * N + 256 * nbi + 4 * lane;
    f32x4 m = (f32x4){0.f, 0.f, 0.f, 0.f};
#pragma unroll 8
    for (int k = 0; k < 64; ++k) { const f32x4 w = *(const GAS f32x4*)(p + (size_t)k * N); m.x = fmaxf(m.x, fabsf(w.x)); m.y = fmaxf(m.y, fabsf(w.y)); m.z = fmaxf(m.z, fabsf(w.z)); m.w = fmaxf(m.w, fabsf(w.w)); }
    GAS unsigned* c = cmaxbits + 256 * nbi + 4 * lane;
    __hip_atomic_fetch_max(c + 0, __float_as_uint(m.x), __ATOMIC_RELAXED, __HIP_MEMORY_SCOPE_AGENT); __hip_atomic_fetch_max(c + 1, __float_as_uint(m.y), __ATOMIC_RELAXED, __HIP_MEMORY_SCOPE_AGENT);
    __hip_atomic_fetch_max(c + 2, __float_as_uint(m.z), __ATOMIC_RELAXED, __HIP_MEMORY_SCOPE_AGENT); __hip_atomic_fetch_max(c + 3, __float_as_uint(m.w), __ATOMIC_RELAXED, __HIP_MEMORY_SCOPE_AGENT);
}
DI void tr_item_i8(const GAS float* W, int K, int N, GAS unsigned char* WT, int ldk, const GAS float* cmax, LAS float* scr, int item, int lane, int row_off = 0, int nb = 1 << 30, int nstride = 0) {
    const int nblk = N / 32, kb = item / nblk, nbi = item % nblk, k0 = 64 * kb, n0 = 32 * nbi;
    f32x4 ld[8];
#pragma unroll
    for (int i = 0; i < 8; ++i) ld[i] = *(const GAS f32x4*)(W + (size_t)(k0 + (lane >> 3) + 8 * i) * N + n0 + 4 * (lane & 7));
#pragma unroll
    for (int i = 0; i < 8; ++i) { LAS float* d = scr + ((lane >> 3) + 8 * i) * 33 + 4 * (lane & 7); d[0] = ld[i].x; d[1] = ld[i].y; d[2] = ld[i].z; d[3] = ld[i].w; }
    LDS_WAIT(); asm volatile("" ::: "memory");
    const int c = lane & 7;
#pragma unroll
    for (int j = 0; j < 4; ++j) { const int n = (lane >> 3) + 8 * j; const LAS float* sp = scr + (8 * c) * 33 + n;
        const float q = 127.0f / fmaxf(cmax[n0 + n], 1e-30f);
        v2u o; o.x = pk4_i8(sp[0 * 33] * q, sp[1 * 33] * q, sp[2 * 33] * q, sp[3 * 33] * q); o.y = pk4_i8(sp[4 * 33] * q, sp[5 * 33] * q, sp[6 * 33] * q, sp[7 * 33] * q);
        const int ng = n0 + n, drow = row_off + (ng / nb) * nstride + (ng % nb);
        *(GAS v2u*)(WT + (size_t)drow * ldk + k0 + 8 * c) = o; }
    LDS_WAIT(); asm volatile("" ::: "memory");
}

DI void p0_prologue(const Frame& F0, const Args& A) {
    const Frame F = fresh(F0);
    LAS float* scr = (LAS float*)(F.lds + F.wave * 16384);
    GAS unsigned char* ws = F.ws;
    constexpr int IT_IN = 16 * 160, IT_BR = 8 * 32, IT_O = 16 * 32, IT_F = 16 * 88, IT_FD = 44 * 32;
    constexpr int PER_L = IT_BR + IT_O;
    constexpr int NITEMS = 2 * PER_L + IT_FD;
    for (int it = F.gw; it < NITEMS; it += F.NGW) {
        int r = it;
        if (r < 2 * PER_L) { const int l = r / PER_L; r -= l * PER_L;
            if (r < IT_BR) { tr_item(((const GAS float*)A.in[I_WBR]) + (size_t)l * DH * D, DH, D, (GAS bf16*)(ws + WS_WR) + (size_t)l * D * DH, DH, 0, 0, 1 << 30, 0, scr, r, F.lane); continue; } r -= IT_BR;
            tr_item(((const GAS float*)A.in[I_WOUT]) + (size_t)l * D * D, D, D, (GAS bf16*)(ws + WS_WO) + (size_t)l * D * D, D, 0, 0, 1 << 30, 0, scr, r, F.lane); continue; }
        r -= 2 * PER_L;
        tr_item8(((const GAS float*)A.in[I_FD]), DFF, D, ws + WS_WD, DFF, 0, 1 << 30, 0, 64.f, scr, r, F.lane);
    }
    for (int it = F.gw; it < 2 * 16 * 20; it += F.NGW) { const int l = it / 320;
        absmax_item(((const GAS float*)A.in[I_WIN]) + (size_t)l * D * INC, INC, (GAS unsigned*)(ws + WS_CTL) + CW_CMAX_IN + l * INC, it % 320, F.lane); }
    for (int it = F.gw; it < 2 * 16 * 11; it += F.NGW) { const int w = it / 176;
        absmax_item((const GAS float*)A.in[w ? I_FU : I_FG], DFF, (GAS unsigned*)(ws + WS_CTL) + (w ? CW_CMAX_FU : CW_CMAX_FG), it % 176, F.lane); }
    for (int item = blockIdx.x; item < 2 * 4 * 16 * 2; item += F.G) {
        const int l = item >> 7, g = (item >> 5) & 3, cb = (item >> 1) & 15, n = (item & 1) * 512 + F.tid;
        const GAS float* pw = ((const GAS float*)A.in[I_POOLW]) + (((size_t)l * 4 + g) * 128 + cb * 8) * 128;
        const GAS float* ps = ((const GAS float*)A.in[I_POOLS]) + l * DH + g * 128;
        const GAS float* wp = ((const GAS float*)A.in[I_WBP]) + ((size_t)l * DH + g * 128) * D + n;
        float acc[8];
#pragma unroll
        for (int j = 0; j < 8; ++j) acc[j] = 0.f;
#pragma unroll 8
        for (int e = 0; e < 128; ++e) { const float w = wp[(size_t)e * D] * ps[e];
#pragma unroll
            for (int j = 0; j < 8; ++j) acc[j] += pw[j * 128 + e] * w; }
        v4u o; o.x = pk2(acc[0], acc[1]); o.y = pk2(acc[2], acc[3]); o.z = pk2(acc[4], acc[5]); o.w = pk2(acc[6], acc[7]);
        *(GAS v4u*)((GAS bf16*)(ws + WS_WP) + ((size_t)l * D + n) * DH + g * 128 + cb * 8) = o;
    }
    for (int i = blockIdx.x * NTHR + F.tid; i < 2 * 2 * DH; i += F.G * NTHR) {
        const int l = i / (2 * DH), rem = i % (2 * DH);
        float v = 0.f;
        if (l == 1) { const float h0 = ((const GAS float*)A.in[I_LB])[rem], h1 = ((const GAS float*)A.in[I_LB])[2 * DH + rem]; v = 1.f / (1.f + expf(h0 - h1)); }
        ((GAS float*)(ws + WS_LB))[i] = v;
    }
    __syncthreads();
    constexpr int TP = 1026;
    LAS float* T = (LAS float*)F.lds;
    for (int item = blockIdx.x; item < 2 * 96; item += F.G) {
        const int l = item / 96, e0 = (item % 96) * 64;
        for (int i = F.tid; i < 33 * 1024; i += NTHR) { const int bb = i >> 10, k = i & 1023; const float cv = bb < 32 ? ((const GAS float*)A.in[I_C])[bb * 1024 + k] : ((const GAS float*)A.in[I_CCTX])[k];
            T[bb * TP + k] = cv * __builtin_amdgcn_rcpf(1.0f + __builtin_amdgcn_exp2f(-1.4426950408889634f * cv)); }
        __syncthreads();
        const int kq = F.wave, j = F.lane & 31, kk = F.lane >> 5;
        const GAS float* wp = ((const GAS float*)A.in[I_ADAW]) + (size_t)l * D * 6144 + (size_t)(128 * kq + kk) * 6144 + e0 + 2 * j;
        const LAS float* tp = T + j * TP + 128 * kq + kk; const LAS float* t32 = T + 32 * TP + 128 * kq + kk;
        f32x16 acc0, acc1;
#pragma unroll
        for (int r = 0; r < 16; ++r) { acc0[r] = 0.f; acc1[r] = 0.f; }
        float c0 = 0.f, c1 = 0.f;
#pragma unroll 1
        for (int bt = 0; bt < 8; ++bt) { f32x2 wb[8];
#pragma unroll
            for (int u = 0; u < 8; ++u) wb[u] = *(const GAS f32x2*)(wp + (size_t)(2 * (8 * bt + u)) * 6144);
#pragma unroll
            for (int u = 0; u < 8; ++u) { const int s2 = 8 * bt + u; const float a = tp[2 * s2], tc = t32[2 * s2]; const f32x2 w = wb[u];
                acc0 = __builtin_amdgcn_mfma_f32_32x32x2f32(a, w.x, acc0, 0, 0, 0);
                acc1 = __builtin_amdgcn_mfma_f32_32x32x2f32(a, w.y, acc1, 0, 0, 0);
                c0 += tc * w.x; c1 += tc * w.y; }
        }
        c0 += __shfl_xor(c0, 32); c1 += __shfl_xor(c1, 32);
        __syncthreads();
        LAS float* R = (LAS float*)F.lds;
#pragma unroll
        for (int r = 0; r < 16; ++r) { const int i = 8 * (r >> 2) + 4 * kk + (r & 3); R[(kq * 33 + i) * 64 + 2 * j] = acc0[r]; R[(kq * 33 + i) * 64 + 2 * j + 1] = acc1[r]; }
        if (kk == 0) { R[(kq * 33 + 32) * 64 + 2 * j] = c0; R[(kq * 33 + 32) * 64 + 2 * j + 1] = c1; }
        __syncthreads();
        for (int i = F.tid; i < 33 * 64; i += NTHR) { const int b = i >> 6, c = i & 63; float sm = 0.f;
#pragma unroll
            for (int q = 0; q < 8; ++q) sm += R[(q * 33 + b) * 64 + c];
            ((GAS float*)(ws + WS_MOD))[((size_t)l * 33 + b) * 6144 + e0 + c] = sm + ((const GAS float*)A.in[I_ADAB])[l * 6144 + e0 + c]; }
        __syncthreads();
    }
}

DI void win_to_i8(const Frame& F0, const Args& A) {
    const Frame F = fresh(F0);
    LAS float* scr = (LAS float*)(F.lds + F.wave * 16384);
    for (int it = F.gw; it < 2 * 16 * 160; it += F.NGW) { const int l = it / 2560;
        tr_item_i8(((const GAS float*)A.in[I_WIN]) + (size_t)l * D * INC, D, INC, F.ws + WS_WIN + (size_t)l * INC * D, D, (const GAS float*)(F.ws + WS_CTL) + CW_CMAX_IN + l * INC, scr, it % 2560, F.lane); }
    for (int it = F.gw; it < 2 * 16 * 88; it += F.NGW) { const int w = it / 1408;
        tr_item_i8((const GAS float*)A.in[w ? I_FU : I_FG], D, DFF, F.ws + WS_WGU, D, (const GAS float*)(F.ws + WS_CTL) + (w ? CW_CMAX_FU : CW_CMAX_FG), scr, it % 1408, F.lane, w ? 128 : 0, 128, 256); }
}
constexpr int MOE_CONV_ITEMS = NE * (2 * 16 * 112 + 56 * 32), MOE_C1 = 16000, MOE_C2 = 8000;
struct Tr8Desc { const GAS float* W; GAS unsigned char* WT; int N, ldk, row_off, nb, nstride, item; float qs; };
DI void tr8_load(const Tr8Desc& d, int lane, f32x4 (&ld)[8]) {
    const int nblk = d.N / 32, kb = d.item / nblk, nbi = d.item % nblk, k0 = 64 * kb, n0 = 32 * nbi;
#pragma unroll
    for (int i = 0; i < 8; ++i) ld[i] = *(const GAS f32x4*)(d.W + (size_t)(k0 + (lane >> 3) + 8 * i) * d.N + n0 + 4 * (lane & 7));
}
DI void tr8_to_lds(int lane, LAS float* scr, const f32x4 (&ld)[8]) {
#pragma unroll
    for (int i = 0; i < 8; ++i) { LAS float* q = scr + ((lane >> 3) + 8 * i) * 33 + 4 * (lane & 7); q[0] = ld[i].x; q[1] = ld[i].y; q[2] = ld[i].z; q[3] = ld[i].w; }
    LDS_WAIT(); asm volatile("" ::: "memory");
}
DI void tr8_store(const Tr8Desc& d, int lane, LAS float* scr) {
    const int nblk = d.N / 32, kb = d.item / nblk, nbi = d.item % nblk, k0 = 64 * kb, n0 = 32 * nbi, c = lane & 7; const float qs = d.qs;
#pragma unroll
    for (int j = 0; j < 4; ++j) { const int n = (lane >> 3) + 8 * j; const LAS float* sp = scr + (8 * c) * 33 + n;
        v2u o; o.x = pk4_fp8(sp[0 * 33] * qs, sp[1 * 33] * qs, sp[2 * 33] * qs, sp[3 * 33] * qs); o.y = pk4_fp8(sp[4 * 33] * qs, sp[5 * 33] * qs, sp[6 * 33] * qs, sp[7 * 33] * qs);
        const int ng = n0 + n, drow = d.row_off + (ng / d.nb) * d.nstride + (ng % d.nb);
        *(GAS v2u*)(d.WT + (size_t)drow * d.ldk + k0 + 8 * c) = o; }
    LDS_WAIT(); asm volatile("" ::: "memory");
}
DI void moe_weight_convert(const Frame& F0, const Args& A, int it0, int it1, int wg0) {
    const Frame F = fresh(F0);
    if ((int)blockIdx.x < wg0) return;
    LAS float* scr = (LAS float*)(F.lds + F.wave * 16384);
    constexpr int IT_G = 16 * 112, IT_D = 56 * 32, PER_E = 2 * IT_G + IT_D;
    auto desc = [&](int it) { Tr8Desc d; const int e = it / PER_E; int r = it % PER_E;
        GAS unsigned char* gu = F.ws + WS_MGU + (size_t)e * 2 * DEX * D;
        if (r < IT_G) { d.W = ((const GAS float*)A.in[I_MG]) + (size_t)e * D * DEX; d.WT = gu; d.N = DEX; d.ldk = D; d.row_off = 0; d.nb = 128; d.nstride = 256; d.qs = 32.f; d.item = r; return d; } r -= IT_G;
        if (r < IT_G) { d.W = ((const GAS float*)A.in[I_MU]) + (size_t)e * D * DEX; d.WT = gu; d.N = DEX; d.ldk = D; d.row_off = 128; d.nb = 128; d.nstride = 256; d.qs = 32.f; d.item = r; return d; } r -= IT_G;
        d.W = ((const GAS float*)A.in[I_MD]) + (size_t)e * DEX * D; d.WT = F.ws + WS_MD + (size_t)e * D * DEX; d.N = D; d.ldk = DEX; d.row_off = 0; d.nb = 1 << 30; d.nstride = 0; d.qs = 64.f; d.item = r; return d; };
    const int step = (F.G - wg0) * NWAVES;
    int it = it0 + ((int)blockIdx.x - wg0) * NWAVES + F.wave;
    if (it >= it1) return;
    f32x4 ld[8]; Tr8Desc cur = desc(it); tr8_load(cur, F.lane, ld);
    for (;;) {
        tr8_to_lds(F.lane, scr, ld);
        const int itn = it + step; const bool more = itn < it1;
        Tr8Desc nxt = cur;
        if (more) { nxt = desc(itn); tr8_load(nxt, F.lane, ld); }
        tr8_store(cur, F.lane, scr);
        if (!more) break;
        cur = nxt; it = itn;
    }
}

struct RowVecs { f32x4 a1[4], a2[4], a3[4]; };
DI void load_rowvecs(RowVecs& V, const GAS float* gatev, const GAS float* postg, const GAS float* preg, const GAS float* sc, const GAS float* sh, int lane) {
#pragma unroll
    for (int j = 0; j < 4; ++j) { const int e = 4 * lane + 256 * j;
        if (gatev) { const f32x4 g = *(const GAS f32x4*)(gatev + e), p = *(const GAS f32x4*)(postg + e); V.a1[j] = g * p; } else V.a1[j] = (f32x4){0.f, 0.f, 0.f, 0.f};
        if (preg) { const f32x4 p = *(const GAS f32x4*)(preg + e), s = *(const GAS f32x4*)(sc + e); V.a2[j] = p * (s + 1.0f); V.a3[j] = *(const GAS f32x4*)(sh + e); }
        else { V.a2[j] = (f32x4){0.f, 0.f, 0.f, 0.f}; V.a3[j] = V.a2[j]; } }
}
struct RowData { f32x4 x[4]; v2u y[4]; };
DI GAS bf16* xb_row(GAS float* out, int r) { return (GAS bf16*)(out + (size_t)r * D) + D; }
DI void row_load(RowData& R, const GAS float* xin, const GAS bf16* xinb, const GAS bf16* y, int lane) {
    if (xinb) {
#pragma unroll
        for (int j = 0; j < 4; ++j) { const v2u w = *(const GAS v2u*)(xinb + 4 * lane + 256 * j); R.x[j] = (f32x4){bflo(w.x), bfhi(w.x), bflo(w.y), bfhi(w.y)}; }
    } else {
#pragma unroll
        for (int j = 0; j < 4; ++j) R.x[j] = *(const GAS f32x4*)(xin + 4 * lane + 256 * j);
    }
    if (y) {
#pragma unroll
        for (int j = 0; j < 4; ++j) R.y[j] = *(const GAS v2u*)(y + 4 * lane + 256 * j);
    }
}
DI void row_compute(const RowData& R, bool hasy, GAS float* xout, GAS bf16* xoutb, GAS bf16* hout, const RowVecs& V, int lane, f32x4 (&hv)[4], GAS unsigned char* hout8 = nullptr, GAS unsigned char* hout_i8 = nullptr, GAS float* rs_out = nullptr) {
    f32x4 v[4];
#pragma unroll
    for (int j = 0; j < 4; ++j) v[j] = R.x[j];
    if (hasy) {
        f32x4 yv[4]; float ss = 0.f;
#pragma unroll
        for (int j = 0; j < 4; ++j) { const v2u w = R.y[j]; yv[j] = (f32x4){bflo(w.x), bfhi(w.x), bflo(w.y), bfhi(w.y)};
            ss += (yv[j].x * yv[j].x + yv[j].y * yv[j].y) + (yv[j].z * yv[j].z + yv[j].w * yv[j].w); }
        const float r = 1.0f / sqrtf(wave_sum(ss) * (1.0f / D) + EPS);
#pragma unroll
        for (int j = 0; j < 4; ++j) v[j] += V.a1[j] * (yv[j] * r);
    }
    if (xout) {
#pragma unroll
        for (int j = 0; j < 4; ++j) *(GAS f32x4*)(xout + 4 * lane + 256 * j) = v[j];
    }
    if (xoutb) {
#pragma unroll
        for (int j = 0; j < 4; ++j) { v2u w; w.x = pk2(v[j].x, v[j].y); w.y = pk2(v[j].z, v[j].w); *(GAS v2u*)(xoutb + 4 * lane + 256 * j) = w; }
    }
    if (hout || hout8 || hout_i8) {
        float ss = 0.f;
#pragma unroll
        for (int j = 0; j < 4; ++j) ss += (v[j].x * v[j].x + v[j].y * v[j].y) + (v[j].z * v[j].z + v[j].w * v[j].w);
        const float r = 1.0f / sqrtf(wave_sum(ss) * (1.0f / D) + EPS);
#pragma unroll
        for (int j = 0; j < 4; ++j) hv[j] = (v[j] * r) * V.a2[j] + V.a3[j];
        if (hout_i8) {
            float m = 0.f;
#pragma unroll
            for (int j = 0; j < 4; ++j) m = fmaxf(m, fmaxf(fmaxf(fabsf(hv[j].x), fabsf(hv[j].y)), fmaxf(fabsf(hv[j].z), fabsf(hv[j].w))));
            m = fmaxf(wave_max(m), 1e-30f); const float isc = 127.0f / m;
#pragma unroll
            for (int j = 0; j < 4; ++j) *(GAS unsigned*)(hout_i8 + 4 * lane + 256 * j) = pk4_i8(hv[j].x * isc, hv[j].y * isc, hv[j].z * isc, hv[j].w * isc);
            if (lane == 0) *rs_out = m * (1.0f / 127.0f);
        } else
#pragma unroll
        for (int j = 0; j < 4; ++j) {
            if (hout8) *(GAS unsigned*)(hout8 + 4 * lane + 256 * j) = pk4_fp8(hv[j].x, hv[j].y, hv[j].z, hv[j].w);
            else { v2u w; w.x = pk2(hv[j].x, hv[j].y); w.y = pk2(hv[j].z, hv[j].w); *(GAS v2u*)(hout + 4 * lane + 256 * j) = w; } }
    }
}
DI const GAS float* modp(const Frame& F, int l, int bb, int which) { return (const GAS float*)(F.ws + WS_MOD) + ((size_t)l * 33 + bb) * 6144 + which * 1024; }

DI void route_row(const Frame& F, const LAS float* RT, LAS unsigned* lcount, const f32x4 (&hv)[4], int r) {
                float lg[8];
#pragma unroll
                for (int e = 0; e < 8; ++e) lg[e] = 0.f;
#pragma unroll
                for (int j = 0; j < 4; ++j)
#pragma unroll
                    for (int i = 0; i < 4; ++i) { const LAS float* rp = RT + (4 * F.lane + 256 * j + i) * 8; const f32x4 ra = *(const LAS f32x4*)rp, rb = *(const LAS f32x4*)(rp + 4); const float hx = hv[j][i];
                        lg[0] += hx * ra.x; lg[1] += hx * ra.y; lg[2] += hx * ra.z; lg[3] += hx * ra.w; lg[4] += hx * rb.x; lg[5] += hx * rb.y; lg[6] += hx * rb.z; lg[7] += hx * rb.w; }
#pragma unroll
                for (int e = 0; e < 8; ++e) lg[e] = wave_sum(lg[e]);
                int e0 = 0; float v0 = lg[0];
#pragma unroll
                for (int e = 1; e < 8; ++e) if (lg[e] > v0) { v0 = lg[e]; e0 = e; }
                int e1 = -1; float v1 = -3.0e38f;
#pragma unroll
                for (int e = 0; e < 8; ++e) if (e != e0 && lg[e] > v1) { v1 = lg[e]; e1 = e; }
                if (F.lane == 0) {
                    const float p1 = 1.0f / (1.0f + expf(v0 - v1)), p0 = 1.0f - p1;
                    const int sl = slice_of(r);
                    const unsigned k0 = __hip_atomic_fetch_add(lcount + sl * 8 + e0, 1u, __ATOMIC_RELAXED, __HIP_MEMORY_SCOPE_WORKGROUP), k1 = __hip_atomic_fetch_add(lcount + sl * 8 + e1, 1u, __ATOMIC_RELAXED, __HIP_MEMORY_SCOPE_WORKGROUP);
                    ((GAS i32x2*)(F.ws + WS_RTOP))[r] = (i32x2){e0, e1};
                    ((GAS f32x2*)(F.ws + WS_RPROB))[r] = (f32x2){p0, p1};
                    ((GAS i32x2*)(F.ws + WS_RRANK))[r] = (i32x2){(int)k0, (int)k1};
                }
}
template <int MODE>
DI void rows_phase(const Frame& F0, const Args& A, int l, bool dry = false) {
    const Frame F = fresh(F0);
    GAS bf16* H = (GAS bf16*)(F.ws + WS_H); GAS bf16* CX = (GAS bf16*)(F.ws + WS_CX);
    const bool route = (MODE == 1 && l == 1) && (!dry || F.never);
    const bool st = !dry || F.never;
    LAS unsigned* lcount = (LAS unsigned*)(F.lds + 64);
    LAS unsigned* lbase = (LAS unsigned*)(F.lds + 256);
    LAS float* RT = (LAS float*)(F.lds + 1024);
    if (route) {
        if (F.tid < 32) lcount[F.tid] = 0u;
        for (int i = F.tid; i < 1024 * 8; i += NTHR) RT[i] = ((const GAS float*)A.in[I_ROUTER])[i];
        __syncthreads();
    }
    RowVecs V; f32x4 hv[4];
    for (int r0 = F.gw * 32; r0 < NX; r0 += F.NGW * 32) {
        const int b = r0 >> 11;
        if (MODE == 0) load_rowvecs(V, nullptr, nullptr, ((const GAS float*)A.in[I_MIXPRE]), modp(F, 0, b, 1), modp(F, 0, b, 0), F.lane);
        if (MODE == 1) load_rowvecs(V, modp(F, l, b, 2), ((const GAS float*)A.in[I_MIXPOST]) + l * D, ((const GAS float*)A.in[I_FFNPRE]) + l * D, modp(F, l, b, 4), modp(F, l, b, 3), F.lane);
        if (MODE == 2) load_rowvecs(V, modp(F, 0, b, 5), ((const GAS float*)A.in[I_FFNPOST]), ((const GAS float*)A.in[I_MIXPRE]) + D, modp(F, 1, b, 1), modp(F, 1, b, 0), F.lane);
        const bool toi = (MODE == 0 || MODE == 2 || (MODE == 1 && l == 0)); GAS float* RS = (GAS float*)(F.ws + WS_RS);
        const bool to8 = (MODE == 1 && l == 1); GAS unsigned char* H8 = F.ws + WS_H8;
        const bool xf32 = (MODE == 0 || (MODE == 1 && l == 0));
        const GAS float* xbase = (const GAS float*)A.in[I_X];
#define XIN_F(r) (xf32 ? xbase + (size_t)(r) * D : (const GAS float*)nullptr)
#define XIN_B(r) (xf32 ? (const GAS bf16*)nullptr : (const GAS bf16*)xb_row(F.out, (r)))
        RowData Ra, Rb;
        row_load(Ra, XIN_F(r0), XIN_B(r0), MODE == 0 ? nullptr : H + (size_t)r0 * D, F.lane);
        for (int r = r0; r < r0 + 32; r += 2) {
            row_load(Rb, XIN_F(r + 1), XIN_B(r + 1), MODE == 0 ? nullptr : H + (size_t)(r + 1) * D, F.lane);
            row_compute(Ra, MODE != 0, nullptr, (MODE == 0 || !st) ? nullptr : xb_row(F.out, r), (st && !to8 && !toi) ? H + (size_t)r * D : nullptr, V, F.lane, hv, (st && to8) ? H8 + (size_t)r * D : nullptr, (st && toi) ? (GAS unsigned char*)(H + (size_t)r * D) : nullptr, RS + r);
            if (route) route_row(F, RT, lcount, hv, r);
            if (r + 2 < r0 + 32) row_load(Ra, XIN_F(r + 2), XIN_B(r + 2), MODE == 0 ? nullptr : H + (size_t)(r + 2) * D, F.lane);
            row_compute(Rb, MODE != 0, nullptr, (MODE == 0 || !st) ? nullptr : xb_row(F.out, r + 1), (st && !to8 && !toi) ? H + (size_t)(r + 1) * D : nullptr, V, F.lane, hv, (st && to8) ? H8 + (size_t)(r + 1) * D : nullptr, (st && toi) ? (GAS unsigned char*)(H + (size_t)(r + 1) * D) : nullptr, RS + r + 1);
            if (route) route_row(F, RT, lcount, hv, r + 1);
        }
#undef XIN_F
#undef XIN_B
    }
    if (route) {
        __syncthreads();
        if (F.tid < 32) lbase[F.tid] = __hip_atomic_fetch_add((GAS unsigned*)(F.ws + WS_CTL) + CW_GCOUNT + 64 * F.tid, lcount[F.tid], __ATOMIC_RELAXED, __HIP_MEMORY_SCOPE_AGENT);
        __syncthreads();
        VM_WAIT();
        if (F.lane < 32) {
            for (int r0 = F.gw * 32; r0 < NX; r0 += F.NGW * 32) { const int r = r0 + F.lane; const int sl = slice_of(r); const i32x2 t = ((GAS i32x2*)(F.ws + WS_RTOP))[r]; i32x2 k = ((GAS i32x2*)(F.ws + WS_RRANK))[r];
                    k.x += (int)lbase[sl * 8 + t.x]; k.y += (int)lbase[sl * 8 + t.y]; ((GAS i32x2*)(F.ws + WS_RRANK))[r] = k; }
        }
    }
    if (MODE == 0 || MODE == 2 || (MODE == 1 && l == 0)) {
        if (MODE == 0) load_rowvecs(V, nullptr, nullptr, ((const GAS float*)A.in[I_MIXPRE]), modp(F, 0, 32, 1), modp(F, 0, 32, 0), F.lane);
        if (MODE == 1) load_rowvecs(V, modp(F, 0, 32, 2), ((const GAS float*)A.in[I_MIXPOST]), ((const GAS float*)A.in[I_FFNPRE]), modp(F, 0, 32, 4), modp(F, 0, 32, 3), F.lane);
        if (MODE == 2) load_rowvecs(V, modp(F, 0, 32, 5), ((const GAS float*)A.in[I_FFNPOST]), ((const GAS float*)A.in[I_MIXPRE]) + D, modp(F, 1, 32, 1), modp(F, 1, 32, 0), F.lane);
        const GAS float* cbase = (const GAS float*)A.in[I_CTX];
        for (int r0 = F.gw * 4; r0 < NC; r0 += F.NGW * 4) {
            RowData Rd[4];
#pragma unroll
            for (int i = 0; i < 4; ++i) row_load(Rd[i], cbase + (size_t)(r0 + i) * D, MODE == 2 ? (const GAS bf16*)CX + (size_t)(r0 + i) * D : (const GAS bf16*)nullptr, MODE == 0 ? nullptr : H + (size_t)(NX + r0 + i) * D, F.lane);
#pragma unroll
            for (int i = 0; i < 4; ++i) { const int r = r0 + i;
                row_compute(Rd[i], MODE != 0, nullptr, (MODE == 1 && st) ? CX + (size_t)r * D : nullptr, nullptr, V, F.lane, hv, nullptr,
                            st ? (GAS unsigned char*)(H + (size_t)(NX + r) * D) : nullptr, (GAS float*)(F.ws + WS_RS) + NX + r); }
        }
    }
}

constexpr int SC_CUM = 0, SC_TOT = 32768, SC_VT = 34816, SC_QM = 53248, SC_KM = 70656, SC_QD = 70656, SC_KDT = 88064, SC_AL = 114176, SC_ST = 123392, SC_DEC = 158208, SC_END = 158720;
constexpr int PQ = 272, PV = 144;
static_assert(SC_KDT + 128 * PV <= SC_AL && SC_QD + 64 * PQ <= SC_KDT && SC_KM + 160 * PQ <= SC_AL && SC_AL + 64 * PV <= SC_ST && SC_ST + 128 * PQ <= SC_DEC, "scan LDS map");
DI int scan_row(int b, int dir, int s) { return s < CTX ? NX + b * CTX + (dir ? CTX - 1 - s : s) : b * SEQ + (dir ? SEQ - 1 - (s - CTX) : (s - CTX)); }
DI float ex2(float x) { return __builtin_amdgcn_exp2f(x); }
DI void unpack8(const v4u w, float (&o)[8]) { o[0] = bflo(w.x); o[1] = bfhi(w.x); o[2] = bflo(w.y); o[3] = bfhi(w.y); o[4] = bflo(w.z); o[5] = bfhi(w.z); o[6] = bflo(w.w); o[7] = bfhi(w.w); }
DI v4u pack8(const float (&o)[8]) { v4u w; w.x = pk2(o[0], o[1]); w.y = pk2(o[2], o[3]); w.z = pk2(o[4], o[5]); w.w = pk2(o[6], o[7]); return w; }
DI void scan_phase(const Frame& F0, const Args& A, int l, bool dostore) {
    const Frame F = fresh(F0);
    (void)A;
    GAS bf16* P = (GAS bf16*)(F.ws + WS_P);
    LAS unsigned char* L = F.lds;
    const int tid = F.tid, lane = F.lane, w = F.wave, r = lane & 15, q4 = lane >> 4;
    const float L2E = 1.4426950408889634f;
    for (int ch = blockIdx.x; ch < 256; ch += F.G) {
        const int b = ch >> 3, h = (ch >> 1) & 3, dir = ch & 1;
        const int colq = C_Q + h * DK, colf = C_FF + dir * DH + h * DK, colv = C_V + h * DK;
        __syncthreads();
        for (int i = tid; i < (SC_DEC - SC_AL) / 16; i += NTHR) *(LAS v4u*)(L + SC_AL + 16 * i) = (v4u){0u, 0u, 0u, 0u};
        f32x4 accS[8];
#pragma unroll
        for (int t = 0; t < 8; ++t) accS[t] = (f32x4){0.f, 0.f, 0.f, 0.f};
        v4u qreg[2], lfreg[2]; unsigned vreg[8];
#pragma unroll
        for (int pi = 0; pi < 2; ++pi) { const int i = (tid >> 4) + 32 * pi, k0 = 8 * (tid & 15); const GAS bf16* rp = P + (size_t)scan_row(b, dir, i) * INC + k0;
            qreg[pi] = *(const GAS v4u*)(rp + colq); lfreg[pi] = *(const GAS v4u*)(rp + colf); }
#pragma unroll
        for (int e = 0; e < 8; ++e) vreg[e] = *(const GAS unsigned*)(P + (size_t)scan_row(b, dir, 8 * w + e) * INC + colv + 2 * lane);
        __syncthreads();
#pragma unroll 1
        for (int c = 0; c < (CTX + SEQ) / 64; ++c) {
            float qf[2][8], kk[2][8];
#pragma unroll
            for (int pi = 0; pi < 2; ++pi) { const int i = (tid >> 4) + 32 * pi, k0 = 8 * (tid & 15);
                float lf[8]; unpack8(lfreg[pi], lf); unpack8(qreg[pi], qf[pi]);
#pragma unroll
                for (int e = 0; e < 8; ++e) { lf[e] *= L2E; kk[pi][e] = 1.0f - ex2(lf[e]); }
                *(LAS f32x4*)(L + SC_CUM + (i * 128 + k0) * 4) = (f32x4){lf[0], lf[1], lf[2], lf[3]};
                *(LAS f32x4*)(L + SC_CUM + (i * 128 + k0) * 4 + 16) = (f32x4){lf[4], lf[5], lf[6], lf[7]}; }
            { v4u lo, hi;
              lo.x = (vreg[0] & 0xffffu) | (vreg[1] << 16); lo.y = (vreg[2] & 0xffffu) | (vreg[3] << 16); lo.z = (vreg[4] & 0xffffu) | (vreg[5] << 16); lo.w = (vreg[6] & 0xffffu) | (vreg[7] << 16);
              hi.x = (vreg[0] >> 16) | (vreg[1] & 0xffff0000u); hi.y = (vreg[2] >> 16) | (vreg[3] & 0xffff0000u); hi.z = (vreg[4] >> 16) | (vreg[5] & 0xffff0000u); hi.w = (vreg[6] >> 16) | (vreg[7] & 0xffff0000u);
              *(LAS v4u*)(L + SC_VT + (2 * lane) * PV + 16 * w) = lo; *(LAS v4u*)(L + SC_VT + (2 * lane + 1) * PV + 16 * w) = hi; }
            __syncthreads();
            { const int k = tid & 127, qd = tid >> 7; float run = 0.f;
#pragma unroll
              for (int s2 = 0; s2 < 16; ++s2) { LAS float* cp = (LAS float*)(L + SC_CUM) + (16 * qd + s2) * 128 + k; run += *cp; *cp = run; }
              ((LAS float*)(L + SC_TOT))[qd * 128 + k] = run; }
            __syncthreads();
            { const int k = tid & 127, I = tid >> 7; const LAS float* tp = (const LAS float*)(L + SC_TOT) + k; const LAS float* cm = (const LAS float*)(L + SC_CUM) + 7 * 128 + k;
              const float t0 = tp[0], t1 = tp[128], t2 = tp[256], t3 = tp[384];
              const float p1 = t0, p2 = t0 + t1, p3 = p2 + t2, tt = p3 + t3;
              const float R0 = cm[0], R1 = cm[16 * 128] + p1, R2 = cm[32 * 128] + p2, R3 = cm[48 * 128] + p3;
              const float RI = (I == 0) ? R0 : (I == 1) ? R1 : (I == 2) ? R2 : R3;
              LAS float* QF = (LAS float*)(L + SC_AL); LAS float* FT = QF + 512;
              QF[I * 128 + k] = ex2(RI);
              if (I == 0) { FT[0 * 128 + k] = ex2(R1 - R0); FT[1 * 128 + k] = ex2(R2 - R0); FT[3 * 128 + k] = ex2(R3 - R0); }
              if (I == 1) { FT[2 * 128 + k] = ex2(R2 - R1); FT[4 * 128 + k] = ex2(R3 - R1); }
              if (I == 2) { FT[5 * 128 + k] = ex2(R3 - R2); }
              if (I == 3) ((LAS float*)(L + SC_DEC))[k] = ex2(tt); }
            __syncthreads();
            v4u qdreg[2];
#pragma unroll
            for (int pi = 0; pi < 2; ++pi) { const int i = (tid >> 4) + 32 * pi, k0 = 8 * (tid & 15), I = i >> 4;
                float cl[8], cmid[8], qm[8], km[8], o8[8];
                { const f32x4 a = *(const LAS f32x4*)(L + SC_CUM + (i * 128 + k0) * 4), bq = *(const LAS f32x4*)(L + SC_CUM + (i * 128 + k0) * 4 + 16);
                  cl[0] = a.x; cl[1] = a.y; cl[2] = a.z; cl[3] = a.w; cl[4] = bq.x; cl[5] = bq.y; cl[6] = bq.z; cl[7] = bq.w; }
                { const f32x4 a = *(const LAS f32x4*)(L + SC_CUM + ((16 * I + 7) * 128 + k0) * 4), bq = *(const LAS f32x4*)(L + SC_CUM + ((16 * I + 7) * 128 + k0) * 4 + 16);
                  cmid[0] = a.x; cmid[1] = a.y; cmid[2] = a.z; cmid[3] = a.w; cmid[4] = bq.x; cmid[5] = bq.y; cmid[6] = bq.z; cmid[7] = bq.w; }
#pragma unroll
                for (int e = 0; e < 8; ++e) { const float dlt = cl[e] - cmid[e]; qm[e] = qf[pi][e] * ex2(fminf(dlt, 86.f)); km[e] = kk[pi][e] * ex2(fminf(-dlt, 86.f)); }
                *(LAS v4u*)(L + SC_QM + i * PQ + 2 * k0) = pack8(qm);
                *(LAS v4u*)(L + SC_KM + (8 * I * (I + 1) + i) * PQ + 2 * k0) = pack8(km);
                { const f32x4 a = *(const LAS f32x4*)(L + SC_AL + (I * 128 + k0) * 4), bq = *(const LAS f32x4*)(L + SC_AL + (I * 128 + k0) * 4 + 16);
                  o8[0] = qm[0] * a.x; o8[1] = qm[1] * a.y; o8[2] = qm[2] * a.z; o8[3] = qm[3] * a.w; o8[4] = qm[4] * bq.x; o8[5] = qm[5] * bq.y; o8[6] = qm[6] * bq.z; o8[7] = qm[7] * bq.w; }
                qdreg[pi] = pack8(o8);
#pragma unroll
                for (int Ip = 1; Ip < 4; ++Ip) if (Ip > I) { const int pr = Ip * (Ip - 1) / 2 + I;
                    const f32x4 a = *(const LAS f32x4*)(L + SC_AL + 2048 + (pr * 128 + k0) * 4), bq = *(const LAS f32x4*)(L + SC_AL + 2048 + (pr * 128 + k0) * 4 + 16);
                    o8[0] = km[0] * a.x; o8[1] = km[1] * a.y; o8[2] = km[2] * a.z; o8[3] = km[3] * a.w; o8[4] = km[4] * bq.x; o8[5] = km[5] * bq.y; o8[6] = km[6] * bq.z; o8[7] = km[7] * bq.w;
                    *(LAS v4u*)(L + SC_KM + (8 * Ip * (Ip + 1) + i) * PQ + 2 * k0) = pack8(o8); } }
            __syncthreads();
            if (c + 1 < (CTX + SEQ) / 64) {
#pragma unroll
                for (int pi = 0; pi < 2; ++pi) { const int i = (tid >> 4) + 32 * pi, k0 = 8 * (tid & 15); const GAS bf16* rp = P + (size_t)scan_row(b, dir, 64 * (c + 1) + i) * INC + k0;
                    qreg[pi] = *(const GAS v4u*)(rp + colq); lfreg[pi] = *(const GAS v4u*)(rp + colf); }
#pragma unroll
                for (int e = 0; e < 8; ++e) vreg[e] = *(const GAS unsigned*)(P + (size_t)scan_row(b, dir, 64 * (c + 1) + 8 * w + e) * INC + colv + 2 * lane);
            }
#pragma unroll 1
            for (int bl = w; bl < 10; bl += 8) {
                const int I = (bl >= 6) ? 3 : (bl >= 3) ? 2 : (bl >= 1) ? 1 : 0, J = bl - I * (I + 1) / 2;
                f32x4 acc = (f32x4){0.f, 0.f, 0.f, 0.f};
#pragma unroll
                for (int ks = 0; ks < 4; ++ks) { const bf16x8 a = *(const LAS bf16x8*)(L + SC_QM + (16 * I + r) * PQ + 64 * ks + 16 * q4);
                    const bf16x8 bb = *(const LAS bf16x8*)(L + SC_KM + (8 * I * (I + 1) + 16 * J + r) * PQ + 64 * ks + 16 * q4);
                    acc = __builtin_amdgcn_mfma_f32_16x16x32_bf16(a, bb, acc, 0, 0, 0); }
#pragma unroll
                for (int jj = 0; jj < 4; ++jj) { float x = acc[jj]; if (I == J && r > 4 * q4 + jj) x = 0.f;
                    *(LAS bf16*)(L + SC_AL + (16 * I + 4 * q4 + jj) * PV + 2 * (16 * J + r)) = (bf16)(pk2(x, 0.f) & 0xffffu); }
            }
            if (w == 2 || w == 3) { const int I = (w == 2) ? 0 : 2, J = I + 1;
#pragma unroll
                for (int jj = 0; jj < 4; ++jj) *(LAS bf16*)(L + SC_AL + (16 * I + 4 * q4 + jj) * PV + 2 * (16 * J + r)) = (bf16)0; }
            __syncthreads();
#pragma unroll
            for (int pi = 0; pi < 2; ++pi) { const int i = (tid >> 4) + 32 * pi, k0 = 8 * (tid & 15); *(LAS v4u*)(L + SC_QD + i * PQ + 2 * k0) = qdreg[pi]; }
            { const int k = tid & 127, qd = tid >> 7; const LAS float* tp = (const LAS float*)(L + SC_TOT) + k;
              const float t1 = tp[128], t2 = tp[256], t3 = tp[384];
              const float rest = (qd == 0) ? (t1 + t2) + t3 : (qd == 1) ? t2 + t3 : (qd == 2) ? t3 : 0.f;
              float cl[16], kd[16];
#pragma unroll
              for (int s2 = 0; s2 < 16; ++s2) cl[s2] = ((const LAS float*)(L + SC_CUM))[(16 * qd + s2) * 128 + k];
              float g = ex2(fminf(rest, 0.f));
#pragma unroll
              for (int s2 = 15; s2 >= 0; --s2) { const float f = ex2(cl[s2] - (s2 ? cl[s2 - 1] : 0.f)); kd[s2] = (1.0f - f) * g; g *= f; }
              v4u w0, w1; w0.x = pk2(kd[0], kd[1]); w0.y = pk2(kd[2], kd[3]); w0.z = pk2(kd[4], kd[5]); w0.w = pk2(kd[6], kd[7]);
              w1.x = pk2(kd[8], kd[9]); w1.y = pk2(kd[10], kd[11]); w1.z = pk2(kd[12], kd[13]); w1.w = pk2(kd[14], kd[15]);
              *(LAS v4u*)(L + SC_KDT + k * PV + 32 * qd) = w0; *(LAS v4u*)(L + SC_KDT + k * PV + 32 * qd + 16) = w1; }
            __syncthreads();
            { const int ip = w & 1, vp = w >> 1;
              f32x4 acc[2][2];
#pragma unroll
              for (int ii = 0; ii < 2; ++ii)
#pragma unroll
                  for (int tt = 0; tt < 2; ++tt) acc[ii][tt] = (f32x4){0.f, 0.f, 0.f, 0.f};
#pragma unroll
              for (int ks = 0; ks < 4; ++ks) { bf16x8 bq[2], a[2];
#pragma unroll
                  for (int ii = 0; ii < 2; ++ii) bq[ii] = *(const LAS bf16x8*)(L + SC_QD + (16 * (2 * ip + ii) + r) * PQ + 64 * ks + 16 * q4);
#pragma unroll
                  for (int tt = 0; tt < 2; ++tt) a[tt] = *(const LAS bf16x8*)(L + SC_ST + (16 * (2 * vp + tt) + r) * PQ + 64 * ks + 16 * q4);
#pragma unroll
                  for (int ii = 0; ii < 2; ++ii)
#pragma unroll
                      for (int tt = 0; tt < 2; ++tt) acc[ii][tt] = __builtin_amdgcn_mfma_f32_16x16x32_bf16(a[tt], bq[ii], acc[ii][tt], 0, 0, 0); }
#pragma unroll
              for (int js = 0; js < 2; ++js) if (js == 0 || ip == 1) { bf16x8 bA[2], a[2];
#pragma unroll
                  for (int ii = 0; ii < 2; ++ii) bA[ii] = *(const LAS bf16x8*)(L + SC_AL + (16 * (2 * ip + ii) + r) * PV + 64 * js + 16 * q4);
#pragma unroll
                  for (int tt = 0; tt < 2; ++tt) a[tt] = *(const LAS bf16x8*)(L + SC_VT + (16 * (2 * vp + tt) + r) * PV + 64 * js + 16 * q4);
#pragma unroll
                  for (int ii = 0; ii < 2; ++ii)
#pragma unroll
                      for (int tt = 0; tt < 2; ++tt) acc[ii][tt] = __builtin_amdgcn_mfma_f32_16x16x32_bf16(a[tt], bA[ii], acc[ii][tt], 0, 0, 0); }
              if (dostore && !(l == 1 && c < CTX / 64)) {
#pragma unroll
                  for (int ii = 0; ii < 2; ++ii) { GAS bf16* op = P + (size_t)scan_row(b, dir, 64 * c + 16 * (2 * ip + ii) + r) * INC + colf + 4 * q4;
#pragma unroll
                      for (int tt = 0; tt < 2; ++tt) { v2u o2; o2.x = pk2(acc[ii][tt][0], acc[ii][tt][1]); o2.y = pk2(acc[ii][tt][2], acc[ii][tt][3]); *(GAS v2u*)(op + 16 * (2 * vp + tt)) = o2; } }
              }
              const int kp = w >> 1, vh = w & 1;
#pragma unroll
              for (int kk = 0; kk < 2; ++kk) { const f32x4 dv = *(const LAS f32x4*)(L + SC_DEC + (16 * (2 * kp + kk) + 4 * q4) * 4);
#pragma unroll
                  for (int t4 = 0; t4 < 4; ++t4) accS[kk * 4 + t4] *= dv; }
#pragma unroll
              for (int js = 0; js < 2; ++js) { bf16x8 a[2], bv[4];
#pragma unroll
                  for (int kk = 0; kk < 2; ++kk) a[kk] = *(const LAS bf16x8*)(L + SC_KDT + (16 * (2 * kp + kk) + r) * PV + 64 * js + 16 * q4);
#pragma unroll
                  for (int t4 = 0; t4 < 4; ++t4) bv[t4] = *(const LAS bf16x8*)(L + SC_VT + (16 * (4 * vh + t4) + r) * PV + 64 * js + 16 * q4);
#pragma unroll
                  for (int kk = 0; kk < 2; ++kk)
#pragma unroll
                      for (int t4 = 0; t4 < 4; ++t4) accS[kk * 4 + t4] = __builtin_amdgcn_mfma_f32_16x16x32_bf16(a[kk], bv[t4], accS[kk * 4 + t4], 0, 0, 0); }
            }
            __syncthreads();
            { const int kp = w >> 1, vh = w & 1;
#pragma unroll
              for (int kk = 0; kk < 2; ++kk)
#pragma unroll
                  for (int t4 = 0; t4 < 4; ++t4) { const f32x4 sv = accS[kk * 4 + t4]; v2u s2; s2.x = pk2(sv[0], sv[1]); s2.y = pk2(sv[2], sv[3]);
                      *(LAS v2u*)(L + SC_ST + (16 * (4 * vh + t4) + r) * PQ + 2 * (16 * (2 * kp + kk) + 4 * q4)) = s2; } }
        }
    }
    __syncthreads();
}

DI void post_phase(const Frame& F0, const Args& A, int l, int part = 3, bool dry = false) {
    const Frame F = fresh(F0);
    GAS bf16* P = (GAS bf16*)(F.ws + WS_P);
    const int nrows = (l == 0) ? MALL : NX;
    if (part & 1) {
        const GAS float* gp = ((const GAS float*)A.in[I_GAIN]) + l * DH + 8 * F.lane;
        const f32x4 ga = *(const GAS f32x4*)gp, gb = *(const GAS f32x4*)(gp + 4);
        const float gn[8] = {ga.x, ga.y, ga.z, ga.w, gb.x, gb.y, gb.z, gb.w};
        v4u cur[6], nxt[6];
        if (F.gw < nrows) { const int r = F.gw; const bool two = (r + F.NGW) < nrows;
            const GAS bf16* q0 = P + (size_t)r * INC + 8 * F.lane; const GAS bf16* q1 = P + (size_t)(two ? r + F.NGW : r) * INC + 8 * F.lane;
            cur[0] = *(const GAS v4u*)(q0 + C_FF); cur[1] = *(const GAS v4u*)(q0 + C_FB); cur[2] = *(const GAS v4u*)(q0 + C_G);
            cur[3] = *(const GAS v4u*)(q1 + C_FF); cur[4] = *(const GAS v4u*)(q1 + C_FB); cur[5] = *(const GAS v4u*)(q1 + C_G); }
        for (int r = F.gw; r < nrows; r += 2 * F.NGW) {
            const bool two = (r + F.NGW) < nrows;
            GAS bf16* rp0 = P + (size_t)r * INC + 8 * F.lane; GAS bf16* rp1 = P + (size_t)(two ? r + F.NGW : r) * INC + 8 * F.lane;
            { const int rn = r + 2 * F.NGW;
              if (rn < nrows) { const bool twon = (rn + F.NGW) < nrows;
                  const GAS bf16* q0 = P + (size_t)rn * INC + 8 * F.lane; const GAS bf16* q1 = P + (size_t)(twon ? rn + F.NGW : rn) * INC + 8 * F.lane;
                  nxt[0] = *(const GAS v4u*)(q0 + C_FF); nxt[1] = *(const GAS v4u*)(q0 + C_FB); nxt[2] = *(const GAS v4u*)(q0 + C_G);
                  nxt[3] = *(const GAS v4u*)(q1 + C_FF); nxt[4] = *(const GAS v4u*)(q1 + C_FB); nxt[5] = *(const GAS v4u*)(q1 + C_G); } }
#pragma unroll
            for (int half = 0; half < 2; ++half) {
                if (half == 1 && !two) break;
                const v4u a = cur[3 * half], bq = cur[3 * half + 1], g = cur[3 * half + 2]; GAS bf16* rp = half ? rp1 : rp0;
                float o[8] = {bflo(a.x) + bflo(bq.x), bfhi(a.x) + bfhi(bq.x), bflo(a.y) + bflo(bq.y), bfhi(a.y) + bfhi(bq.y), bflo(a.z) + bflo(bq.z), bfhi(a.z) + bfhi(bq.z), bflo(a.w) + bflo(bq.w), bfhi(a.w) + bfhi(bq.w)};
                const float sg[8] = {bflo(g.x), bfhi(g.x), bflo(g.y), bfhi(g.y), bflo(g.z), bfhi(g.z), bflo(g.w), bfhi(g.w)};
                float ss = 0.f;
#pragma unroll
                for (int j = 0; j < 8; ++j) ss += o[j] * o[j];
                ss += __shfl_xor(ss, 1); ss += __shfl_xor(ss, 2); ss += __shfl_xor(ss, 4); ss += __shfl_xor(ss, 8);
                const float rr = 1.0f / sqrtf(ss * (1.0f / DK) + EPS);
#pragma unroll
                for (int j = 0; j < 8; ++j) o[j] = o[j] * rr * gn[j] * sg[j];
                v4u w; w.x = pk2(o[0], o[1]); w.y = pk2(o[2], o[3]); w.z = pk2(o[4], o[5]); w.w = pk2(o[6], o[7]);
                if (!dry || F.never) *(GAS v4u*)(rp + C_FF) = w;
            }
#pragma unroll
            for (int i = 0; i < 6; ++i) cur[i] = nxt[i];
        }
    }
    if (!(part & 2)) return;
    constexpr int PP = 520;
    LAS unsigned* U = (LAS unsigned*)F.lds;
    LAS unsigned* Vs = U + 32 * PP;
    v4u pre[8];
    { const int un = blockIdx.x;
      if (un < BATCH * 32) {
#pragma unroll
          for (int i = 0; i < 4; ++i) { const int t = F.tid + 512 * i; const GAS bf16* gp = P + (size_t)((un >> 5) * SEQ + t) * INC + C_U + (un & 31) * 16;
              pre[2 * i] = *(const GAS v4u*)gp; pre[2 * i + 1] = *(const GAS v4u*)(gp + 8); } } }
    REP(4) for (int un = blockIdx.x; un < BATCH * 32; un += F.G) {
        const int b = un >> 5, hx = un & 31, w = 2 << (hx >> 3), hw = w >> 1;
        __syncthreads();
#pragma unroll
        for (int i = 0; i < 4; ++i) { const int t = F.tid + 512 * i, gy = t >> 6, gx = t & 63;
            *(LAS v4u*)(U + gy * PP + gx * 8) = pre[2 * i]; *(LAS v4u*)(U + gy * PP + gx * 8 + 4) = pre[2 * i + 1]; }
        __syncthreads();
        { const int un2 = un + F.G;
          if (un2 < BATCH * 32) {
#pragma unroll
              for (int i = 0; i < 4; ++i) { const int t = F.tid + 512 * i; const GAS bf16* gp = P + (size_t)((un2 >> 5) * SEQ + t) * INC + C_U + (un2 & 31) * 16;
                  pre[2 * i] = *(const GAS v4u*)gp; pre[2 * i + 1] = *(const GAS v4u*)(gp + 8); } } }
        { float s0 = 0.f, s1 = 0.f;
          for (int y = 0; y < hw; ++y) { const unsigned u = U[y * PP + F.tid]; s0 += bflo(u); s1 += bfhi(u); }
#pragma unroll 4
          for (int gy = 0; gy < 32; ++gy) {
              Vs[gy * PP + F.tid] = pk2(s0, s1);
              if (gy + hw < 32) { const unsigned u = U[(gy + hw) * PP + F.tid]; s0 += bflo(u); s1 += bfhi(u); }
              if (gy - hw >= 0) { const unsigned u = U[(gy - hw) * PP + F.tid]; s0 -= bflo(u); s1 -= bfhi(u); }
          } }
        __syncthreads();
        { const int c4 = F.lane & 3, gy = (F.wave & 1) * 16 + (F.lane >> 2), x0 = (F.wave >> 1) * 16;
          const int cy = min(gy + hw, 32) - max(gy - hw, 0);
          const LAS unsigned* vr = Vs + gy * PP + c4 * 2; LAS unsigned* ur = U + gy * PP + c4 * 2;
          float s[4] = {0.f, 0.f, 0.f, 0.f};
          for (int x = max(x0 - hw, 0); x < min(x0 + hw, 64); ++x) { const v2u q = *(const LAS v2u*)(vr + x * 8); s[0] += bflo(q.x); s[1] += bfhi(q.x); s[2] += bflo(q.y); s[3] += bfhi(q.y); }
#pragma unroll 4
          for (int gx = x0; gx < x0 + 16; ++gx) {
              const int cx = min(gx + hw, 64) - max(gx - hw, 0);
              const float inv = __builtin_amdgcn_rcpf((float)(cy * cx));
              const v2u uc = *(const LAS v2u*)(ur + gx * 8);
              v2u o; o.x = pk2(s[0] * inv - bflo(uc.x), s[1] * inv - bfhi(uc.x)); o.y = pk2(s[2] * inv - bflo(uc.y), s[3] * inv - bfhi(uc.y));
              *(LAS v2u*)(ur + gx * 8) = o;
              if (gx + hw < 64) { const v2u q = *(const LAS v2u*)(vr + (gx + hw) * 8); s[0] += bflo(q.x); s[1] += bfhi(q.x); s[2] += bflo(q.y); s[3] += bfhi(q.y); }
              if (gx - hw >= 0) { const v2u q = *(const LAS v2u*)(vr + (gx - hw) * 8); s[0] -= bflo(q.x); s[1] -= bfhi(q.x); s[2] -= bflo(q.y); s[3] -= bfhi(q.y); }
          } }
        __syncthreads();
#pragma unroll
        for (int i = 0; i < 4; ++i) { const int t = F.tid + 512 * i, gy = t >> 6, gx = t & 63;
            const v4u q0 = *(const LAS v4u*)(U + gy * PP + gx * 8), q1 = *(const LAS v4u*)(U + gy * PP + gx * 8 + 4);
            GAS bf16* op = P + (size_t)(b * SEQ + t) * INC + C_Q + hx * 16;
            *(GAS v4u*)op = q0; *(GAS v4u*)(op + 8) = q1; }
    }
    __syncthreads();
    if (l == 0) { LAS unsigned char* Uc = F.lds;
        for (int un = blockIdx.x; un < BATCH * 32; un += F.G) {
            const int b = un >> 5, hx = un & 31, w = 2 << (hx >> 3), hw = w >> 1;
            __syncthreads();
            if (F.tid < CTX) { const GAS bf16* gp = P + (size_t)(NX + b * CTX + F.tid) * INC + C_U + hx * 16;
                const v4u q0 = *(const GAS v4u*)gp, q1 = *(const GAS v4u*)(gp + 8);
                *(LAS v4u*)(Uc + F.tid * 32) = q0; *(LAS v4u*)(Uc + F.tid * 32 + 16) = q1; }
            __syncthreads();
            if (F.tid < CTX) { const int t = F.tid, t0 = max(t - hw, 0), t1 = min(t - hw + w, CTX);
                float a[16];
#pragma unroll
                for (int j = 0; j < 16; ++j) a[j] = 0.f;
                for (int s2 = t0; s2 < t1; ++s2) { float v0[8], v1[8]; unpack8(*(const LAS v4u*)(Uc + s2 * 32), v0); unpack8(*(const LAS v4u*)(Uc + s2 * 32 + 16), v1);
#pragma unroll
                    for (int j = 0; j < 8; ++j) { a[j] += v0[j]; a[8 + j] += v1[j]; } }
                const float inv = 1.0f / (float)(t1 - t0);
                float u0[8], u1[8]; unpack8(*(const LAS v4u*)(Uc + t * 32), u0); unpack8(*(const LAS v4u*)(Uc + t * 32 + 16), u1);
                float lo[8], hi[8];
#pragma unroll
                for (int j = 0; j < 8; ++j) { lo[j] = a[j] * inv - u0[j]; hi[j] = a[8 + j] * inv - u1[j]; }
                GAS bf16* op = P + (size_t)(NX + b * CTX + t) * INC + C_Q + hx * 16;
                *(GAS v4u*)op = pack8(lo); *(GAS v4u*)(op + 8) = pack8(hi); }
        }
    }
    __syncthreads();
}

DI void slice_offsets(const Frame& F, int s, int (&toff)[9]) {
    const GAS unsigned* gc = (const GAS unsigned*)(F.ws + WS_CTL) + CW_GCOUNT;
    int acc = 0;
#pragma unroll
    for (int e = 0; e < 8; ++e) { toff[e] = acc; const unsigned c = __builtin_amdgcn_readfirstlane(__hip_atomic_load(gc + 64 * (s * 8 + e), __ATOMIC_RELAXED, __HIP_MEMORY_SCOPE_AGENT)); acc += (int)((c + 255u) >> 8); }
    toff[8] = acc < SLICE_ROWS / 256 ? acc : SLICE_ROWS / 256;
}
DI void gather_phase(const Frame& F0, const Args& A, int s) {
    const Frame F = fresh(F0);
    (void)A;
    int toff[9]; slice_offsets(F, s, toff);
    const GAS unsigned char* H8 = F.ws + WS_H8; GAS unsigned char* AS = F.ws + WS_AS; GAS float* RG = (GAS float*)(F.ws + WS_RGATE);
    const int rend = slice_start(s + 1);
    int r = slice_start(s) + F.gw;
    i32x2 t = {0, 0}, k = {0, 0}; v4u a = {0u, 0u, 0u, 0u};
    if (r < rend) { t = ((const GAS i32x2*)(F.ws + WS_RTOP))[r]; k = ((const GAS i32x2*)(F.ws + WS_RRANK))[r]; a = *(const GAS v4u*)(H8 + (size_t)r * D + 16 * F.lane); }
    for (; r < rend; r += F.NGW) {
        const int rn = r + F.NGW;
        i32x2 tn = t, kn = k; v4u an = a;
        if (rn < rend) { tn = ((const GAS i32x2*)(F.ws + WS_RTOP))[rn]; kn = ((const GAS i32x2*)(F.ws + WS_RRANK))[rn]; an = *(const GAS v4u*)(H8 + (size_t)rn * D + 16 * F.lane); }
        int p0 = k.x, p1 = k.y;
#pragma unroll
        for (int e = 0; e < 8; ++e) { if (t.x == e) p0 += toff[e] * 256; if (t.y == e) p1 += toff[e] * 256; }
        p0 = min(max(p0, 0), SLICE_ROWS - 1); p1 = min(max(p1, 0), SLICE_ROWS - 1);
        *(GAS v4u*)(AS + (size_t)p0 * D + 16 * F.lane) = a;
        *(GAS v4u*)(AS + (size_t)p1 * D + 16 * F.lane) = a;
        if (F.lane == 0) ((GAS i32x2*)(F.ws + WS_RPOS))[r] = (i32x2){p0, p1};
        t = tn; k = kn; a = an;
    }
    (void)RG;
}
DI void combine_phase(const Frame& F0, const Args& A, int s, bool dry = false) {
    const Frame F = fresh(F0);
    const GAS bf16* YS = (const GAS bf16*)(F.ws + WS_YS);
    RowVecs V; f32x4 hv[4];
    for (int r0 = slice_start(s) + F.gw * 8; r0 < slice_start(s + 1); r0 += F.NGW * 8) {
        const int b = r0 >> 11;
        load_rowvecs(V, modp(F, 1, b, 5), ((const GAS float*)A.in[I_FFNPOST]) + D, nullptr, nullptr, nullptr, F.lane);
        for (int r = r0; r < r0 + 8; ++r) {
            const i32x2 pp = ((const GAS i32x2*)(F.ws + WS_RPOS))[r]; const f32x2 pr = ((const GAS f32x2*)(F.ws + WS_RPROB))[r];
            GAS float* xr = F.out + (size_t)r * D;
            f32x4 yv[4]; float ss = 0.f;
#pragma unroll
            for (int j = 0; j < 4; ++j) { const v2u w0 = *(const GAS v2u*)(YS + (size_t)pp.x * D + 4 * F.lane + 256 * j), w1 = *(const GAS v2u*)(YS + (size_t)pp.y * D + 4 * F.lane + 256 * j);
                yv[j] = (f32x4){bflo(w0.x) * pr.x + bflo(w1.x) * pr.y, bfhi(w0.x) * pr.x + bfhi(w1.x) * pr.y, bflo(w0.y) * pr.x + bflo(w1.y) * pr.y, bfhi(w0.y) * pr.x + bfhi(w1.y) * pr.y};
                ss += (yv[j].x * yv[j].x + yv[j].y * yv[j].y) + (yv[j].z * yv[j].z + yv[j].w * yv[j].w); }
            const float rr = 1.0f / sqrtf(wave_sum(ss) * (1.0f / D) + EPS);
            f32x4 xv[4];
#pragma unroll
            for (int j = 0; j < 4; ++j) { const v2u w = *(const GAS v2u*)(xb_row(F.out, r) + 4 * F.lane + 256 * j); xv[j] = (f32x4){bflo(w.x), bfhi(w.x), bflo(w.y), bfhi(w.y)}; }
            VM_WAIT();
#pragma unroll
            for (int j = 0; j < 4; ++j) { const f32x4 x = xv[j] + V.a1[j] * (yv[j] * rr); if (!dry || F.never) *(GAS f32x4*)(xr + 4 * F.lane + 256 * j) = x; }
        }
    }
    (void)hv;
}

__global__ void __launch_bounds__(NTHR, 2) mk_fwd(Args args) {
    extern __shared__ __attribute__((aligned(16))) unsigned char lds_raw[];
    Frame F;
    F.lds = (LAS unsigned char*)lds_raw;
    F.tid = threadIdx.x; F.lane = F.tid & 63; F.wave = __builtin_amdgcn_readfirstlane(F.tid >> 6);
    F.G = gridDim.x; F.gw = blockIdx.x * NWAVES + F.wave; F.NGW = F.G * NWAVES; F.never = args.ph_lo < 0;
    F.out = (GAS float*)args.out; F.ws = (GAS unsigned char*)args.ws;
    volatile LAS unsigned* MISC = (volatile LAS unsigned*)(F.lds + MISC_OFF);
    if (F.tid < 16) MISC[F.tid] = 0u;
    __syncthreads();
    XcdBarrier bar; bar.bar = (unsigned*)(F.ws + WS_CTL) + CW_BAR; bar.x = 0; bar.st = nullptr;
    if (!MK_PER_PHASE) bar = xcd_barrier_post((unsigned*)(F.ws + WS_CTL) + CW_BAR, MISC + 8);
    const int lo = args.ph_lo, hi = args.ph_hi;
    int seq = 0;
#ifndef PHASE_MASK
#define PHASE_MASK 0xffff
#endif
#define EN(k) (((PHASE_MASK) >> (k)) & 1)
#define PH_ON() (lo <= seq && seq < hi)
#define PH_END() do { if (lo <= seq && seq + 1 < hi) { if (!MK_PER_PHASE) { xcd_barrier(bar); if (((DUP_MASK) >> 16) & 1) xcd_barrier(bar); } } ++seq; } while (0)
    LAS unsigned char* ring = F.lds;
#define SITE_PTRS() GAS unsigned char* ws = F.ws; asm volatile("" : "+s"(ws)); GAS bf16* P = (GAS bf16*)(ws + WS_P); GAS bf16* H = (GAS bf16*)(ws + WS_H); (void)P; (void)H

    if (PH_ON() && EN(0)) REP(0) p0_prologue(F, args);
    PH_END();
    if (PH_ON() && EN(1)) { REP(1) rows_phase<0>(F, args, 0); __syncthreads(); win_to_i8(F, args); }
    PH_END();
    for (int l = 0; l < 2; ++l) {
        const int nM = (l == 0) ? MALL / 256 : NX / 256;
        if (PH_ON() && EN(2)) { SITE_PTRS();
            pg8::Gemm g{H, (const GAS bf16*)(ws + WS_WIN + (size_t)l * INC * D), D, D / 2, D / 2};
            pg8::InSched S; S.G = F.G; S.c = (int)blockIdx.x; S.last = (l == 1);
            LAS float* cml = (LAS float*)(F.lds + 131072);
            { int t2 = F.tid; asm volatile("" : "+v"(t2)); const GAS float* cg = (const GAS float*)(ws + WS_CTL) + CW_CMAX_IN + l * INC; for (int i = t2; i < INC; i += NTHR) cml[i] = cg[i]; }
            __syncthreads();
            if (l == 0) { pg8::EpiIn<true> E{P, (const GAS float*)(ws + WS_LB), (const GAS float*)(ws + WS_RS), cml};
                REP(2) pg8::gemm_phase<pg8::EpiIn<true>, pg8::InSched, false, 127, true>(ring, g, S, E); }
            else { pg8::EpiIn<false> E{P, (const GAS float*)(ws + WS_LB) + 2 * DH, (const GAS float*)(ws + WS_RS), cml};
                REP(2) pg8::gemm_phase<pg8::EpiIn<false>, pg8::InSched, false, 127, true>(ring, g, S, E); }
            if (l == 0) moe_weight_convert(F, args, MOE_C1, MOE_C1 + MOE_C2, F.G / 2);
        }
        PH_END();
        if (PH_ON() && EN(3)) { if ((DUP_MASK >> 3) & 1) scan_phase(F, args, l, false); scan_phase(F, args, l, true); }
        PH_END();
        if (PH_ON() && EN(4)) { if ((DUP_MASK >> 17) & 1) post_phase(F, args, l, 1, true); post_phase(F, args, l); }
        PH_END();
        if (PH_ON() && EN(6)) { SITE_PTRS();
            { pg8::Gemm g{P + C_FF, (const GAS bf16*)(ws + WS_WR) + (size_t)l * D * DH, INC, DH, DH};
              pg8::StaticSched S; S.init(nM, D / 256, F.G, (int)blockIdx.x, 0);
              pg8::EpiRow<1> E{P + C_GA, INC, nullptr, 0};
              REP(6) pg8::gemm_phase(ring, g, S, E); }
            { pg8::Gemm g{P + C_Q, (const GAS bf16*)(ws + WS_WP) + (size_t)l * D * DH, INC, DH, DH};
              pg8::StaticSched S; S.init(nM, D / 256, F.G, (int)blockIdx.x, 0);
              pg8::EpiRow<2> E{P + C_GA, INC, nullptr, C_GB - C_GA};
              REP(6) pg8::gemm_phase(ring, g, S, E); }
        }
        PH_END();
        if (PH_ON() && EN(7)) { SITE_PTRS();
            pg8::Gemm g{P + C_GA, (const GAS bf16*)(ws + WS_WO) + (size_t)l * D * D, INC, D, D};
            pg8::StaticSched S; S.init(nM, D / 256, F.G, (int)blockIdx.x, 0);
            pg8::EpiRow<0> E{H, D, nullptr, 0};
            REP(7) pg8::gemm_phase(ring, g, S, E);
        }
        PH_END();
        if (PH_ON() && EN(8)) { if ((DUP_MASK >> 8) & 1) rows_phase<1>(F, args, l, true); rows_phase<1>(F, args, l); if (l == 1) { __syncthreads(); moe_weight_convert(F, args, MOE_C1 + MOE_C2, MOE_CONV_ITEMS, 0); } }
        PH_END();
        if (l == 0) {
            if (PH_ON() && EN(9)) { SITE_PTRS();
                pg8::Gemm g{H, (const GAS bf16*)(ws + WS_WGU), D, D / 2, D / 2};
                pg8::StaticSched S; S.init(MALL / 256, 2 * DFF / 256, F.G, (int)blockIdx.x, 0);
                LAS float* cmgl = (LAS float*)(F.lds + 131072); LAS float* cmul = cmgl + DFF;
                { int t2 = F.tid; asm volatile("" : "+v"(t2)); const GAS float* cg = (const GAS float*)(ws + WS_CTL) + CW_CMAX_FG; const GAS float* cu = (const GAS float*)(ws + WS_CTL) + CW_CMAX_FU;
                  for (int i = t2; i < DFF; i += NTHR) { cmgl[i] = cg[i]; cmul[i] = cu[i]; } }
                __syncthreads();
                pg8::EpiSwiGLU<true> E{(GAS bf16*)(ws + WS_HH0), DFF, nullptr, (const GAS float*)(ws + WS_RS), cmgl, cmul};
                REP(9) pg8::gemm_phase<pg8::EpiSwiGLU<true>, pg8::StaticSched, false, 127, true>(ring, g, S, E);
            }
            PH_END();
            if (PH_ON() && EN(10)) { SITE_PTRS();
                pg8::Gemm g{(const GAS bf16*)(ws + WS_HH0), (const GAS bf16*)(ws + WS_WD), DFF / 2, DFF / 2, DFF / 2};
                pg8::StaticSched S; S.init(MALL / 256, D / 256, F.G, (int)blockIdx.x, 0);
                pg8::EpiRow<0> E{H, D, nullptr, 0};
                REP(10) pg8::gemm_phase<pg8::EpiRow<0>, pg8::StaticSched, true, 121>(ring, g, S, E);
                moe_weight_convert(F, args, 0, MOE_C1, F.G / 2);
            }
            PH_END();
            if (PH_ON() && EN(11)) { if ((DUP_MASK >> 11) & 1) rows_phase<2>(F, args, 0, true); rows_phase<2>(F, args, 0); }
            PH_END();
        } else {
            if (PH_ON() && EN(12)) gather_phase(F, args, 0);
            PH_END();
            for (int s = 0; s < NSLICE; ++s) {
                if (PH_ON() && EN(13)) { SITE_PTRS();
                    pg8::MoeSched S; S.G = F.G; S.c = (int)blockIdx.x; S.nN = 2 * DEX / 256; S.nrow_e = 2 * DEX; slice_offsets(F, s, S.toff); S.nM = S.toff[8];
                    pg8::Gemm g{(const GAS bf16*)(ws + WS_AS), (const GAS bf16*)(ws + WS_MGU), D / 2, D / 2, D / 2};
                    pg8::EpiSwiGLU8 E{ws + WS_HHS, DEX, nullptr};
                    REP(13) pg8::gemm_phase<pg8::EpiSwiGLU8, pg8::MoeSched, true, 122>(ring, g, S, E);
                    if (s > 0) { if ((DUP_MASK >> 15) & 1) combine_phase(F, args, s - 1, true); combine_phase(F, args, s - 1); }
                }
                PH_END();
                if (PH_ON() && EN(14)) { SITE_PTRS();
                    pg8::MoeSched S; S.G = F.G; S.c = (int)blockIdx.x; S.nN = D / 256; S.nrow_e = D; slice_offsets(F, s, S.toff); S.nM = S.toff[8];
                    pg8::Gemm g{(const GAS bf16*)(ws + WS_HHS), (const GAS bf16*)(ws + WS_MD), DEX / 2, DEX / 2, DEX / 2};
                    pg8::EpiRow<0> E{(GAS bf16*)(ws + WS_YS), D, nullptr, 0};
                    REP(14) pg8::gemm_phase<pg8::EpiRow<0>, pg8::MoeSched, true, 121>(ring, g, S, E);
                    if (s + 1 < NSLICE) gather_phase(F, args, s + 1);
                }
                PH_END();
            }
            if (PH_ON() && EN(15)) { if ((DUP_MASK >> 15) & 1) combine_phase(F, args, NSLICE - 1, true); combine_phase(F, args, NSLICE - 1); }
            PH_END();
        }
    }
}
constexpr int N_PHASES = 2 + 6 + 3 + 6 + 1 + 2 * NSLICE + 1;

extern "C" void kernel_launch(void* const* d_in, const int* in_sizes, int n_in, void* d_out, int out_size, void* d_ws, size_t ws_size, hipStream_t stream) {
    static int grid = 0;
    if (grid == 0) {
        if (n_in != 25 || out_size != NX * D || ws_size < WS_END) { fprintf(stderr, "kernel_launch: unexpected problem (n_in %d, out %d, ws %zu < %zu)\n", n_in, out_size, ws_size, (size_t)WS_END); grid = -1; return; }
        int dev = 0, cus = 0, per_cu = 0;
        if (hipGetDevice(&dev) != hipSuccess || hipDeviceGetAttribute(&cus, hipDeviceAttributeMultiprocessorCount, dev) != hipSuccess) { grid = -1; return; }
        if (hipFuncSetAttribute((const void*)mk_fwd, hipFuncAttributeMaxDynamicSharedMemorySize, LDS_BYTES) != hipSuccess) { fprintf(stderr, "kernel_launch: hipFuncSetAttribute failed\n"); grid = -1; return; }
        if (hipOccupancyMaxActiveBlocksPerMultiprocessor(&per_cu, (const void*)mk_fwd, NTHR, LDS_BYTES) != hipSuccess || per_cu < 1) { fprintf(stderr, "kernel_launch: occupancy query says %d\n", per_cu); }
        (void)hipGetLastError();
        grid = cus;
    }
    if (grid < 0) return;
    (void)in_sizes;
    if (hipMemsetAsync((char*)d_ws + WS_CTL, 0, CTL_BYTES, stream) != hipSuccess) return;
    Args a{};
    for (int i = 0; i < 25; ++i) a.in[i] = (const float*)d_in[i];
    a.out = (float*)d_out; a.ws = (unsigned char*)d_ws;
#if MK_PER_PHASE
    for (int p = 0; p < N_PHASES; ++p) { a.ph_lo = p; a.ph_hi = p + 1; hipLaunchKernelGGL(mk_fwd, dim3(grid), dim3(NTHR), LDS_BYTES, stream, a); }
#else
    a.ph_lo = 0; a.ph_hi = N_PHASES;
    hipLaunchKernelGGL(mk_fwd, dim3(grid), dim3(NTHR), LDS_BYTES, stream, a);
#endif
}
```

```cpp
#include <hip/hip_runtime.h>
#include <cstdio>
#include <cstdint>

#ifndef MK_PER_PHASE
#define MK_PER_PHASE 0
#endif

#ifndef DUP_MASK
#define DUP_MASK 0
#endif
#define REP(k) for (int rep_ = 0; rep_ < 1 + (((DUP_MASK) >> (k)) & 1); ++rep_)
#define GAS __attribute__((address_space(1)))
#define LAS __attribute__((address_space(3)))
#define DI __device__ __forceinline__
typedef unsigned short bf16;
typedef unsigned v4u __attribute__((ext_vector_type(4)));
typedef unsigned v2u __attribute__((ext_vector_type(2)));
typedef float f32x4 __attribute__((ext_vector_type(4)));
typedef float f32x2 __attribute__((ext_vector_type(2)));
typedef float f32x16 __attribute__((ext_vector_type(16)));
typedef short bf16x8 __attribute__((ext_vector_type(8)));
typedef int i32x2 __attribute__((ext_vector_type(2)));

constexpr int D = 1024, BATCH = 32, SEQ = 2048, CTX = 256, GW = 64;
constexpr int NX = BATCH * SEQ, NC = BATCH * CTX, MALL = NX + NC;
constexpr int DH = 512, DK = 128, INC = 5120, DFF = 2816, NE = 8, DEX = 3584;
constexpr int C_Q = 0, C_FF = 512, C_FB = 1024, C_V = 1536, C_G = 2048, C_U = 2560, C_GA = 3072, C_GB = 4096;
constexpr float EPS = 1e-6f;
constexpr int NSLICE = 3, SL1 = 21848, SL2 = 43696, NGRP = NSLICE * NE;
constexpr int SLICE_ROWS = 45824;
DI int slice_of(int r) { return (r >= SL1 ? 1 : 0) + (r >= SL2 ? 1 : 0); }
DI int slice_start(int s) { return s == 0 ? 0 : s == 1 ? SL1 : s == 2 ? SL2 : NX; }
constexpr int NWAVES = 8, NTHR = 512;

constexpr size_t MiB = 1u << 20;
constexpr size_t al256(size_t x) { return (x + 255) & ~(size_t)255; }
constexpr size_t WS_CTL = 0, CTL_BYTES = 1 * MiB;
constexpr size_t WS_MOD = WS_CTL + CTL_BYTES;
constexpr size_t WS_LB = WS_MOD + al256((size_t)2 * 33 * 6144 * 4);
constexpr size_t WS_WIN = WS_LB + al256(2 * 2 * 512 * 4);
constexpr size_t WS_WR = WS_WIN + (size_t)2 * INC * D * 2;
constexpr size_t WS_WP = WS_WR + (size_t)2 * D * DH * 2;
constexpr size_t WS_WO = WS_WP + (size_t)2 * D * DH * 2;
constexpr size_t WS_WGU = WS_WO + (size_t)2 * D * D * 2;
constexpr size_t WS_WD = WS_WGU + (size_t)2 * DFF * D * 2;
constexpr size_t WS_H = WS_WD + (size_t)D * DFF * 2;
constexpr size_t WS_CX = WS_H + (size_t)MALL * D * 2;
constexpr size_t WS_RTOP = WS_CX + (size_t)NC * D * 2;
constexpr size_t WS_RPROB = WS_RTOP + (size_t)NX * 8;
constexpr size_t WS_RRANK = WS_RPROB + (size_t)NX * 8;
constexpr size_t WS_RPOS = WS_RRANK + (size_t)NX * 8;
constexpr size_t WS_RGATE = WS_RPOS + (size_t)NX * 8;
constexpr size_t WS_P = WS_RGATE + al256((size_t)SLICE_ROWS * 4);
constexpr size_t P_BYTES = (size_t)MALL * INC * 2;
constexpr size_t WS_MGU = WS_P + P_BYTES;
constexpr size_t WS_MD = WS_MGU + (size_t)NE * 2 * DEX * D;
constexpr size_t WS_END = WS_MD + (size_t)NE * D * DEX;
constexpr size_t WS_HH0 = WS_P;
constexpr size_t WS_H8 = WS_P;
constexpr size_t WS_AS = WS_H8 + (size_t)NX * D;
constexpr size_t WS_YS = WS_AS + (size_t)SLICE_ROWS * D;
constexpr size_t WS_HHS = WS_YS + (size_t)SLICE_ROWS * D * 2;
static_assert(WS_HHS + (size_t)SLICE_ROWS * DEX <= WS_P + P_BYTES, "moe overlay");
static_assert((size_t)MALL * DFF * 2 <= P_BYTES, "ffn overlay");
constexpr int CW_BAR = 0;
constexpr int CW_GCOUNT = 4096;
constexpr int CW_CMAX_FG = 18432, CW_CMAX_FU = 21248;
constexpr int CW_CMAX_IN = 8192;
constexpr size_t WS_RS = WS_CTL + 524288;
constexpr int LDS_BYTES = 159744, MISC_OFF = 158720;

typedef __bf16 bf16x2_t __attribute__((ext_vector_type(2)));
DI unsigned pk2(float lo, float hi) { bf16x2_t v = {(__bf16)lo, (__bf16)hi}; return __builtin_bit_cast(unsigned, v); }
DI float bflo(unsigned w) { return __uint_as_float(w << 16); }
DI float bfhi(unsigned w) { return __uint_as_float(w & 0xffff0000u); }
DI float wave_sum(float v) {
#pragma unroll
    for (int o = 1; o < 64; o <<= 1) v += __shfl_xor(v, o);
    return v;
}
DI float sat8(float x) { return __builtin_amdgcn_fmed3f(x, -448.f, 448.f); }
DI unsigned pk4_fp8(float a, float b, float c, float d) { int p = __builtin_amdgcn_cvt_pk_fp8_f32(sat8(a), sat8(b), 0, false); p = __builtin_amdgcn_cvt_pk_fp8_f32(sat8(c), sat8(d), p, true); return (unsigned)p; }
DI float wave_max(float v) {
#pragma unroll
    for (int o = 1; o < 64; o <<= 1) v = fmaxf(v, __shfl_xor(v, o));
    return v;
}
DI unsigned pk4_i8(float a, float b, float c, float d) {
    const int qa = (int)rintf(a), qb = (int)rintf(b), qc = (int)rintf(c), qd = (int)rintf(d);
    return (unsigned)(qa & 0xff) | ((unsigned)(qb & 0xff) << 8) | ((unsigned)(qc & 0xff) << 16) | ((unsigned)qd << 24);
}
DI float sigmoidf_(float a) { return __builtin_amdgcn_rcpf(1.0f + __builtin_amdgcn_exp2f(a * -1.4426950408889634f)); }
DI float siluf_(float a) { return a * sigmoidf_(a); }
#define LDS_WAIT() asm volatile("s_waitcnt lgkmcnt(0)" ::: "memory")
#define VM_WAIT() asm volatile("s_waitcnt vmcnt(0)" ::: "memory")

#define XB_TMO      128
#define XB_XCNT(j)  (256  + 64 * (j))
#define XB_XSUB(j)  (1280 + 64 * (j))
#define XB_XGEN(j)  (2304 + 64 * (j))
#define XB_TOP      3328
#define XB_TOPGEN   3392
#define XCD_BAR_WORDS 3456
#define XB_SPIN_CAP (1u << 20)

__device__ __forceinline__ unsigned xb_ld(unsigned* p)              { return __hip_atomic_load(p, __ATOMIC_RELAXED, __HIP_MEMORY_SCOPE_AGENT); }
__device__ __forceinline__ unsigned xb_add(unsigned* p, unsigned v) { return __hip_atomic_fetch_add(p, v, __ATOMIC_RELAXED, __HIP_MEMORY_SCOPE_AGENT); }
__device__ __forceinline__ unsigned xb_xcc_id() { return (unsigned)__builtin_amdgcn_s_getreg((3 << 11) | 20) & 0xFu; }
#define XB_SPIN(cond, bar) do { unsigned _sp = 0; while (cond) { __builtin_amdgcn_s_sleep(1); \
    if ((++_sp & 255u) == 0u) { if (xb_ld(&(bar)[XB_TMO])) break; if (_sp > XB_SPIN_CAP) { atomicAdd(&(bar)[XB_TMO], 1u); break; } } } } while (0)

struct XcdBarrier { unsigned* bar; unsigned x; volatile LAS unsigned* st; };

__device__ __forceinline__ XcdBarrier xcd_barrier_post(unsigned* bar, volatile LAS unsigned* st) {
    XcdBarrier b; b.bar = bar; b.x = xb_xcc_id(); b.st = st;
    if (threadIdx.x == 0) (void)xb_add(&bar[XB_XCNT(b.x)], 1u);
    return b;
}
__device__ __forceinline__ void xcd_barrier_complete(unsigned* bar, unsigned x, unsigned& nloc, unsigned& nx) {
    const unsigned G = gridDim.x * gridDim.y * gridDim.z;
    unsigned sum, cnt, mine, sp = 0u;
    for (;;) {
        sum = 0u; cnt = 0u; mine = 0u;
#pragma unroll
        for (unsigned j = 0; j < 16; ++j) { const unsigned c = xb_ld(&bar[XB_XCNT(j)]); sum += c; cnt += (c > 0u) ? 1u : 0u; mine = (j == x) ? c : mine; }
        if (sum == G) break;
        __builtin_amdgcn_s_sleep(1);
        if ((++sp & 255u) == 0u) { if (xb_ld(&bar[XB_TMO])) break; if (sp > XB_SPIN_CAP) { atomicAdd(&bar[XB_TMO], 1u); break; } }
    }
    nloc = mine > 0u ? mine : 1u; nx = cnt > 0u ? cnt : 1u;
}
__device__ __forceinline__ void xcd_barrier(const XcdBarrier& b) {
    asm volatile("s_waitcnt vmcnt(0)" ::: "memory");
    __syncthreads();
    if (threadIdx.x == 0) {
        unsigned* bar = b.bar;
        __builtin_amdgcn_s_waitcnt(0);
        unsigned nloc = b.st[0], nx = b.st[1];
        if (nloc == 0u) { xcd_barrier_complete(bar, b.x, nloc, nx); b.st[0] = nloc; b.st[1] = nx; }
        const unsigned old = xb_add(&bar[XB_XSUB(b.x)], 1u);
        const unsigned gen = old / nloc;
        if (old + 1u == (gen + 1u) * nloc) {
            __builtin_amdgcn_fence(__ATOMIC_RELEASE, "agent");
            asm volatile("s_waitcnt vmcnt(0)" ::: "memory");
            const unsigned og = xb_add(&bar[XB_TOP], 1u);
            const unsigned tg = og / nx;
            if (og + 1u == (tg + 1u) * nx) xb_add(&bar[XB_TOPGEN], 1u);
            else XB_SPIN(xb_ld(&bar[XB_TOPGEN]) == tg, bar);
            __builtin_amdgcn_fence(__ATOMIC_ACQUIRE, "agent");
            xb_add(&bar[XB_XGEN(b.x)], 1u);
            asm volatile("s_waitcnt vmcnt(0)" ::: "memory");
        } else {
            XB_SPIN(xb_ld(&bar[XB_XGEN(b.x)]) == gen, bar);
            __builtin_amdgcn_fence(__ATOMIC_ACQUIRE, "agent");
            asm volatile("s_waitcnt vmcnt(0)" ::: "memory");
        }
    }
    __syncthreads();
}

namespace pg8 {
constexpr int BM = 256, BK = 64, HALF = 128, HTB = HALF * BK * 2, STAGE_BYTES = 8 * HTB, NXCD = 8, WGM = 4;
__host__ __device__ __forceinline__ int lds_byte(int r, int c) { const int st = (r >> 4) * 2 + (c >> 5), rr = r & 15, cc = c & 31, ob = rr * 64 + cc * 2; return st * 1024 + (ob ^ (((ob >> 9) & 1) << 5)); }
__host__ __device__ __forceinline__ void stage_rc(int b, int& R, int& C) { const int st = b / 1024, sb = b % 1024, swz = sb ^ (((sb >> 9) & 1) << 5); R = (st >> 1) * 16 + swz / 64; C = (st & 1) * 32 + (swz % 64) / 2; }
__host__ __device__ __forceinline__ int perm32(int rho) { const int n = rho >> 4, i = rho & 15; return 8 * (i >> 2) + 4 * n + (i & 3); }

struct Unit { int arow, brow, pn, aux; };
struct Gemm { const GAS bf16* A; const GAS bf16* Bt; int lda, ldb, K; };
typedef int v8i __attribute__((ext_vector_type(8))); typedef int v4i __attribute__((ext_vector_type(4)));
DI v8i cat16(bf16x8 a, bf16x8 b) { const v4i x = __builtin_bit_cast(v4i, a), y = __builtin_bit_cast(v4i, b); return __builtin_shufflevector(x, y, 0, 1, 2, 3, 4, 5, 6, 7); }

DI void tile_order(int L, int nM, int nN, int& pm, int& pn) {
    const int nwg = nM * nN;
    int wgid = L; { const int q = nwg / NXCD, r = nwg % NXCD, xcd = wgid % NXCD, off = wgid / NXCD; wgid = (xcd < r ? xcd * (q + 1) : r * (q + 1) + (xcd - r) * q) + off; }
    const int nig = WGM * nN, gid = wgid / nig, fm = gid * WGM, gsz = (nM - fm) < WGM ? (nM - fm) : WGM;
    pm = fm + ((wgid % nig) % gsz); pn = (wgid % nig) / gsz;
}
struct StaticSched {
    int nM, nN, G, c, arow0;
    DI void init(int nM_, int nN_, int G_, int c_, int arow0_) { nM = nM_; nN = nN_; G = G_; c = c_; arow0 = arow0_; }
    DI bool next(int i, Unit& u) const {
        const long L = (long)i * G + c; if (L >= (long)nM * nN) return false;
        int pm, pn; tile_order((int)L, nM, nN, pm, pn);
        u.arow = arow0 + pm * BM; u.brow = pn * BM; u.pn = pn; u.aux = 0; return true;
    }
};
struct InSched {
    int G, c; bool last;
    DI bool next(int i, Unit& u) const {
        const int L = i * G + c; int pm, pn;
        if (!last) { if (L >= (MALL / 256) * (INC / 256)) return false; tile_order(L, MALL / 256, INC / 256, pm, pn); }
        else if (L < (NX / 256) * (INC / 256)) tile_order(L, NX / 256, INC / 256, pm, pn);
        else { const int L2 = L - (NX / 256) * (INC / 256); if (L2 >= (NC / 256) * 6) return false; pm = NX / 256 + L2 % (NC / 256); pn = 2 + L2 / (NC / 256); }
        u.arow = pm * BM; u.brow = pn * BM; u.pn = pn; u.aux = 0; return true;
    }
};
struct MoeSched {
    int nM, nN, G, c, nrow_e; int toff[9];
    DI bool next(int i, Unit& u) const {
        const long L = (long)i * G + c; if (L >= (long)nM * nN) return false;
        int pm, pn; tile_order((int)L, nM, nN, pm, pn);
        int e = 0;
#pragma unroll
        for (int j = 1; j < 8; ++j) e += (pm >= toff[j]) ? 1 : 0;
        u.arow = pm * BM; u.brow = e * nrow_e + pn * BM; u.pn = pn; u.aux = e; return true;
    }
};

template <class Epi, class Sched, bool FP8 = false, int WSC = 127, bool I8 = false>
DI void gemm_phase(LAS unsigned char* lds, const Gemm g, const Sched& S, const Epi& E) {
    int tid = threadIdx.x; asm volatile("" : "+v"(tid));
    const int wid = __builtin_amdgcn_readfirstlane(tid >> 6), lane = tid & 63, wr = wid >> 2, wc = wid & 3, fr = lane & 15, fq = lane >> 4;
    const int K = g.K, nt = K / BK;
    unsigned voffA[2], voffB[2];
#pragma unroll
    for (int i = 0; i < 2; ++i) { int R, C; stage_rc(tid * 16 + i * 8192, R, C); const int Rb = Epi::PERM ? ((R & ~31) + perm32(R & 31)) : R;
        voffA[i] = (unsigned)(R * g.lda + C) * 2u; voffB[i] = (unsigned)(Rb * g.ldb + C) * 2u; }
    const size_t kstep = (size_t)(BK * 2);
    const size_t hstepA = (size_t)HALF * g.lda * 2, hstepB = (size_t)HALF * g.ldb * 2;
    const size_t rowA = (size_t)g.lda * 2, rowB = (size_t)g.ldb * 2;
    const unsigned ldsw = (unsigned)wid * 1024u;
    const int aoff = lds_byte(wr * 64 + fr, fq * 8), boff = lds_byte(wc * 32 + fr, fq * 8);
#define PG8_SA(b, h) (((b) * 2 + (h)) * HTB)
#define PG8_SB(b, h) ((4 + (b) * 2 + (h)) * HTB)
#define PG8_STAGE(bufoff, gbase, voff) do { _Pragma("unroll") for (int _i = 0; _i < 2; ++_i) \
        __builtin_amdgcn_global_load_lds((const GAS unsigned*)((const GAS char*)(gbase) + (voff)[_i]), (LAS unsigned*)(lds + (bufoff) + ldsw + _i * 8192), 16, 0, 0); } while (0)
#define PG8_LDA(dst, b, h) do { _Pragma("unroll") for (int m = 0; m < 4; ++m) { if constexpr (FP8) dst##8[m] = cat16(*(const LAS bf16x8*)(lds + PG8_SA(b, h) + aoff + m * 2048), *(const LAS bf16x8*)(lds + PG8_SA(b, h) + aoff + m * 2048 + 1024)); \
        else { _Pragma("unroll") for (int k = 0; k < 2; ++k) dst[m][k] = *(const LAS bf16x8*)(lds + PG8_SA(b, h) + aoff + m * 2048 + k * 1024); } } } while (0)
#define PG8_LDB(dst, b, h) do { _Pragma("unroll") for (int n = 0; n < 2; ++n) { if constexpr (FP8) dst##8[n] = cat16(*(const LAS bf16x8*)(lds + PG8_SB(b, h) + boff + n * 2048), *(const LAS bf16x8*)(lds + PG8_SB(b, h) + boff + n * 2048 + 1024)); \
        else { _Pragma("unroll") for (int k = 0; k < 2; ++k) dst[n][k] = *(const LAS bf16x8*)(lds + PG8_SB(b, h) + boff + n * 2048 + k * 1024); } } } while (0)
#define PG8_MMA(ai, bj, At, Bt) do { __builtin_amdgcn_s_setprio(1); _Pragma("unroll") for (int m = 0; m < 4; ++m) _Pragma("unroll") for (int n = 0; n < 2; ++n) { \
        if constexpr (FP8) asm volatile("v_mfma_scale_f32_16x16x128_f8f6f4 %0, %1, %2, %0, %3, %4 op_sel_hi:[0,0,0]" : "+v"(acc[ai][bj][m][n]) : "v"(Bt##8[n]), "v"(At##8[m]), "v"(sc_w), "v"(sc_a)); \
        else if constexpr (I8) { _Pragma("unroll") for (int k = 0; k < 2; ++k) acc[ai][bj][m][n] = __builtin_bit_cast(f32x4, __builtin_amdgcn_mfma_i32_16x16x64_i8(__builtin_bit_cast(v4i, Bt[n][k]), __builtin_bit_cast(v4i, At[m][k]), __builtin_bit_cast(v4i, acc[ai][bj][m][n]), 0, 0, 0)); } \
        else { _Pragma("unroll") for (int k = 0; k < 2; ++k) acc[ai][bj][m][n] = __builtin_amdgcn_mfma_f32_16x16x32_bf16(Bt[n][k], At[m][k], acc[ai][bj][m][n], 0, 0, 0); } } \
        __builtin_amdgcn_s_setprio(0); } while (0)
#define PG8_WAIT_V(n) asm volatile("s_waitcnt vmcnt(" #n ")" ::: "memory")
#define PG8_WAIT_L(n) asm volatile("s_waitcnt lgkmcnt(" #n ")" ::: "memory")
#define PG8_BAR __builtin_amdgcn_s_barrier()
#define PG8_SCHED __builtin_amdgcn_sched_barrier(0)
    Unit cur, nxt; int ui = 0;
    if (!S.next(0, cur)) return;
    f32x4 acc[2][2][4][2];
#pragma unroll
    for (int a = 0; a < 2; ++a)
#pragma unroll
        for (int b = 0; b < 2; ++b)
#pragma unroll
            for (int m = 0; m < 4; ++m)
#pragma unroll
                for (int n = 0; n < 2; ++n) acc[a][b][m][n] = (f32x4){0.f, 0.f, 0.f, 0.f};
    const int sc_w = WSC * 0x01010101, sc_a = 0x7f7f7f7f;
    bf16x8 At[4][2], B0[2][2], B1[2][2]; v8i At8[4], B08[2], B18[2];
    const GAS char* cA = (const GAS char*)g.A + (size_t)cur.arow * rowA; const GAS char* cB = (const GAS char*)g.Bt + (size_t)cur.brow * rowB;
    PG8_STAGE(PG8_SB(0, 0), cB, voffB); PG8_STAGE(PG8_SB(0, 1), cB + hstepB, voffB); PG8_STAGE(PG8_SA(0, 0), cA, voffA); PG8_STAGE(PG8_SA(0, 1), cA + hstepA, voffA);
    if (wr == 1) PG8_BAR;
    PG8_WAIT_V(2); PG8_BAR;
    PG8_STAGE(PG8_SB(1, 0), cB + kstep, voffB); PG8_STAGE(PG8_SA(1, 0), cA + kstep, voffA); PG8_STAGE(PG8_SB(1, 1), cB + hstepB + kstep, voffB);
    PG8_WAIT_V(6); PG8_BAR;
    for (;;) {
        const bool has_next = S.next(ui + 1, nxt);
        const GAS char* nA = has_next ? (const GAS char*)g.A + (size_t)nxt.arow * rowA : cA; const GAS char* nB = has_next ? (const GAS char*)g.Bt + (size_t)nxt.brow * rowB : cB;
        for (int t = 0; t < nt; t += 2) {
            const bool last = (t == nt - 2);
            const GAS char* a1 = cA + (size_t)(t + 1) * kstep;
            const GAS char* a2 = last ? nA : cA + (size_t)(t + 2) * kstep; const GAS char* b2 = last ? nB : cB + (size_t)(t + 2) * kstep;
            const GAS char* a3 = a2 + kstep; const GAS char* b3 = b2 + kstep;
            PG8_LDB(B0, 0, 0); PG8_LDB(B1, 0, 1); PG8_SCHED; PG8_LDA(At, 0, 0); PG8_STAGE(PG8_SA(1, 1), a1 + hstepA, voffA);
            PG8_WAIT_V(8); PG8_WAIT_L(0); PG8_BAR; PG8_MMA(0, 0, At, B0); PG8_MMA(0, 1, At, B1); PG8_BAR; PG8_SCHED;
            PG8_LDA(At, 0, 1); PG8_STAGE(PG8_SB(0, 0), b2, voffB); PG8_STAGE(PG8_SB(0, 1), b2 + hstepB, voffB); PG8_STAGE(PG8_SA(0, 0), a2, voffA);
            PG8_WAIT_V(8); PG8_WAIT_L(0); PG8_BAR; PG8_MMA(1, 0, At, B0); PG8_MMA(1, 1, At, B1); PG8_BAR; PG8_SCHED;
            PG8_LDB(B0, 1, 0); PG8_LDB(B1, 1, 1); PG8_SCHED; PG8_LDA(At, 1, 0); PG8_STAGE(PG8_SA(0, 1), a2 + hstepA, voffA);
            PG8_WAIT_V(8); PG8_WAIT_L(0); PG8_BAR; PG8_MMA(0, 0, At, B0); PG8_MMA(0, 1, At, B1); PG8_BAR; PG8_SCHED;
            PG8_LDA(At, 1, 1); PG8_STAGE(PG8_SB(1, 0), b3, voffB); PG8_STAGE(PG8_SB(1, 1), b3 + hstepB, voffB); PG8_STAGE(PG8_SA(1, 0), a3, voffA);
            PG8_WAIT_V(8); PG8_WAIT_L(0); PG8_BAR; PG8_MMA(1, 0, At, B0); PG8_MMA(1, 1, At, B1); PG8_BAR; PG8_SCHED;
        }
        if (wr == 0) PG8_BAR;
        if constexpr (FP8) asm volatile("s_nop 15\n\ts_nop 15\n\ts_nop 15\n\ts_nop 15" ::: "memory");
        if constexpr (Epi::HAS_PRE) {
            const auto pre = E.preload(cur, wr, fr);
            if constexpr (I8) {
#pragma unroll
                for (int a = 0; a < 2; ++a)
#pragma unroll
                    for (int b = 0; b < 2; ++b)
#pragma unroll
                        for (int m = 0; m < 4; ++m)
#pragma unroll
                            for (int n = 0; n < 2; ++n) { const v4i t = __builtin_bit_cast(v4i, acc[a][b][m][n]); acc[a][b][m][n] = (f32x4){(float)t.x, (float)t.y, (float)t.z, (float)t.w}; } }
            E(acc, cur, wr, wc, fr, fq, pre);
        } else {
        if constexpr (I8) {
#pragma unroll
            for (int a = 0; a < 2; ++a)
#pragma unroll
                for (int b = 0; b < 2; ++b)
#pragma unroll
                    for (int m = 0; m < 4; ++m)
#pragma unroll
                        for (int n = 0; n < 2; ++n) { const v4i t = __builtin_bit_cast(v4i, acc[a][b][m][n]); acc[a][b][m][n] = (f32x4){(float)t.x, (float)t.y, (float)t.z, (float)t.w}; } }
        E(acc, cur, wr, wc, fr, fq);
        }
        if (!has_next) break;
#pragma unroll
        for (int a = 0; a < 2; ++a)
#pragma unroll
            for (int b = 0; b < 2; ++b)
#pragma unroll
                for (int m = 0; m < 4; ++m)
#pragma unroll
                    for (int n = 0; n < 2; ++n) acc[a][b][m][n] = (f32x4){0.f, 0.f, 0.f, 0.f};
        cur = nxt; cA = nA; cB = nB; ++ui;
        if (wr == 1) PG8_BAR;
    }
    PG8_WAIT_V(0);
    PG8_BAR;
#undef PG8_SA
#undef PG8_SB
#undef PG8_STAGE
#undef PG8_LDA
#undef PG8_LDB
#undef PG8_MMA
#undef PG8_WAIT_V
#undef PG8_WAIT_L
#undef PG8_BAR
#undef PG8_SCHED
}

DI f32x2 ex2p(f32x2 x) { return (f32x2){__builtin_amdgcn_exp2f(x.x), __builtin_amdgcn_exp2f(x.y)}; }
DI f32x2 rcpp(f32x2 x) { return (f32x2){__builtin_amdgcn_rcpf(x.x), __builtin_amdgcn_rcpf(x.y)}; }
DI f32x2 lo2(f32x4 v) { return __builtin_shufflevector(v, v, 0, 1); }
DI f32x2 hi2(f32x4 v) { return __builtin_shufflevector(v, v, 2, 3); }
DI v4u pack8p(const f32x2 (&o)[4]) { v4u w; w.x = pk2(o[0].x, o[0].y); w.y = pk2(o[1].x, o[1].y); w.z = pk2(o[2].x, o[2].y); w.w = pk2(o[3].x, o[3].y); return w; }
DI v4u pack8f(const float (&o)[8]) { v4u w; w.x = pk2(o[0], o[1]); w.y = pk2(o[2], o[3]); w.z = pk2(o[4], o[5]); w.w = pk2(o[6], o[7]); return w; }
template <bool LBZ> struct EpiIn {
    static constexpr bool PERM = true; static constexpr bool HAS_PRE = true;
    GAS bf16* P; const GAS float* LB;
    static constexpr bool lbz = LBZ;
    const GAS float* rs; const LAS float* cmax;
    template <int T> DI static void act8(float (&v)[8], const float (&lb)[8]) {
        const float L2E = 1.4426950408889634f, LN2 = 0.6931471805599453f;
        if (T == 2) return;
        if (T == 0 || T == 3 || T == 4) {
            f32x2 a2[4] = {{v[0], v[1]}, {v[2], v[3]}, {v[4], v[5]}, {v[6], v[7]}}, e2[4];
#pragma unroll
            for (int p = 0; p < 4; ++p) e2[p] = ex2p(a2[p] * (f32x2){-L2E, -L2E});
#pragma unroll
            for (int p = 0; p < 4; ++p) { e2[p] = e2[p] + (f32x2){1.0f, 1.0f}; if (T == 0) a2[p] = a2[p] * (f32x2){0.08838834764831845f, 0.08838834764831845f}; }
#pragma unroll
            for (int p = 0; p < 4; ++p) e2[p] = rcpp(e2[p]);
#pragma unroll
            for (int p = 0; p < 4; ++p) { const f32x2 o = (T == 4) ? e2[p] : a2[p] * e2[p]; v[2 * p] = o.x; v[2 * p + 1] = o.y; }
            return;
        }
        f32x2 a2[4] = {{v[0], v[1]}, {v[2], v[3]}, {v[4], v[5]}, {v[6], v[7]}}, t2[4], m2[4];
#pragma unroll
        for (int p = 0; p < 4; ++p) { m2[p] = __builtin_elementwise_min(a2[p], (f32x2){0.f, 0.f}); t2[p] = (a2[p] - m2[p] - m2[p]) * (f32x2){-L2E, -L2E}; }
#pragma unroll
        for (int p = 0; p < 4; ++p) t2[p] = ex2p(t2[p]);
        if constexpr (LBZ) {
#pragma unroll
            for (int p = 0; p < 4; ++p) t2[p] = t2[p] + (f32x2){1.0f, 1.0f};
#pragma unroll
            for (int p = 0; p < 4; ++p) t2[p] = (f32x2){__builtin_amdgcn_logf(t2[p].x), __builtin_amdgcn_logf(t2[p].y)};
#pragma unroll
            for (int p = 0; p < 4; ++p) { const f32x2 o = m2[p] - t2[p] * (f32x2){LN2, LN2}; v[2 * p] = o.x; v[2 * p + 1] = o.y; }
        } else {
            f32x2 r2[4];
#pragma unroll
            for (int p = 0; p < 4; ++p) r2[p] = rcpp(t2[p] + (f32x2){1.0f, 1.0f});
#pragma unroll
            for (int p = 0; p < 4; ++p) { const f32x2 num = (f32x2){a2[p].x >= 0.f ? 1.0f : t2[p].x, a2[p].y >= 0.f ? 1.0f : t2[p].y};
                const f32x2 lbp = (f32x2){lb[2 * p], lb[2 * p + 1]}; r2[p] = lbp + ((f32x2){1.0f, 1.0f} - lbp) * (num * r2[p]); }
#pragma unroll
            for (int p = 0; p < 4; ++p) { v[2 * p] = __builtin_amdgcn_logf(r2[p].x) * LN2; v[2 * p + 1] = __builtin_amdgcn_logf(r2[p].y) * LN2; }
        }
    }
    struct Pre { float r[2][4]; };
    DI Pre preload(const Unit& u, int wr, int fr) const { Pre p; asm volatile("" : "+v"(fr)); const int row0 = u.arow + wr * 64 + fr;
#pragma unroll
        for (int ai = 0; ai < 2; ++ai)
#pragma unroll
            for (int m = 0; m < 4; ++m) p.r[ai][m] = rs[row0 + ai * 128 + m * 16];
        return p; }
    template <int T> DI void run(const f32x4 (&acc)[2][2][4][2], const Unit& u, int wr, int wc, int fr, int fq, const Pre& pre) const {
        const int row0 = u.arow + wr * 64 + fr, colt = u.pn * 256 + wc * 32 + 8 * fq;
        float rsr[2][4];
#pragma unroll
        for (int ai = 0; ai < 2; ++ai)
#pragma unroll
            for (int m = 0; m < 4; ++m) rsr[ai][m] = pre.r[ai][m];
#pragma unroll
        for (int bj = 0; bj < 2; ++bj) {
            float lb[8];
#pragma unroll
            for (int j = 0; j < 8; ++j) lb[j] = (T == 1 && !lbz) ? LB[colt - 512 + bj * 128 + j] : 0.f;
            const f32x4 c0 = *(const LAS f32x4*)(cmax + colt + bj * 128) * (1.0f / 127.0f), c1 = *(const LAS f32x4*)(cmax + colt + bj * 128 + 4) * (1.0f / 127.0f);
#pragma unroll
            for (int ai = 0; ai < 2; ++ai)
#pragma unroll
                for (int m = 0; m < 4; ++m) { GAS bf16* rowp = P + (size_t)(row0 + ai * 128 + m * 16) * INC + colt;
                    const f32x4 w0 = acc[ai][bj][m][0] * (c0 * rsr[ai][m]), w1 = acc[ai][bj][m][1] * (c1 * rsr[ai][m]);
                    float v[8] = {w0[0], w0[1], w0[2], w0[3], w1[0], w1[1], w1[2], w1[3]};
                    act8<T>(v, lb);
                    *(GAS v4u*)(rowp + bj * 128) = pack8f(v);
                    __builtin_amdgcn_sched_barrier(0); }
        }
    }
    DI void operator()(const f32x4 (&acc)[2][2][4][2], const Unit& u, int wr, int wc, int fr, int fq, const Pre& pre) const {
        const int t = u.pn >> 1;
        if (t == 0) run<0>(acc, u, wr, wc, fr, fq, pre);
        else if (t == 1 || t == 2) run<1>(acc, u, wr, wc, fr, fq, pre);
        else if (t == 3 || t == 5) run<2>(acc, u, wr, wc, fr, fq, pre);
        else if (t == 4) run<3>(acc, u, wr, wc, fr, fq, pre);
        else run<4>(acc, u, wr, wc, fr, fq, pre);
    }
};
template <int MODE> struct EpiRow {
    static constexpr bool PERM = true; static constexpr bool HAS_PRE = false;
    GAS bf16* O; int ldc; const GAS float* colscale; int g2off;
    DI void operator()(const f32x4 (&acc)[2][2][4][2], const Unit& u, int wr, int wc, int fr, int fq) const {
        const int row0 = u.arow + wr * 64 + fr, colt = u.pn * 256 + wc * 32 + 8 * fq;
        if constexpr (MODE == 0) {
            float cs[2][8];
#pragma unroll
            for (int bj = 0; bj < 2; ++bj)
#pragma unroll
                for (int j = 0; j < 8; ++j) cs[bj][j] = colscale ? colscale[colt + bj * 128 + j] : 1.f;
#pragma unroll
            for (int ai = 0; ai < 2; ++ai)
#pragma unroll
                for (int m = 0; m < 4; ++m) { GAS bf16* rowp = O + (size_t)(row0 + ai * 128 + m * 16) * ldc + colt;
#pragma unroll
                    for (int bj = 0; bj < 2; ++bj) { const f32x4 v0 = acc[ai][bj][m][0], v1 = acc[ai][bj][m][1];
                        float o[8] = {v0[0], v0[1], v0[2], v0[3], v1[0], v1[1], v1[2], v1[3]};
#pragma unroll
                        for (int j = 0; j < 8; ++j) o[j] *= cs[bj][j];
                        v4u w; w.x = pk2(o[0], o[1]); w.y = pk2(o[2], o[3]); w.z = pk2(o[4], o[5]); w.w = pk2(o[6], o[7]);
                        *(GAS v4u*)(rowp + bj * 128) = w; } }
        } else if constexpr (MODE == 1) {
            v4u gq[2][4], r0[2][4];
#pragma unroll
            for (int ai = 0; ai < 2; ++ai)
#pragma unroll
                for (int m = 0; m < 4; ++m) gq[ai][m] = *(const GAS v4u*)(O + (size_t)(row0 + ai * 128 + m * 16) * ldc + colt);
#pragma unroll
            for (int ai = 0; ai < 2; ++ai)
#pragma unroll
                for (int m = 0; m < 4; ++m) { const f32x4 v0 = acc[ai][0][m][0], v1 = acc[ai][0][m][1]; const v4u g = gq[ai][m];
                    v4u w; w.x = pk2(v0[0] * bflo(g.x), v0[1] * bfhi(g.x)); w.y = pk2(v0[2] * bflo(g.y), v0[3] * bfhi(g.y)); w.z = pk2(v1[0] * bflo(g.z), v1[1] * bfhi(g.z)); w.w = pk2(v1[2] * bflo(g.w), v1[3] * bfhi(g.w));
                    r0[ai][m] = w; }
            __builtin_amdgcn_sched_barrier(0);
#pragma unroll
            for (int ai = 0; ai < 2; ++ai)
#pragma unroll
                for (int m = 0; m < 4; ++m) gq[ai][m] = *(const GAS v4u*)(O + (size_t)(row0 + ai * 128 + m * 16) * ldc + colt + 128);
            __builtin_amdgcn_sched_barrier(0);
#pragma unroll
            for (int ai = 0; ai < 2; ++ai)
#pragma unroll
                for (int m = 0; m < 4; ++m) *(GAS v4u*)(O + (size_t)(row0 + ai * 128 + m * 16) * ldc + colt) = r0[ai][m];
            __builtin_amdgcn_sched_barrier(0);
#pragma unroll
            for (int ai = 0; ai < 2; ++ai)
#pragma unroll
                for (int m = 0; m < 4; ++m) { const f32x4 v0 = acc[ai][1][m][0], v1 = acc[ai][1][m][1]; const v4u g = gq[ai][m];
                    v4u w; w.x = pk2(v0[0] * bflo(g.x), v0[1] * bfhi(g.x)); w.y = pk2(v0[2] * bflo(g.y), v0[3] * bfhi(g.y)); w.z = pk2(v1[0] * bflo(g.z), v1[1] * bfhi(g.z)); w.w = pk2(v1[2] * bflo(g.w), v1[3] * bfhi(g.w));
                    *(GAS v4u*)(O + (size_t)(row0 + ai * 128 + m * 16) * ldc + colt + 128) = w; }
        } else {
            v4u gq[2][4], pq[2][4], rq[4];
            auto LD = [&](int q, int slot) {
#pragma unroll
                for (int m = 0; m < 4; ++m) { const GAS bf16* rp = O + (size_t)(row0 + (q & 1) * 128 + m * 16) * ldc + colt + (q >> 1) * 128; gq[slot][m] = *(const GAS v4u*)(rp + g2off); pq[slot][m] = *(const GAS v4u*)rp; } };
            auto CP = [&](int q, int slot) {
#pragma unroll
                for (int m = 0; m < 4; ++m) { const f32x4 v0 = acc[q & 1][q >> 1][m][0], v1 = acc[q & 1][q >> 1][m][1]; const v4u g = gq[slot][m], t = pq[slot][m];
                    v4u w; w.x = pk2(bflo(t.x) + v0[0] * bflo(g.x), bfhi(t.x) + v0[1] * bfhi(g.x)); w.y = pk2(bflo(t.y) + v0[2] * bflo(g.y), bfhi(t.y) + v0[3] * bfhi(g.y));
                    w.z = pk2(bflo(t.z) + v1[0] * bflo(g.z), bfhi(t.z) + v1[1] * bfhi(g.z)); w.w = pk2(bflo(t.w) + v1[2] * bflo(g.w), bfhi(t.w) + v1[3] * bfhi(g.w));
                    rq[m] = w; } };
            auto ST = [&](int q) {
#pragma unroll
                for (int m = 0; m < 4; ++m) *(GAS v4u*)(O + (size_t)(row0 + (q & 1) * 128 + m * 16) * ldc + colt + (q >> 1) * 128) = rq[m]; };
            LD(0, 0); LD(1, 1); __builtin_amdgcn_sched_barrier(0);
            CP(0, 0); __builtin_amdgcn_sched_barrier(0); LD(2, 0); __builtin_amdgcn_sched_barrier(0); ST(0); __builtin_amdgcn_sched_barrier(0);
            CP(1, 1); __builtin_amdgcn_sched_barrier(0); LD(3, 1); __builtin_amdgcn_sched_barrier(0); ST(1); __builtin_amdgcn_sched_barrier(0);
            CP(2, 0); ST(2); __builtin_amdgcn_sched_barrier(0);
            CP(3, 1); ST(3);
        }
    }
};
template <bool OUT8> struct EpiSwiGLU {
    static constexpr bool PERM = true; static constexpr bool HAS_PRE = true;
    GAS bf16* Hh; int ldc; const GAS float* rowgate;
    const GAS float* rs; const LAS float* cmg; const LAS float* cmu;
    struct Pre { float r[2][4]; };
    DI Pre preload(const Unit& u, int wr, int fr) const { Pre p; asm volatile("" : "+v"(fr)); const int row0 = u.arow + wr * 64 + fr;
#pragma unroll
        for (int ai = 0; ai < 2; ++ai)
#pragma unroll
            for (int m = 0; m < 4; ++m) p.r[ai][m] = rs[row0 + ai * 128 + m * 16];
        return p; }
    DI void operator()(const f32x4 (&acc)[2][2][4][2], const Unit& u, int wr, int wc, int fr, int fq, const Pre& pre) const {
        const int row0 = u.arow + wr * 64 + fr, col0 = u.pn * 128 + wc * 32 + 8 * fq;
        const f32x4 sg4[2] = {*(const LAS f32x4*)(cmg + col0) * (1.0f / 127.0f), *(const LAS f32x4*)(cmg + col0 + 4) * (1.0f / 127.0f)}, su4[2] = {*(const LAS f32x4*)(cmu + col0) * (1.0f / 127.0f), *(const LAS f32x4*)(cmu + col0 + 4) * (1.0f / 127.0f)};
        float rsv[2][4], rgv[2][4];
#pragma unroll
        for (int ai = 0; ai < 2; ++ai)
#pragma unroll
            for (int m = 0; m < 4; ++m) { rsv[ai][m] = pre.r[ai][m]; rgv[ai][m] = rowgate ? rowgate[row0 + ai * 128 + m * 16] : 1.f; }
#pragma unroll
        for (int ai = 0; ai < 2; ++ai)
#pragma unroll
            for (int m = 0; m < 4; ++m) { const int row = row0 + ai * 128 + m * 16; const float rg = rgv[ai][m];
                const f32x4 g0 = acc[ai][0][m][0], g1 = acc[ai][0][m][1], u0 = acc[ai][1][m][0], u1 = acc[ai][1][m][1];
                const float rsr = rsv[ai][m];
                const f32x4 a0 = g0 * (sg4[0] * rsr), a1 = g1 * (sg4[1] * rsr), b0 = u0 * (su4[0] * (rsr * rg)), b1 = u1 * (su4[1] * (rsr * rg));
                f32x2 g2[4] = {lo2(a0), hi2(a0), lo2(a1), hi2(a1)}, u2[4] = {lo2(b0), hi2(b0), lo2(b1), hi2(b1)}, e2[4];
#pragma unroll
                for (int p = 0; p < 4; ++p) e2[p] = ex2p(g2[p] * (f32x2){-1.4426950408889634f, -1.4426950408889634f});
#pragma unroll
                for (int p = 0; p < 4; ++p) e2[p] = e2[p] + (f32x2){1.0f, 1.0f};
#pragma unroll
                for (int p = 0; p < 4; ++p) e2[p] = rcpp(e2[p]);
#pragma unroll
                for (int p = 0; p < 4; ++p) g2[p] = g2[p] * u2[p];
#pragma unroll
                for (int p = 0; p < 4; ++p) g2[p] = g2[p] * e2[p];
                if constexpr (OUT8) { v2u w; w.x = pk4_fp8(g2[0].x, g2[0].y, g2[1].x, g2[1].y); w.y = pk4_fp8(g2[2].x, g2[2].y, g2[3].x, g2[3].y);
                    *(GAS v2u*)((GAS unsigned char*)Hh + (size_t)row * ldc + col0) = w; }
                else *(GAS v4u*)(Hh + (size_t)row * ldc + col0) = pack8p(g2); }
    }
};
template <class E> struct EpiDry { static constexpr bool PERM = E::PERM; static constexpr bool HAS_PRE = false; E e; bool never;
    DI void operator()(const f32x4 (&acc)[2][2][4][2], const Unit& u, int wr, int wc, int fr, int fq) const { if (never) e(acc, u, wr, wc, fr, fq); } };
struct EpiSwiGLU8 {
    static constexpr bool PERM = true; static constexpr bool HAS_PRE = false;
    GAS unsigned char* Hh; int ldc; const GAS float* rowgate;
    DI void operator()(const f32x4 (&acc)[2][2][4][2], const Unit& u, int wr, int wc, int fr, int fq) const {
        const int row0 = u.arow + wr * 64 + fr, col0 = u.pn * 128 + wc * 32 + 8 * fq;
        float rgv[2][4];
#pragma unroll
        for (int ai = 0; ai < 2; ++ai)
#pragma unroll
            for (int m = 0; m < 4; ++m) rgv[ai][m] = rowgate ? rowgate[row0 + ai * 128 + m * 16] : 1.f;
#pragma unroll
        for (int ai = 0; ai < 2; ++ai)
#pragma unroll
            for (int m = 0; m < 4; ++m) { const int row = row0 + ai * 128 + m * 16; const float rg = rgv[ai][m];
                const f32x4 g0 = acc[ai][0][m][0], g1 = acc[ai][0][m][1], u0 = acc[ai][1][m][0], u1 = acc[ai][1][m][1];
                f32x2 g2[4] = {lo2(g0), hi2(g0), lo2(g1), hi2(g1)}, u2[4] = {lo2(u0), hi2(u0), lo2(u1), hi2(u1)}, e2[4];
#pragma unroll
                for (int p = 0; p < 4; ++p) e2[p] = ex2p(g2[p] * (f32x2){-1.4426950408889634f, -1.4426950408889634f});
#pragma unroll
                for (int p = 0; p < 4; ++p) { e2[p] = e2[p] + (f32x2){1.0f, 1.0f}; u2[p] = u2[p] * (f32x2){rg, rg}; }
#pragma unroll
                for (int p = 0; p < 4; ++p) e2[p] = rcpp(e2[p]);
#pragma unroll
                for (int p = 0; p < 4; ++p) g2[p] = g2[p] * u2[p];
#pragma unroll
                for (int p = 0; p < 4; ++p) g2[p] = g2[p] * e2[p];
                v2u w; w.x = pk4_fp8(g2[0].x, g2[0].y, g2[1].x, g2[1].y); w.y = pk4_fp8(g2[2].x, g2[2].y, g2[3].x, g2[3].y);
                *(GAS v2u*)(Hh + (size_t)row * ldc + col0) = w; }
    }
};
}

struct Args { const float* in[25]; float* out; unsigned char* ws; int ph_lo, ph_hi; };
struct Frame {
    LAS unsigned char* lds; int tid, lane, wave, G, gw, NGW; bool never;
    GAS float* out; GAS unsigned char* ws;
};
DI Frame fresh(const Frame& F0) { Frame F = F0; asm volatile("" : "+v"(F.tid)); F.lane = F.tid & 63; asm volatile("" : "+s"(F.ws), "+s"(F.out)); return F; }
enum { I_X = 0, I_C, I_CTX, I_CCTX, I_ADAW, I_ADAB, I_MIXPRE, I_MIXPOST, I_FFNPRE, I_FFNPOST, I_WIN, I_LB, I_GAIN, I_POOLW, I_POOLS, I_WBR, I_WBP, I_WOUT, I_FG, I_FU, I_FD, I_ROUTER, I_MG, I_MU, I_MD };

DI void tr_item(const GAS float* W, int K, int N, GAS bf16* WT, int ldk, int koff, int row_off, int nb, int nstride, LAS float* scr, int item, int lane) {
    const int nblk = N / 32, kb = item / nblk, nbi = item % nblk, k0 = 64 * kb, n0 = 32 * nbi;
    f32x4 ld[8];
#pragma unroll
    for (int i = 0; i < 8; ++i) ld[i] = *(const GAS f32x4*)(W + (size_t)(k0 + (lane >> 3) + 8 * i) * N + n0 + 4 * (lane & 7));
#pragma unroll
    for (int i = 0; i < 8; ++i) { LAS float* d = scr + ((lane >> 3) + 8 * i) * 33 + 4 * (lane & 7); d[0] = ld[i].x; d[1] = ld[i].y; d[2] = ld[i].z; d[3] = ld[i].w; }
    LDS_WAIT(); asm volatile("" ::: "memory");
    const int c = lane & 7;
#pragma unroll
    for (int j = 0; j < 4; ++j) { const int n = (lane >> 3) + 8 * j; const LAS float* s = scr + (8 * c) * 33 + n;
        v4u o; o.x = pk2(s[0 * 33], s[1 * 33]); o.y = pk2(s[2 * 33], s[3 * 33]); o.z = pk2(s[4 * 33], s[5 * 33]); o.w = pk2(s[6 * 33], s[7 * 33]);
        const int ng = n0 + n, drow = row_off + (ng / nb) * nstride + (ng % nb);
        *(GAS v4u*)(WT + (size_t)drow * ldk + koff + k0 + 8 * c) = o; }
    LDS_WAIT(); asm volatile("" ::: "memory");
}

DI void tr_item8(const GAS float* W, int K, int N, GAS unsigned char* WT, int ldk, int row_off, int nb, int nstride, float qs, LAS float* scr, int item, int lane) {
    const int nblk = N / 32, kb = item / nblk, nbi = item % nblk, k0 = 64 * kb, n0 = 32 * nbi;
    f32x4 ld[8];
#pragma unroll
    for (int i = 0; i < 8; ++i) ld[i] = *(const GAS f32x4*)(W + (size_t)(k0 + (lane >> 3) + 8 * i) * N + n0 + 4 * (lane & 7));
#pragma unroll
    for (int i = 0; i < 8; ++i) { LAS float* d = scr + ((lane >> 3) + 8 * i) * 33 + 4 * (lane & 7); d[0] = ld[i].x; d[1] = ld[i].y; d[2] = ld[i].z; d[3] = ld[i].w; }
    LDS_WAIT(); asm volatile("" ::: "memory");
    const int c = lane & 7;
#pragma unroll
    for (int j = 0; j < 4; ++j) { const int n = (lane >> 3) + 8 * j; const LAS float* sp = scr + (8 * c) * 33 + n;
        v2u o; o.x = pk4_fp8(sp[0 * 33] * qs, sp[1 * 33] * qs, sp[2 * 33] * qs, sp[3 * 33] * qs); o.y = pk4_fp8(sp[4 * 33] * qs, sp[5 * 33] * qs, sp[6 * 33] * qs, sp[7 * 33] * qs);
        const int ng = n0 + n, drow = row_off + (ng / nb) * nstride + (ng % nb);
        *(GAS v2u*)(WT + (size_t)drow * ldk + k0 + 8 * c) = o; }
    LDS_WAIT(); asm volatile("" ::: "memory");
}

DI void absmax_item(const GAS float* W, int N, GAS unsigned* cmaxbits, int item, int lane) {
    const int nblk = N / 256, kb = item / nblk, nbi = item % nblk;
    const GAS float* p = W + (size_t)(64 * kb) * N + 256 * nbi + 4 * lane;
    f32x4 m = (f32x4){0.f, 0.f, 0.f, 0.f};
#pragma unroll 8
    for (int k = 0; k < 64; ++k) { const f32x4 w = *(const GAS f32x4*)(p + (size_t)k * N); m.x = fmaxf(m.x, fabsf(w.x)); m.y = fmaxf(m.y, fabsf(w.y)); m.z = fmaxf(m.z, fabsf(w.z)); m.w = fmaxf(m.w, fabsf(w.w)); }
    GAS unsigned* c = cmaxbits + 256 * nbi + 4 * lane;
    __hip_atomic_fetch_max(c + 0, __float_as_uint(m.x), __ATOMIC_RELAXED, __HIP_MEMORY_SCOPE_AGENT); __hip_atomic_fetch_max(c + 1, __float_as_uint(m.y), __ATOMIC_RELAXED, __HIP_MEMORY_SCOPE_AGENT);
    __hip_atomic_fetch_max(c + 2, __float_as_uint(m.z), __ATOMIC_RELAXED, __HIP_MEMORY_SCOPE_AGENT); __hip_atomic_fetch_max(c + 3, __float_as_uint(m.w), __ATOMIC_RELAXED, __HIP_MEMORY_SCOPE_AGENT);
}
DI void tr_item_i8(const GAS float* W, int K, int N, GAS unsigned char* WT, int ldk, const GAS float* cmax, LAS float* scr, int item, int lane, int row_off = 0, int nb = 1 << 30, int nstride = 0) {
    const int nblk = N / 32, kb = item / nblk, nbi = item % nblk, k0 = 64 * kb, n0 = 32 * nbi;
    f32x4 ld[8];
#pragma unroll
    for (int i = 0; i < 8; ++i) ld[i] = *(const GAS f32x4*)(W + (size_t)(k0 + (lane >> 3) + 8 * i) * N + n0 + 4 * (lane & 7));
#pragma unroll
    for (int i = 0; i < 8; ++i) { LAS float* d = scr + ((lane >> 3) + 8 * i) * 33 + 4 * (lane & 7); d[0] = ld[i].x; d[1] = ld[i].y; d[2] = ld[i].z; d[3] = ld[i].w; }
    LDS_WAIT(); asm volatile("" ::: "memory");
    const int c = lane & 7;
#pragma unroll
    for (int j = 0; j < 4; ++j) { const int n = (lane >> 3) + 8 * j; const LAS float* sp = scr + (8 * c) * 33 + n;
        const float q = 127.0f / fmaxf(cmax[n0 + n], 1e-30f);
        v2u o; o.x = pk4_i8(sp[0 * 33] * q, sp[1 * 33] * q, sp[2 * 33] * q, sp[3 * 33] * q); o.y = pk4_i8(sp[4 * 33] * q, sp[5 * 33] * q, sp[6 * 33] * q, sp[7 * 33] * q);
        const int ng = n0 + n, drow = row_off + (ng / nb) * nstride + (ng % nb);
        *(GAS v2u*)(WT + (size_t)drow * ldk + k0 + 8 * c) = o; }
    LDS_WAIT(); asm volatile("" ::: "memory");
}

DI void p0_prologue(const Frame& F0, const Args& A) {
    const Frame F = fresh(F0);
    LAS float* scr = (LAS float*)(F.lds + F.wave * 16384);
    GAS unsigned char* ws = F.ws;
    constexpr int IT_IN = 16 * 160, IT_BR = 8 * 32, IT_O = 16 * 32, IT_F = 16 * 88, IT_FD = 44 * 32;
    constexpr int PER_L = IT_BR + IT_O;
    constexpr int NITEMS = 2 * PER_L + IT_FD;
    for (int it = F.gw; it < NITEMS; it += F.NGW) {
        int r = it;
        if (r < 2 * PER_L) { const int l = r / PER_L; r -= l * PER_L;
            if (r < IT_BR) { tr_item(((const GAS float*)A.in[I_WBR]) + (size_t)l * DH * D, DH, D, (GAS bf16*)(ws + WS_WR) + (size_t)l * D * DH, DH, 0, 0, 1 << 30, 0, scr, r, F.lane); continue; } r -= IT_BR;
            tr_item(((const GAS float*)A.in[I_WOUT]) + (size_t)l * D * D, D, D, (GAS bf16*)(ws + WS_WO) + (size_t)l * D * D, D, 0, 0, 1 << 30, 0, scr, r, F.lane); continue; }
        r -= 2 * PER_L;
        tr_item8(((const GAS float*)A.in[I_FD]), DFF, D, ws + WS_WD, DFF, 0, 1 << 30, 0, 64.f, scr, r, F.lane);
    }
    for (int it = F.gw; it < 2 * 16 * 20; it += F.NGW) { const int l = it / 320;
        absmax_item(((const GAS float*)A.in[I_WIN]) + (size_t)l * D * INC, INC, (GAS unsigned*)(ws + WS_CTL) + CW_CMAX_IN + l * INC, it % 320, F.lane); }
    for (int it = F.gw; it < 2 * 16 * 11; it += F.NGW) { const int w = it / 176;
        absmax_item((const GAS float*)A.in[w ? I_FU : I_FG], DFF, (GAS unsigned*)(ws + WS_CTL) + (w ? CW_CMAX_FU : CW_CMAX_FG), it % 176, F.lane); }
    for (int item = blockIdx.x; item < 2 * 4 * 16 * 2; item += F.G) {
        const int l = item >> 7, g = (item >> 5) & 3, cb = (item >> 1) & 15, n = (item & 1) * 512 + F.tid;
        const GAS float* pw = ((const GAS float*)A.in[I_POOLW]) + (((size_t)l * 4 + g) * 128 + cb * 8) * 128;
        const GAS float* ps = ((const GAS float*)A.in[I_POOLS]) + l * DH + g * 128;
        const GAS float* wp = ((const GAS float*)A.in[I_WBP]) + ((size_t)l * DH + g * 128) * D + n;
        float acc[8];
#pragma unroll
        for (int j = 0; j < 8; ++j) acc[j] = 0.f;
#pragma unroll 8
        for (int e = 0; e < 128; ++e) { const float w = wp[(size_t)e * D] * ps[e];
#pragma unroll
            for (int j = 0; j < 8; ++j) acc[j] += pw[j * 128 + e] * w; }
        v4u o; o.x = pk2(acc[0], acc[1]); o.y = pk2(acc[2], acc[3]); o.z = pk2(acc[4], acc[5]); o.w = pk2(acc[6], acc[7]);
        *(GAS v4u*)((GAS bf16*)(ws + WS_WP) + ((size_t)l * D + n) * DH + g * 128 + cb * 8) = o;
    }
    for (int i = blockIdx.x * NTHR + F.tid; i < 2 * 2 * DH; i += F.G * NTHR) {
        const int l = i / (2 * DH), rem = i % (2 * DH);
        float v = 0.f;
        if (l == 1) { const float h0 = ((const GAS float*)A.in[I_LB])[rem], h1 = ((const GAS float*)A.in[I_LB])[2 * DH + rem]; v = 1.f / (1.f + expf(h0 - h1)); }
        ((GAS float*)(ws + WS_LB))[i] = v;
    }
    __syncthreads();
    constexpr int TP = 1026;
    LAS float* T = (LAS float*)F.lds;
    for (int item = blockIdx.x; item < 2 * 96; item += F.G) {
        const int l = item / 96, e0 = (item % 96) * 64;
        for (int i = F.tid; i < 33 * 1024; i += NTHR) { const int bb = i >> 10, k = i & 1023; const float cv = bb < 32 ? ((const GAS float*)A.in[I_C])[bb * 1024 + k] : ((const GAS float*)A.in[I_CCTX])[k];
            T[bb * TP + k] = cv * __builtin_amdgcn_rcpf(1.0f + __builtin_amdgcn_exp2f(-1.4426950408889634f * cv)); }
        __syncthreads();
        const int kq = F.wave, j = F.lane & 31, kk = F.lane >> 5;
        const GAS float* wp = ((const GAS float*)A.in[I_ADAW]) + (size_t)l * D * 6144 + (size_t)(128 * kq + kk) * 6144 + e0 + 2 * j;
        const LAS float* tp = T + j * TP + 128 * kq + kk; const LAS float* t32 = T + 32 * TP + 128 * kq + kk;
        f32x16 acc0, acc1;
#pragma unroll
        for (int r = 0; r < 16; ++r) { acc0[r] = 0.f; acc1[r] = 0.f; }
        float c0 = 0.f, c1 = 0.f;
#pragma unroll 1
        for (int bt = 0; bt < 8; ++bt) { f32x2 wb[8];
#pragma unroll
            for (int u = 0; u < 8; ++u) wb[u] = *(const GAS f32x2*)(wp + (size_t)(2 * (8 * bt + u)) * 6144);
#pragma unroll
            for (int u = 0; u < 8; ++u) { const int s2 = 8 * bt + u; const float a = tp[2 * s2], tc = t32[2 * s2]; const f32x2 w = wb[u];
                acc0 = __builtin_amdgcn_mfma_f32_32x32x2f32(a, w.x, acc0, 0, 0, 0);
                acc1 = __builtin_amdgcn_mfma_f32_32x32x2f32(a, w.y, acc1, 0, 0, 0);
                c0 += tc * w.x; c1 += tc * w.y; }
        }
        c0 += __shfl_xor(c0, 32); c1 += __shfl_xor(c1, 32);
        __syncthreads();
        LAS float* R = (LAS float*)F.lds;
#pragma unroll
        for (int r = 0; r < 16; ++r) { const int i = 8 * (r >> 2) + 4 * kk + (r & 3); R[(kq * 33 + i) * 64 + 2 * j] = acc0[r]; R[(kq * 33 + i) * 64 + 2 * j + 1] = acc1[r]; }
        if (kk == 0) { R[(kq * 33 + 32) * 64 + 2 * j] = c0; R[(kq * 33 + 32) * 64 + 2 * j + 1] = c1; }
        __syncthreads();
        for (int i = F.tid; i < 33 * 64; i += NTHR) { const int b = i >> 6, c = i & 63; float sm = 0.f;
#pragma unroll
            for (int q = 0; q < 8; ++q) sm += R[(q * 33 + b) * 64 + c];
            ((GAS float*)(ws + WS_MOD))[((size_t)l * 33 + b) * 6144 + e0 + c] = sm + ((const GAS float*)A.in[I_ADAB])[l * 6144 + e0 + c]; }
        __syncthreads();
    }
}

DI void win_to_i8(const Frame& F0, const Args& A) {
    const Frame F = fresh(F0);
    LAS float* scr = (LAS float*)(F.lds + F.wave * 16384);
    for (int it = F.gw; it < 2 * 16 * 160; it += F.NGW) { const int l = it / 2560;
        tr_item_i8(((const GAS float*)A.in[I_WIN]) + (size_t)l * D * INC, D, INC, F.ws + WS_WIN + (size_t)l * INC * D, D, (const GAS float*)(F.ws + WS_CTL) + CW_CMAX_IN + l * INC, scr, it % 2560, F.lane); }
    for (int it = F.gw; it < 2 * 16 * 88; it += F.NGW) { const int w = it / 1408;
        tr_item_i8((const GAS float*)A.in[w ? I_FU : I_FG], D, DFF, F.ws + WS_WGU, D, (const GAS float*)(F.ws + WS_CTL) + (w ? CW_CMAX_FU : CW_CMAX_FG), scr, it % 1408, F.lane, w ? 128 : 0, 128, 256); }
}
constexpr int MOE_CONV_ITEMS = NE * (2 * 16 * 112 + 56 * 32), MOE_C1 = 16000, MOE_C2 = 8000;
DI void moe_weight_convert(const Frame& F0, const Args& A, int it0, int it1, int wg0) {
    const Frame F = fresh(F0);
    if ((int)blockIdx.x < wg0) return;
    LAS float* scr = (LAS float*)(F.lds + F.wave * 16384);
    constexpr int IT_G = 16 * 112, IT_D = 56 * 32, PER_E = 2 * IT_G + IT_D;
    for (int it = it0 + ((int)blockIdx.x - wg0) * NWAVES + F.wave; it < it1; it += (F.G - wg0) * NWAVES) {
        const int e = it / PER_E; int r = it % PER_E;
        GAS unsigned char* gu = F.ws + WS_MGU + (size_t)e * 2 * DEX * D;
        if (r < IT_G) { tr_item8(((const GAS float*)A.in[I_MG]) + (size_t)e * D * DEX, D, DEX, gu, D, 0, 128, 256, 32.f, scr, r, F.lane); continue; } r -= IT_G;
        if (r < IT_G) { tr_item8(((const GAS float*)A.in[I_MU]) + (size_t)e * D * DEX, D, DEX, gu, D, 128, 128, 256, 32.f, scr, r, F.lane); continue; } r -= IT_G;
        tr_item8(((const GAS float*)A.in[I_MD]) + (size_t)e * DEX * D, DEX, D, F.ws + WS_MD + (size_t)e * D * DEX, DEX, 0, 1 << 30, 0, 64.f, scr, r, F.lane);
    }
}

struct RowVecs { f32x4 a1[4], a2[4], a3[4]; };
DI void load_rowvecs(RowVecs& V, const GAS float* gatev, const GAS float* postg, const GAS float* preg, const GAS float* sc, const GAS float* sh, int lane) {
#pragma unroll
    for (int j = 0; j < 4; ++j) { const int e = 4 * lane + 256 * j;
        if (gatev) { const f32x4 g = *(const GAS f32x4*)(gatev + e), p = *(const GAS f32x4*)(postg + e); V.a1[j] = g * p; } else V.a1[j] = (f32x4){0.f, 0.f, 0.f, 0.f};
        if (preg) { const f32x4 p = *(const GAS f32x4*)(preg + e), s = *(const GAS f32x4*)(sc + e); V.a2[j] = p * (s + 1.0f); V.a3[j] = *(const GAS f32x4*)(sh + e); }
        else { V.a2[j] = (f32x4){0.f, 0.f, 0.f, 0.f}; V.a3[j] = V.a2[j]; } }
}
struct RowData { f32x4 x[4]; v2u y[4]; };
DI GAS bf16* xb_row(GAS float* out, int r) { return (GAS bf16*)(out + (size_t)r * D) + D; }
DI void row_load(RowData& R, const GAS float* xin, const GAS bf16* xinb, const GAS bf16* y, int lane) {
    if (xinb) {
#pragma unroll
        for (int j = 0; j < 4; ++j) { const v2u w = *(const GAS v2u*)(xinb + 4 * lane + 256 * j); R.x[j] = (f32x4){bflo(w.x), bfhi(w.x), bflo(w.y), bfhi(w.y)}; }
    } else {
#pragma unroll
        for (int j = 0; j < 4; ++j) R.x[j] = *(const GAS f32x4*)(xin + 4 * lane + 256 * j);
    }
    if (y) {
#pragma unroll
        for (int j = 0; j < 4; ++j) R.y[j] = *(const GAS v2u*)(y + 4 * lane + 256 * j);
    }
}
DI void row_compute(const RowData& R, bool hasy, GAS float* xout, GAS bf16* xoutb, GAS bf16* hout, const RowVecs& V, int lane, f32x4 (&hv)[4], GAS unsigned char* hout8 = nullptr, GAS unsigned char* hout_i8 = nullptr, GAS float* rs_out = nullptr) {
    f32x4 v[4];
#pragma unroll
    for (int j = 0; j < 4; ++j) v[j] = R.x[j];
    if (hasy) {
        f32x4 yv[4]; float ss = 0.f;
#pragma unroll
        for (int j = 0; j < 4; ++j) { const v2u w = R.y[j]; yv[j] = (f32x4){bflo(w.x), bfhi(w.x), bflo(w.y), bfhi(w.y)};
            ss += (yv[j].x * yv[j].x + yv[j].y * yv[j].y) + (yv[j].z * yv[j].z + yv[j].w * yv[j].w); }
        const float r = 1.0f / sqrtf(wave_sum(ss) * (1.0f / D) + EPS);
#pragma unroll
        for (int j = 0; j < 4; ++j) v[j] += V.a1[j] * (yv[j] * r);
    }
    if (xout) {
#pragma unroll
        for (int j = 0; j < 4; ++j) *(GAS f32x4*)(xout + 4 * lane + 256 * j) = v[j];
    }
    if (xoutb) {
#pragma unroll
        for (int j = 0; j < 4; ++j) { v2u w; w.x = pk2(v[j].x, v[j].y); w.y = pk2(v[j].z, v[j].w); *(GAS v2u*)(xoutb + 4 * lane + 256 * j) = w; }
    }
    if (hout || hout8 || hout_i8) {
        float ss = 0.f;
#pragma unroll
        for (int j = 0; j < 4; ++j) ss += (v[j].x * v[j].x + v[j].y * v[j].y) + (v[j].z * v[j].z + v[j].w * v[j].w);
        const float r = 1.0f / sqrtf(wave_sum(ss) * (1.0f / D) + EPS);
#pragma unroll
        for (int j = 0; j < 4; ++j) hv[j] = (v[j] * r) * V.a2[j] + V.a3[j];
        if (hout_i8) {
            float m = 0.f;
#pragma unroll
            for (int j = 0; j < 4; ++j) m = fmaxf(m, fmaxf(fmaxf(fabsf(hv[j].x), fabsf(hv[j].y)), fmaxf(fabsf(hv[j].z), fabsf(hv[j].w))));
            m = fmaxf(wave_max(m), 1e-30f); const float isc = 127.0f / m;
#pragma unroll
            for (int j = 0; j < 4; ++j) *(GAS unsigned*)(hout_i8 + 4 * lane + 256 * j) = pk4_i8(hv[j].x * isc, hv[j].y * isc, hv[j].z * isc, hv[j].w * isc);
            if (lane == 0) *rs_out = m * (1.0f / 127.0f);
        } else
#pragma unroll
        for (int j = 0; j < 4; ++j) {
            if (hout8) *(GAS unsigned*)(hout8 + 4 * lane + 256 * j) = pk4_fp8(hv[j].x, hv[j].y, hv[j].z, hv[j].w);
            else { v2u w; w.x = pk2(hv[j].x, hv[j].y); w.y = pk2(hv[j].z, hv[j].w); *(GAS v2u*)(hout + 4 * lane + 256 * j) = w; } }
    }
}
DI const GAS float* modp(const Frame& F, int l, int bb, int which) { return (const GAS float*)(F.ws + WS_MOD) + ((size_t)l * 33 + bb) * 6144 + which * 1024; }

DI void route_row(const Frame& F, const LAS float* RT, LAS unsigned* lcount, const f32x4 (&hv)[4], int r) {
                float lg[8];
#pragma unroll
                for (int e = 0; e < 8; ++e) lg[e] = 0.f;
#pragma unroll
                for (int j = 0; j < 4; ++j)
#pragma unroll
                    for (int i = 0; i < 4; ++i) { const LAS float* rp = RT + (4 * F.lane + 256 * j + i) * 8; const f32x4 ra = *(const LAS f32x4*)rp, rb = *(const LAS f32x4*)(rp + 4); const float hx = hv[j][i];
                        lg[0] += hx * ra.x; lg[1] += hx * ra.y; lg[2] += hx * ra.z; lg[3] += hx * ra.w; lg[4] += hx * rb.x; lg[5] += hx * rb.y; lg[6] += hx * rb.z; lg[7] += hx * rb.w; }
#pragma unroll
                for (int e = 0; e < 8; ++e) lg[e] = wave_sum(lg[e]);
                int e0 = 0; float v0 = lg[0];
#pragma unroll
                for (int e = 1; e < 8; ++e) if (lg[e] > v0) { v0 = lg[e]; e0 = e; }
                int e1 = -1; float v1 = -3.0e38f;
#pragma unroll
                for (int e = 0; e < 8; ++e) if (e != e0 && lg[e] > v1) { v1 = lg[e]; e1 = e; }
                if (F.lane == 0) {
                    const float p1 = 1.0f / (1.0f + expf(v0 - v1)), p0 = 1.0f - p1;
                    const int sl = slice_of(r);
                    const unsigned k0 = __hip_atomic_fetch_add(lcount + sl * 8 + e0, 1u, __ATOMIC_RELAXED, __HIP_MEMORY_SCOPE_WORKGROUP), k1 = __hip_atomic_fetch_add(lcount + sl * 8 + e1, 1u, __ATOMIC_RELAXED, __HIP_MEMORY_SCOPE_WORKGROUP);
                    ((GAS i32x2*)(F.ws + WS_RTOP))[r] = (i32x2){e0, e1};
                    ((GAS f32x2*)(F.ws + WS_RPROB))[r] = (f32x2){p0, p1};
                    ((GAS i32x2*)(F.ws + WS_RRANK))[r] = (i32x2){(int)k0, (int)k1};
                }
}
template <int MODE>
DI void rows_phase(const Frame& F0, const Args& A, int l, bool dry = false) {
    const Frame F = fresh(F0);
    GAS bf16* H = (GAS bf16*)(F.ws + WS_H); GAS bf16* CX = (GAS bf16*)(F.ws + WS_CX);
    const bool route = (MODE == 1 && l == 1) && (!dry || F.never);
    const bool st = !dry || F.never;
    LAS unsigned* lcount = (LAS unsigned*)(F.lds + 64);
    LAS unsigned* lbase = (LAS unsigned*)(F.lds + 256);
    LAS float* RT = (LAS float*)(F.lds + 1024);
    if (route) {
        if (F.tid < 32) lcount[F.tid] = 0u;
        for (int i = F.tid; i < 1024 * 8; i += NTHR) RT[i] = ((const GAS float*)A.in[I_ROUTER])[i];
        __syncthreads();
    }
    RowVecs V; f32x4 hv[4];
    for (int r0 = F.gw * 32; r0 < NX; r0 += F.NGW * 32) {
        const int b = r0 >> 11;
        if (MODE == 0) load_rowvecs(V, nullptr, nullptr, ((const GAS float*)A.in[I_MIXPRE]), modp(F, 0, b, 1), modp(F, 0, b, 0), F.lane);
        if (MODE == 1) load_rowvecs(V, modp(F, l, b, 2), ((const GAS float*)A.in[I_MIXPOST]) + l * D, ((const GAS float*)A.in[I_FFNPRE]) + l * D, modp(F, l, b, 4), modp(F, l, b, 3), F.lane);
        if (MODE == 2) load_rowvecs(V, modp(F, 0, b, 5), ((const GAS float*)A.in[I_FFNPOST]), ((const GAS float*)A.in[I_MIXPRE]) + D, modp(F, 1, b, 1), modp(F, 1, b, 0), F.lane);
        const bool toi = (MODE == 0 || MODE == 2 || (MODE == 1 && l == 0)); GAS float* RS = (GAS float*)(F.ws + WS_RS);
        const bool to8 = (MODE == 1 && l == 1); GAS unsigned char* H8 = F.ws + WS_H8;
        const bool xf32 = (MODE == 0 || (MODE == 1 && l == 0));
        const GAS float* xbase = (const GAS float*)A.in[I_X];
#define XIN_F(r) (xf32 ? xbase + (size_t)(r) * D : (const GAS float*)nullptr)
#define XIN_B(r) (xf32 ? (const GAS bf16*)nullptr : (const GAS bf16*)xb_row(F.out, (r)))
        RowData Ra, Rb;
        row_load(Ra, XIN_F(r0), XIN_B(r0), MODE == 0 ? nullptr : H + (size_t)r0 * D, F.lane);
        for (int r = r0; r < r0 + 32; r += 2) {
            row_load(Rb, XIN_F(r + 1), XIN_B(r + 1), MODE == 0 ? nullptr : H + (size_t)(r + 1) * D, F.lane);
            row_compute(Ra, MODE != 0, nullptr, (MODE == 0 || !st) ? nullptr : xb_row(F.out, r), (st && !to8 && !toi) ? H + (size_t)r * D : nullptr, V, F.lane, hv, (st && to8) ? H8 + (size_t)r * D : nullptr, (st && toi) ? (GAS unsigned char*)(H + (size_t)r * D) : nullptr, RS + r);
            if (route) route_row(F, RT, lcount, hv, r);
            if (r + 2 < r0 + 32) row_load(Ra, XIN_F(r + 2), XIN_B(r + 2), MODE == 0 ? nullptr : H + (size_t)(r + 2) * D, F.lane);
            row_compute(Rb, MODE != 0, nullptr, (MODE == 0 || !st) ? nullptr : xb_row(F.out, r + 1), (st && !to8 && !toi) ? H + (size_t)(r + 1) * D : nullptr, V, F.lane, hv, (st && to8) ? H8 + (size_t)(r + 1) * D : nullptr, (st && toi) ? (GAS unsigned char*)(H + (size_t)(r + 1) * D) : nullptr, RS + r + 1);
            if (route) route_row(F, RT, lcount, hv, r + 1);
        }
#undef XIN_F
#undef XIN_B
    }
    if (route) {
        __syncthreads();
        if (F.tid < 32) lbase[F.tid] = __hip_atomic_fetch_add((GAS unsigned*)(F.ws + WS_CTL) + CW_GCOUNT + 64 * F.tid, lcount[F.tid], __ATOMIC_RELAXED, __HIP_MEMORY_SCOPE_AGENT);
        __syncthreads();
        VM_WAIT();
        if (F.lane < 32) {
            for (int r0 = F.gw * 32; r0 < NX; r0 += F.NGW * 32) { const int r = r0 + F.lane; const int sl = slice_of(r); const i32x2 t = ((GAS i32x2*)(F.ws + WS_RTOP))[r]; i32x2 k = ((GAS i32x2*)(F.ws + WS_RRANK))[r];
                    k.x += (int)lbase[sl * 8 + t.x]; k.y += (int)lbase[sl * 8 + t.y]; ((GAS i32x2*)(F.ws + WS_RRANK))[r] = k; }
        }
    }
    if (MODE == 0 || MODE == 2 || (MODE == 1 && l == 0)) {
        if (MODE == 0) load_rowvecs(V, nullptr, nullptr, ((const GAS float*)A.in[I_MIXPRE]), modp(F, 0, 32, 1), modp(F, 0, 32, 0), F.lane);
        if (MODE == 1) load_rowvecs(V, modp(F, 0, 32, 2), ((const GAS float*)A.in[I_MIXPOST]), ((const GAS float*)A.in[I_FFNPRE]), modp(F, 0, 32, 4), modp(F, 0, 32, 3), F.lane);
        if (MODE == 2) load_rowvecs(V, modp(F, 0, 32, 5), ((const GAS float*)A.in[I_FFNPOST]), ((const GAS float*)A.in[I_MIXPRE]) + D, modp(F, 1, 32, 1), modp(F, 1, 32, 0), F.lane);
        const GAS float* cbase = (const GAS float*)A.in[I_CTX];
        for (int r0 = F.gw * 4; r0 < NC; r0 += F.NGW * 4) {
            RowData Rd[4];
#pragma unroll
            for (int i = 0; i < 4; ++i) row_load(Rd[i], cbase + (size_t)(r0 + i) * D, MODE == 2 ? (const GAS bf16*)CX + (size_t)(r0 + i) * D : (const GAS bf16*)nullptr, MODE == 0 ? nullptr : H + (size_t)(NX + r0 + i) * D, F.lane);
#pragma unroll
            for (int i = 0; i < 4; ++i) { const int r = r0 + i;
                row_compute(Rd[i], MODE != 0, nullptr, (MODE == 1 && st) ? CX + (size_t)r * D : nullptr, nullptr, V, F.lane, hv, nullptr,
                            st ? (GAS unsigned char*)(H + (size_t)(NX + r) * D) : nullptr, (GAS float*)(F.ws + WS_RS) + NX + r); }
        }
    }
}

constexpr int SC_CUM = 0, SC_TOT = 32768, SC_VT = 34816, SC_QM = 53248, SC_KM = 70656, SC_QD = 70656, SC_KDT = 88064, SC_AL = 114176, SC_ST = 123392, SC_DEC = 158208, SC_END = 158720;
constexpr int PQ = 272, PV = 144;
static_assert(SC_KDT + 128 * PV <= SC_AL && SC_QD + 64 * PQ <= SC_KDT && SC_KM + 160 * PQ <= SC_AL && SC_AL + 64 * PV <= SC_ST && SC_ST + 128 * PQ <= SC_DEC, "scan LDS map");
DI int scan_row(int b, int dir, int s) { return s < CTX ? NX + b * CTX + (dir ? CTX - 1 - s : s) : b * SEQ + (dir ? SEQ - 1 - (s - CTX) : (s - CTX)); }
DI float ex2(float x) { return __builtin_amdgcn_exp2f(x); }
DI void unpack8(const v4u w, float (&o)[8]) { o[0] = bflo(w.x); o[1] = bfhi(w.x); o[2] = bflo(w.y); o[3] = bfhi(w.y); o[4] = bflo(w.z); o[5] = bfhi(w.z); o[6] = bflo(w.w); o[7] = bfhi(w.w); }
DI v4u pack8(const float (&o)[8]) { v4u w; w.x = pk2(o[0], o[1]); w.y = pk2(o[2], o[3]); w.z = pk2(o[4], o[5]); w.w = pk2(o[6], o[7]); return w; }
DI void scan_phase(const Frame& F0, const Args& A, int l, bool dostore) {
    const Frame F = fresh(F0);
    (void)A;
    GAS bf16* P = (GAS bf16*)(F.ws + WS_P);
    LAS unsigned char* L = F.lds;
    const int tid = F.tid, lane = F.lane, w = F.wave, r = lane & 15, q4 = lane >> 4;
    const float L2E = 1.4426950408889634f;
    for (int ch = blockIdx.x; ch < 256; ch += F.G) {
        const int b = ch >> 3, h = (ch >> 1) & 3, dir = ch & 1;
        const int colq = C_Q + h * DK, colf = C_FF + dir * DH + h * DK, colv = C_V + h * DK;
        __syncthreads();
        for (int i = tid; i < (SC_DEC - SC_AL) / 16; i += NTHR) *(LAS v4u*)(L + SC_AL + 16 * i) = (v4u){0u, 0u, 0u, 0u};
        f32x4 accS[8];
#pragma unroll
        for (int t = 0; t < 8; ++t) accS[t] = (f32x4){0.f, 0.f, 0.f, 0.f};
        v4u qreg[2], lfreg[2]; unsigned vreg[8];
#pragma unroll
        for (int pi = 0; pi < 2; ++pi) { const int i = (tid >> 4) + 32 * pi, k0 = 8 * (tid & 15); const GAS bf16* rp = P + (size_t)scan_row(b, dir, i) * INC + k0;
            qreg[pi] = *(const GAS v4u*)(rp + colq); lfreg[pi] = *(const GAS v4u*)(rp + colf); }
#pragma unroll
        for (int e = 0; e < 8; ++e) vreg[e] = *(const GAS unsigned*)(P + (size_t)scan_row(b, dir, 8 * w + e) * INC + colv + 2 * lane);
        __syncthreads();
#pragma unroll 1
        for (int c = 0; c < (CTX + SEQ) / 64; ++c) {
            float qf[2][8], kk[2][8];
#pragma unroll
            for (int pi = 0; pi < 2; ++pi) { const int i = (tid >> 4) + 32 * pi, k0 = 8 * (tid & 15);
                float lf[8]; unpack8(lfreg[pi], lf); unpack8(qreg[pi], qf[pi]);
#pragma unroll
                for (int e = 0; e < 8; ++e) { lf[e] *= L2E; kk[pi][e] = 1.0f - ex2(lf[e]); }
                *(LAS f32x4*)(L + SC_CUM + (i * 128 + k0) * 4) = (f32x4){lf[0], lf[1], lf[2], lf[3]};
                *(LAS f32x4*)(L + SC_CUM + (i * 128 + k0) * 4 + 16) = (f32x4){lf[4], lf[5], lf[6], lf[7]}; }
            { v4u lo, hi;
              lo.x = (vreg[0] & 0xffffu) | (vreg[1] << 16); lo.y = (vreg[2] & 0xffffu) | (vreg[3] << 16); lo.z = (vreg[4] & 0xffffu) | (vreg[5] << 16); lo.w = (vreg[6] & 0xffffu) | (vreg[7] << 16);
              hi.x = (vreg[0] >> 16) | (vreg[1] & 0xffff0000u); hi.y = (vreg[2] >> 16) | (vreg[3] & 0xffff0000u); hi.z = (vreg[4] >> 16) | (vreg[5] & 0xffff0000u); hi.w = (vreg[6] >> 16) | (vreg[7] & 0xffff0000u);
              *(LAS v4u*)(L + SC_VT + (2 * lane) * PV + 16 * w) = lo; *(LAS v4u*)(L + SC_VT + (2 * lane + 1) * PV + 16 * w) = hi; }
            __syncthreads();
            { const int k = tid & 127, qd = tid >> 7; float run = 0.f;
#pragma unroll
              for (int s2 = 0; s2 < 16; ++s2) { LAS float* cp = (LAS float*)(L + SC_CUM) + (16 * qd + s2) * 128 + k; run += *cp; *cp = run; }
              ((LAS float*)(L + SC_TOT))[qd * 128 + k] = run; }
            __syncthreads();
            { const int k = tid & 127, I = tid >> 7; const LAS float* tp = (const LAS float*)(L + SC_TOT) + k; const LAS float* cm = (const LAS float*)(L + SC_CUM) + 7 * 128 + k;
              const float t0 = tp[0], t1 = tp[128], t2 = tp[256], t3 = tp[384];
              const float p1 = t0, p2 = t0 + t1, p3 = p2 + t2, tt = p3 + t3;
              const float R0 = cm[0], R1 = cm[16 * 128] + p1, R2 = cm[32 * 128] + p2, R3 = cm[48 * 128] + p3;
              const float RI = (I == 0) ? R0 : (I == 1) ? R1 : (I == 2) ? R2 : R3;
              LAS float* QF = (LAS float*)(L + SC_AL); LAS float* FT = QF + 512;
              QF[I * 128 + k] = ex2(RI);
              if (I == 0) { FT[0 * 128 + k] = ex2(R1 - R0); FT[1 * 128 + k] = ex2(R2 - R0); FT[3 * 128 + k] = ex2(R3 - R0); }
              if (I == 1) { FT[2 * 128 + k] = ex2(R2 - R1); FT[4 * 128 + k] = ex2(R3 - R1); }
              if (I == 2) { FT[5 * 128 + k] = ex2(R3 - R2); }
              if (I == 3) ((LAS float*)(L + SC_DEC))[k] = ex2(tt); }
            __syncthreads();
            v4u qdreg[2];
#pragma unroll
            for (int pi = 0; pi < 2; ++pi) { const int i = (tid >> 4) + 32 * pi, k0 = 8 * (tid & 15), I = i >> 4;
                float cl[8], cmid[8], qm[8], km[8], o8[8];
                { const f32x4 a = *(const LAS f32x4*)(L + SC_CUM + (i * 128 + k0) * 4), bq = *(const LAS f32x4*)(L + SC_CUM + (i * 128 + k0) * 4 + 16);
                  cl[0] = a.x; cl[1] = a.y; cl[2] = a.z; cl[3] = a.w; cl[4] = bq.x; cl[5] = bq.y; cl[6] = bq.z; cl[7] = bq.w; }
                { const f32x4 a = *(const LAS f32x4*)(L + SC_CUM + ((16 * I + 7) * 128 + k0) * 4), bq = *(const LAS f32x4*)(L + SC_CUM + ((16 * I + 7) * 128 + k0) * 4 + 16);
                  cmid[0] = a.x; cmid[1] = a.y; cmid[2] = a.z; cmid[3] = a.w; cmid[4] = bq.x; cmid[5] = bq.y; cmid[6] = bq.z; cmid[7] = bq.w; }
#pragma unroll
                for (int e = 0; e < 8; ++e) { const float dlt = cl[e] - cmid[e]; qm[e] = qf[pi][e] * ex2(fminf(dlt, 86.f)); km[e] = kk[pi][e] * ex2(fminf(-dlt, 86.f)); }
                *(LAS v4u*)(L + SC_QM + i * PQ + 2 * k0) = pack8(qm);
                *(LAS v4u*)(L + SC_KM + (8 * I * (I + 1) + i) * PQ + 2 * k0) = pack8(km);
                { const f32x4 a = *(const LAS f32x4*)(L + SC_AL + (I * 128 + k0) * 4), bq = *(const LAS f32x4*)(L + SC_AL + (I * 128 + k0) * 4 + 16);
                  o8[0] = qm[0] * a.x; o8[1] = qm[1] * a.y; o8[2] = qm[2] * a.z; o8[3] = qm[3] * a.w; o8[4] = qm[4] * bq.x; o8[5] = qm[5] * bq.y; o8[6] = qm[6] * bq.z; o8[7] = qm[7] * bq.w; }
                qdreg[pi] = pack8(o8);
#pragma unroll
                for (int Ip = 1; Ip < 4; ++Ip) if (Ip > I) { const int pr = Ip * (Ip - 1) / 2 + I;
                    const f32x4 a = *(const LAS f32x4*)(L + SC_AL + 2048 + (pr * 128 + k0) * 4), bq = *(const LAS f32x4*)(L + SC_AL + 2048 + (pr * 128 + k0) * 4 + 16);
                    o8[0] = km[0] * a.x; o8[1] = km[1] * a.y; o8[2] = km[2] * a.z; o8[3] = km[3] * a.w; o8[4] = km[4] * bq.x; o8[5] = km[5] * bq.y; o8[6] = km[6] * bq.z; o8[7] = km[7] * bq.w;
                    *(LAS v4u*)(L + SC_KM + (8 * Ip * (Ip + 1) + i) * PQ + 2 * k0) = pack8(o8); } }
            __syncthreads();
            if (c + 1 < (CTX + SEQ) / 64) {
#pragma unroll
                for (int pi = 0; pi < 2; ++pi) { const int i = (tid >> 4) + 32 * pi, k0 = 8 * (tid & 15); const GAS bf16* rp = P + (size_t)scan_row(b, dir, 64 * (c + 1) + i) * INC + k0;
                    qreg[pi] = *(const GAS v4u*)(rp + colq); lfreg[pi] = *(const GAS v4u*)(rp + colf); }
#pragma unroll
                for (int e = 0; e < 8; ++e) vreg[e] = *(const GAS unsigned*)(P + (size_t)scan_row(b, dir, 64 * (c + 1) + 8 * w + e) * INC + colv + 2 * lane);
            }
#pragma unroll 1
            for (int bl = w; bl < 10; bl += 8) {
                const int I = (bl >= 6) ? 3 : (bl >= 3) ? 2 : (bl >= 1) ? 1 : 0, J = bl - I * (I + 1) / 2;
                f32x4 acc = (f32x4){0.f, 0.f, 0.f, 0.f};
#pragma unroll
                for (int ks = 0; ks < 4; ++ks) { const bf16x8 a = *(const LAS bf16x8*)(L + SC_QM + (16 * I + r) * PQ + 64 * ks + 16 * q4);
                    const bf16x8 bb = *(const LAS bf16x8*)(L + SC_KM + (8 * I * (I + 1) + 16 * J + r) * PQ + 64 * ks + 16 * q4);
                    acc = __builtin_amdgcn_mfma_f32_16x16x32_bf16(a, bb, acc, 0, 0, 0); }
#pragma unroll
                for (int jj = 0; jj < 4; ++jj) { float x = acc[jj]; if (I == J && r > 4 * q4 + jj) x = 0.f;
                    *(LAS bf16*)(L + SC_AL + (16 * I + 4 * q4 + jj) * PV + 2 * (16 * J + r)) = (bf16)(pk2(x, 0.f) & 0xffffu); }
            }
            if (w == 2 || w == 3) { const int I = (w == 2) ? 0 : 2, J = I + 1;
#pragma unroll
                for (int jj = 0; jj < 4; ++jj) *(LAS bf16*)(L + SC_AL + (16 * I + 4 * q4 + jj) * PV + 2 * (16 * J + r)) = (bf16)0; }
            __syncthreads();
#pragma unroll
            for (int pi = 0; pi < 2; ++pi) { const int i = (tid >> 4) + 32 * pi, k0 = 8 * (tid & 15); *(LAS v4u*)(L + SC_QD + i * PQ + 2 * k0) = qdreg[pi]; }
            { const int k = tid & 127, qd = tid >> 7; const LAS float* tp = (const LAS float*)(L + SC_TOT) + k;
              const float t1 = tp[128], t2 = tp[256], t3 = tp[384];
              const float rest = (qd == 0) ? (t1 + t2) + t3 : (qd == 1) ? t2 + t3 : (qd == 2) ? t3 : 0.f;
              float cl[16], kd[16];
#pragma unroll
              for (int s2 = 0; s2 < 16; ++s2) cl[s2] = ((const LAS float*)(L + SC_CUM))[(16 * qd + s2) * 128 + k];
              float g = ex2(fminf(rest, 0.f));
#pragma unroll
              for (int s2 = 15; s2 >= 0; --s2) { const float f = ex2(cl[s2] - (s2 ? cl[s2 - 1] : 0.f)); kd[s2] = (1.0f - f) * g; g *= f; }
              v4u w0, w1; w0.x = pk2(kd[0], kd[1]); w0.y = pk2(kd[2], kd[3]); w0.z = pk2(kd[4], kd[5]); w0.w = pk2(kd[6], kd[7]);
              w1.x = pk2(kd[8], kd[9]); w1.y = pk2(kd[10], kd[11]); w1.z = pk2(kd[12], kd[13]); w1.w = pk2(kd[14], kd[15]);
              *(LAS v4u*)(L + SC_KDT + k * PV + 32 * qd) = w0; *(LAS v4u*)(L + SC_KDT + k * PV + 32 * qd + 16) = w1; }
            __syncthreads();
            { const int ip = w & 1, vp = w >> 1;
              f32x4 acc[2][2];
#pragma unroll
              for (int ii = 0; ii < 2; ++ii)
#pragma unroll
                  for (int tt = 0; tt < 2; ++tt) acc[ii][tt] = (f32x4){0.f, 0.f, 0.f, 0.f};
#pragma unroll
              for (int ks = 0; ks < 4; ++ks) { bf16x8 bq[2], a[2];
#pragma unroll
                  for (int ii = 0; ii < 2; ++ii) bq[ii] = *(const LAS bf16x8*)(L + SC_QD + (16 * (2 * ip + ii) + r) * PQ + 64 * ks + 16 * q4);
#pragma unroll
                  for (int tt = 0; tt < 2; ++tt) a[tt] = *(const LAS bf16x8*)(L + SC_ST + (16 * (2 * vp + tt) + r) * PQ + 64 * ks + 16 * q4);
#pragma unroll
                  for (int ii = 0; ii < 2; ++ii)
#pragma unroll
                      for (int tt = 0; tt < 2; ++tt) acc[ii][tt] = __builtin_amdgcn_mfma_f32_16x16x32_bf16(a[tt], bq[ii], acc[ii][tt], 0, 0, 0); }
#pragma unroll
              for (int js = 0; js < 2; ++js) if (js == 0 || ip == 1) { bf16x8 bA[2], a[2];
#pragma unroll
                  for (int ii = 0; ii < 2; ++ii) bA[ii] = *(const LAS bf16x8*)(L + SC_AL + (16 * (2 * ip + ii) + r) * PV + 64 * js + 16 * q4);
#pragma unroll
                  for (int tt = 0; tt < 2; ++tt) a[tt] = *(const LAS bf16x8*)(L + SC_VT + (16 * (2 * vp + tt) + r) * PV + 64 * js + 16 * q4);
#pragma unroll
                  for (int ii = 0; ii < 2; ++ii)
#pragma unroll
                      for (int tt = 0; tt < 2; ++tt) acc[ii][tt] = __builtin_amdgcn_mfma_f32_16x16x32_bf16(a[tt], bA[ii], acc[ii][tt], 0, 0, 0); }
              if (dostore && !(l == 1 && c < CTX / 64)) {
#pragma unroll
                  for (int ii = 0; ii < 2; ++ii) { GAS bf16* op = P + (size_t)scan_row(b, dir, 64 * c + 16 * (2 * ip + ii) + r) * INC + colf + 4 * q4;
#pragma unroll
                      for (int tt = 0; tt < 2; ++tt) { v2u o2; o2.x = pk2(acc[ii][tt][0], acc[ii][tt][1]); o2.y = pk2(acc[ii][tt][2], acc[ii][tt][3]); *(GAS v2u*)(op + 16 * (2 * vp + tt)) = o2; } }
              }
              const int kp = w >> 1, vh = w & 1;
#pragma unroll
              for (int kk = 0; kk < 2; ++kk) { const f32x4 dv = *(const LAS f32x4*)(L + SC_DEC + (16 * (2 * kp + kk) + 4 * q4) * 4);
#pragma unroll
                  for (int t4 = 0; t4 < 4; ++t4) accS[kk * 4 + t4] *= dv; }
#pragma unroll
              for (int js = 0; js < 2; ++js) { bf16x8 a[2], bv[4];
#pragma unroll
                  for (int kk = 0; kk < 2; ++kk) a[kk] = *(const LAS bf16x8*)(L + SC_KDT + (16 * (2 * kp + kk) + r) * PV + 64 * js + 16 * q4);
#pragma unroll
                  for (int t4 = 0; t4 < 4; ++t4) bv[t4] = *(const LAS bf16x8*)(L + SC_VT + (16 * (4 * vh + t4) + r) * PV + 64 * js + 16 * q4);
#pragma unroll
                  for (int kk = 0; kk < 2; ++kk)
#pragma unroll
                      for (int t4 = 0; t4 < 4; ++t4) accS[kk * 4 + t4] = __builtin_amdgcn_mfma_f32_16x16x32_bf16(a[kk], bv[t4], accS[kk * 4 + t4], 0, 0, 0); }
            }
            __syncthreads();
            { const int kp = w >> 1, vh = w & 1;
#pragma unroll
              for (int kk = 0; kk < 2; ++kk)
#pragma unroll
                  for (int t4 = 0; t4 < 4; ++t4) { const f32x4 sv = accS[kk * 4 + t4]; v2u s2; s2.x = pk2(sv[0], sv[1]); s2.y = pk2(sv[2], sv[3]);
                      *(LAS v2u*)(L + SC_ST + (16 * (4 * vh + t4) + r) * PQ + 2 * (16 * (2 * kp + kk) + 4 * q4)) = s2; } }
        }
    }
    __syncthreads();
}

DI void post_phase(const Frame& F0, const Args& A, int l, int part = 3, bool dry = false) {
    const Frame F = fresh(F0);
    GAS bf16* P = (GAS bf16*)(F.ws + WS_P);
    const int nrows = (l == 0) ? MALL : NX;
    if (part & 1) {
        const GAS float* gp = ((const GAS float*)A.in[I_GAIN]) + l * DH + 8 * F.lane;
        const f32x4 ga = *(const GAS f32x4*)gp, gb = *(const GAS f32x4*)(gp + 4);
        const float gn[8] = {ga.x, ga.y, ga.z, ga.w, gb.x, gb.y, gb.z, gb.w};
        v4u cur[6], nxt[6];
        if (F.gw < nrows) { const int r = F.gw; const bool two = (r + F.NGW) < nrows;
            const GAS bf16* q0 = P + (size_t)r * INC + 8 * F.lane; const GAS bf16* q1 = P + (size_t)(two ? r + F.NGW : r) * INC + 8 * F.lane;
            cur[0] = *(const GAS v4u*)(q0 + C_FF); cur[1] = *(const GAS v4u*)(q0 + C_FB); cur[2] = *(const GAS v4u*)(q0 + C_G);
            cur[3] = *(const GAS v4u*)(q1 + C_FF); cur[4] = *(const GAS v4u*)(q1 + C_FB); cur[5] = *(const GAS v4u*)(q1 + C_G); }
        for (int r = F.gw; r < nrows; r += 2 * F.NGW) {
            const bool two = (r + F.NGW) < nrows;
            GAS bf16* rp0 = P + (size_t)r * INC + 8 * F.lane; GAS bf16* rp1 = P + (size_t)(two ? r + F.NGW : r) * INC + 8 * F.lane;
            { const int rn = r + 2 * F.NGW;
              if (rn < nrows) { const bool twon = (rn + F.NGW) < nrows;
                  const GAS bf16* q0 = P + (size_t)rn * INC + 8 * F.lane; const GAS bf16* q1 = P + (size_t)(twon ? rn + F.NGW : rn) * INC + 8 * F.lane;
                  nxt[0] = *(const GAS v4u*)(q0 + C_FF); nxt[1] = *(const GAS v4u*)(q0 + C_FB); nxt[2] = *(const GAS v4u*)(q0 + C_G);
                  nxt[3] = *(const GAS v4u*)(q1 + C_FF); nxt[4] = *(const GAS v4u*)(q1 + C_FB); nxt[5] = *(const GAS v4u*)(q1 + C_G); } }
#pragma unroll
            for (int half = 0; half < 2; ++half) {
                if (half == 1 && !two) break;
                const v4u a = cur[3 * half], bq = cur[3 * half + 1], g = cur[3 * half + 2]; GAS bf16* rp = half ? rp1 : rp0;
                float o[8] = {bflo(a.x) + bflo(bq.x), bfhi(a.x) + bfhi(bq.x), bflo(a.y) + bflo(bq.y), bfhi(a.y) + bfhi(bq.y), bflo(a.z) + bflo(bq.z), bfhi(a.z) + bfhi(bq.z), bflo(a.w) + bflo(bq.w), bfhi(a.w) + bfhi(bq.w)};
                const float sg[8] = {bflo(g.x), bfhi(g.x), bflo(g.y), bfhi(g.y), bflo(g.z), bfhi(g.z), bflo(g.w), bfhi(g.w)};
                float ss = 0.f;
#pragma unroll
                for (int j = 0; j < 8; ++j) ss += o[j] * o[j];
                ss += __shfl_xor(ss, 1); ss += __shfl_xor(ss, 2); ss += __shfl_xor(ss, 4); ss += __shfl_xor(ss, 8);
                const float rr = 1.0f / sqrtf(ss * (1.0f / DK) + EPS);
#pragma unroll
                for (int j = 0; j < 8; ++j) o[j] = o[j] * rr * gn[j] * sg[j];
                v4u w; w.x = pk2(o[0], o[1]); w.y = pk2(o[2], o[3]); w.z = pk2(o[4], o[5]); w.w = pk2(o[6], o[7]);
                if (!dry || F.never) *(GAS v4u*)(rp + C_FF) = w;
            }
#pragma unroll
            for (int i = 0; i < 6; ++i) cur[i] = nxt[i];
        }
    }
    if (!(part & 2)) return;
    constexpr int PP = 520;
    LAS unsigned* U = (LAS unsigned*)F.lds;
    LAS unsigned* Vs = U + 32 * PP;
    v4u pre[8];
    { const int un = blockIdx.x;
      if (un < BATCH * 32) {
#pragma unroll
          for (int i = 0; i < 4; ++i) { const int t = F.tid + 512 * i; const GAS bf16* gp = P + (size_t)((un >> 5) * SEQ + t) * INC + C_U + (un & 31) * 16;
              pre[2 * i] = *(const GAS v4u*)gp; pre[2 * i + 1] = *(const GAS v4u*)(gp + 8); } } }
    REP(4) for (int un = blockIdx.x; un < BATCH * 32; un += F.G) {
        const int b = un >> 5, hx = un & 31, w = 2 << (hx >> 3), hw = w >> 1;
        __syncthreads();
#pragma unroll
        for (int i = 0; i < 4; ++i) { const int t = F.tid + 512 * i, gy = t >> 6, gx = t & 63;
            *(LAS v4u*)(U + gy * PP + gx * 8) = pre[2 * i]; *(LAS v4u*)(U + gy * PP + gx * 8 + 4) = pre[2 * i + 1]; }
        __syncthreads();
        { const int un2 = un + F.G;
          if (un2 < BATCH * 32) {
#pragma unroll
              for (int i = 0; i < 4; ++i) { const int t = F.tid + 512 * i; const GAS bf16* gp = P + (size_t)((un2 >> 5) * SEQ + t) * INC + C_U + (un2 & 31) * 16;
                  pre[2 * i] = *(const GAS v4u*)gp; pre[2 * i + 1] = *(const GAS v4u*)(gp + 8); } } }
        { float s0 = 0.f, s1 = 0.f;
          for (int y = 0; y < hw; ++y) { const unsigned u = U[y * PP + F.tid]; s0 += bflo(u); s1 += bfhi(u); }
#pragma unroll 4
          for (int gy = 0; gy < 32; ++gy) {
              Vs[gy * PP + F.tid] = pk2(s0, s1);
              if (gy + hw < 32) { const unsigned u = U[(gy + hw) * PP + F.tid]; s0 += bflo(u); s1 += bfhi(u); }
              if (gy - hw >= 0) { const unsigned u = U[(gy - hw) * PP + F.tid]; s0 -= bflo(u); s1 -= bfhi(u); }
          } }
        __syncthreads();
        { const int c4 = F.lane & 3, gy = (F.wave & 1) * 16 + (F.lane >> 2), x0 = (F.wave >> 1) * 16;
          const int cy = min(gy + hw, 32) - max(gy - hw, 0);
          const LAS unsigned* vr = Vs + gy * PP + c4 * 2; LAS unsigned* ur = U + gy * PP + c4 * 2;
          float s[4] = {0.f, 0.f, 0.f, 0.f};
          for (int x = max(x0 - hw, 0); x < min(x0 + hw, 64); ++x) { const v2u q = *(const LAS v2u*)(vr + x * 8); s[0] += bflo(q.x); s[1] += bfhi(q.x); s[2] += bflo(q.y); s[3] += bfhi(q.y); }
#pragma unroll 4
          for (int gx = x0; gx < x0 + 16; ++gx) {
              const int cx = min(gx + hw, 64) - max(gx - hw, 0);
              const float inv = __builtin_amdgcn_rcpf((float)(cy * cx));
              const v2u uc = *(const LAS v2u*)(ur + gx * 8);
              v2u o; o.x = pk2(s[0] * inv - bflo(uc.x), s[1] * inv - bfhi(uc.x)); o.y = pk2(s[2] * inv - bflo(uc.y), s[3] * inv - bfhi(uc.y));
              *(LAS v2u*)(ur + gx * 8) = o;
              if (gx + hw < 64) { const v2u q = *(const LAS v2u*)(vr + (gx + hw) * 8); s[0] += bflo(q.x); s[1] += bfhi(q.x); s[2] += bflo(q.y); s[3] += bfhi(q.y); }
              if (gx - hw >= 0) { const v2u q = *(const LAS v2u*)(vr + (gx - hw) * 8); s[0] -= bflo(q.x); s[1] -= bfhi(q.x); s[2] -= bflo(q.y); s[3] -= bfhi(q.y); }
          } }
        __syncthreads();
#pragma unroll
        for (int i = 0; i < 4; ++i) { const int t = F.tid + 512 * i, gy = t >> 6, gx = t & 63;
            const v4u q0 = *(const LAS v4u*)(U + gy * PP + gx * 8), q1 = *(const LAS v4u*)(U + gy * PP + gx * 8 + 4);
            GAS bf16* op = P + (size_t)(b * SEQ + t) * INC + C_Q + hx * 16;
            *(GAS v4u*)op = q0; *(GAS v4u*)(op + 8) = q1; }
    }
    __syncthreads();
    if (l == 0) { LAS unsigned char* Uc = F.lds;
        for (int un = blockIdx.x; un < BATCH * 32; un += F.G) {
            const int b = un >> 5, hx = un & 31, w = 2 << (hx >> 3), hw = w >> 1;
            __syncthreads();
            if (F.tid < CTX) { const GAS bf16* gp = P + (size_t)(NX + b * CTX + F.tid) * INC + C_U + hx * 16;
                const v4u q0 = *(const GAS v4u*)gp, q1 = *(const GAS v4u*)(gp + 8);
                *(LAS v4u*)(Uc + F.tid * 32) = q0; *(LAS v4u*)(Uc + F.tid * 32 + 16) = q1; }
            __syncthreads();
            if (F.tid < CTX) { const int t = F.tid, t0 = max(t - hw, 0), t1 = min(t - hw + w, CTX);
                float a[16];
#pragma unroll
                for (int j = 0; j < 16; ++j) a[j] = 0.f;
                for (int s2 = t0; s2 < t1; ++s2) { float v0[8], v1[8]; unpack8(*(const LAS v4u*)(Uc + s2 * 32), v0); unpack8(*(const LAS v4u*)(Uc + s2 * 32 + 16), v1);
#pragma unroll
                    for (int j = 0; j < 8; ++j) { a[j] += v0[j]; a[8 + j] += v1[j]; } }
                const float inv = 1.0f / (float)(t1 - t0);
                float u0[8], u1[8]; unpack8(*(const LAS v4u*)(Uc + t * 32), u0); unpack8(*(const LAS v4u*)(Uc + t * 32 + 16), u1);
                float lo[8], hi[8];
#pragma unroll
                for (int j = 0; j < 8; ++j) { lo[j] = a[j] * inv - u0[j]; hi[j] = a[8 + j] * inv - u1[j]; }
                GAS bf16* op = P + (size_t)(NX + b * CTX + t) * INC + C_Q + hx * 16;
                *(GAS v4u*)op = pack8(lo); *(GAS v4u*)(op + 8) = pack8(hi); }
        }
    }
    __syncthreads();
}

DI void slice_offsets(const Frame& F, int s, int (&toff)[9]) {
    const GAS unsigned* gc = (const GAS unsigned*)(F.ws + WS_CTL) + CW_GCOUNT;
    int acc = 0;
#pragma unroll
    for (int e = 0; e < 8; ++e) { toff[e] = acc; const unsigned c = __builtin_amdgcn_readfirstlane(__hip_atomic_load(gc + 64 * (s * 8 + e), __ATOMIC_RELAXED, __HIP_MEMORY_SCOPE_AGENT)); acc += (int)((c + 255u) >> 8); }
    toff[8] = acc < SLICE_ROWS / 256 ? acc : SLICE_ROWS / 256;
}
DI void gather_phase(const Frame& F0, const Args& A, int s) {
    const Frame F = fresh(F0);
    (void)A;
    int toff[9]; slice_offsets(F, s, toff);
    const GAS unsigned char* H8 = F.ws + WS_H8; GAS unsigned char* AS = F.ws + WS_AS; GAS float* RG = (GAS float*)(F.ws + WS_RGATE);
    const int rend = slice_start(s + 1);
    int r = slice_start(s) + F.gw;
    i32x2 t = {0, 0}, k = {0, 0}; v4u a = {0u, 0u, 0u, 0u};
    if (r < rend) { t = ((const GAS i32x2*)(F.ws + WS_RTOP))[r]; k = ((const GAS i32x2*)(F.ws + WS_RRANK))[r]; a = *(const GAS v4u*)(H8 + (size_t)r * D + 16 * F.lane); }
    for (; r < rend; r += F.NGW) {
        const int rn = r + F.NGW;
        i32x2 tn = t, kn = k; v4u an = a;
        if (rn < rend) { tn = ((const GAS i32x2*)(F.ws + WS_RTOP))[rn]; kn = ((const GAS i32x2*)(F.ws + WS_RRANK))[rn]; an = *(const GAS v4u*)(H8 + (size_t)rn * D + 16 * F.lane); }
        int p0 = k.x, p1 = k.y;
#pragma unroll
        for (int e = 0; e < 8; ++e) { if (t.x == e) p0 += toff[e] * 256; if (t.y == e) p1 += toff[e] * 256; }
        p0 = min(max(p0, 0), SLICE_ROWS - 1); p1 = min(max(p1, 0), SLICE_ROWS - 1);
        *(GAS v4u*)(AS + (size_t)p0 * D + 16 * F.lane) = a;
        *(GAS v4u*)(AS + (size_t)p1 * D + 16 * F.lane) = a;
        if (F.lane == 0) ((GAS i32x2*)(F.ws + WS_RPOS))[r] = (i32x2){p0, p1};
        t = tn; k = kn; a = an;
    }
    (void)RG;
}
DI void combine_phase(const Frame& F0, const Args& A, int s, bool dry = false) {
    const Frame F = fresh(F0);
    const GAS bf16* YS = (const GAS bf16*)(F.ws + WS_YS);
    RowVecs V; f32x4 hv[4];
    for (int r0 = slice_start(s) + F.gw * 8; r0 < slice_start(s + 1); r0 += F.NGW * 8) {
        const int b = r0 >> 11;
        load_rowvecs(V, modp(F, 1, b, 5), ((const GAS float*)A.in[I_FFNPOST]) + D, nullptr, nullptr, nullptr, F.lane);
        i32x2 pp[8]; f32x2 pr[8];
#pragma unroll
        for (int k = 0; k < 8; ++k) { pp[k] = ((const GAS i32x2*)(F.ws + WS_RPOS))[r0 + k]; pr[k] = ((const GAS f32x2*)(F.ws + WS_RPROB))[r0 + k]; }
        v2u wa[4], wb[4], wx[4], na[4], nb[4], nx[4];
#pragma unroll
        for (int j = 0; j < 4; ++j) { wa[j] = *(const GAS v2u*)(YS + (size_t)pp[0].x * D + 4 * F.lane + 256 * j); wb[j] = *(const GAS v2u*)(YS + (size_t)pp[0].y * D + 4 * F.lane + 256 * j); wx[j] = *(const GAS v2u*)(xb_row(F.out, r0) + 4 * F.lane + 256 * j); }
#pragma unroll
        for (int k = 0; k < 8; ++k) { const int r = r0 + k;
            if (k < 7) {
#pragma unroll
                for (int j = 0; j < 4; ++j) { na[j] = *(const GAS v2u*)(YS + (size_t)pp[k + 1 < 8 ? k + 1 : 7].x * D + 4 * F.lane + 256 * j); nb[j] = *(const GAS v2u*)(YS + (size_t)pp[k + 1 < 8 ? k + 1 : 7].y * D + 4 * F.lane + 256 * j); nx[j] = *(const GAS v2u*)(xb_row(F.out, r + 1) + 4 * F.lane + 256 * j); }
            }
            VM_WAIT();
            GAS float* xr = F.out + (size_t)r * D;
            f32x4 yv[4]; float ss = 0.f;
#pragma unroll
            for (int j = 0; j < 4; ++j) { const v2u w0 = wa[j], w1 = wb[j];
                yv[j] = (f32x4){bflo(w0.x) * pr[k].x + bflo(w1.x) * pr[k].y, bfhi(w0.x) * pr[k].x + bfhi(w1.x) * pr[k].y, bflo(w0.y) * pr[k].x + bflo(w1.y) * pr[k].y, bfhi(w0.y) * pr[k].x + bfhi(w1.y) * pr[k].y};
                ss += (yv[j].x * yv[j].x + yv[j].y * yv[j].y) + (yv[j].z * yv[j].z + yv[j].w * yv[j].w); }
            const float rr = 1.0f / sqrtf(wave_sum(ss) * (1.0f / D) + EPS);
#pragma unroll
            for (int j = 0; j < 4; ++j) { const v2u w = wx[j]; const f32x4 xv = (f32x4){bflo(w.x), bfhi(w.x), bflo(w.y), bfhi(w.y)};
                const f32x4 x = xv + V.a1[j] * (yv[j] * rr); if (!dry || F.never) *(GAS f32x4*)(xr + 4 * F.lane + 256 * j) = x; }
#pragma unroll
            for (int j = 0; j < 4; ++j) { wa[j] = na[j]; wb[j] = nb[j]; wx[j] = nx[j]; }
        }
    }
    (void)hv;
}

__global__ void __launch_bounds__(NTHR, 2) mk_fwd(Args args) {
    extern __shared__ __attribute__((aligned(16))) unsigned char lds_raw[];
    Frame F;
    F.lds = (LAS unsigned char*)lds_raw;
    F.tid = threadIdx.x; F.lane = F.tid & 63; F.wave = __builtin_amdgcn_readfirstlane(F.tid >> 6);
    F.G = gridDim.x; F.gw = blockIdx.x * NWAVES + F.wave; F.NGW = F.G * NWAVES; F.never = args.ph_lo < 0;
    F.out = (GAS float*)args.out; F.ws = (GAS unsigned char*)args.ws;
    volatile LAS unsigned* MISC = (volatile LAS unsigned*)(F.lds + MISC_OFF);
    if (F.tid < 16) MISC[F.tid] = 0u;
    __syncthreads();
    XcdBarrier bar; bar.bar = (unsigned*)(F.ws + WS_CTL) + CW_BAR; bar.x = 0; bar.st = nullptr;
    if (!MK_PER_PHASE) bar = xcd_barrier_post((unsigned*)(F.ws + WS_CTL) + CW_BAR, MISC + 8);
    const int lo = args.ph_lo, hi = args.ph_hi;
    int seq = 0;
#ifndef PHASE_MASK
#define PHASE_MASK 0xffff
#endif
#define EN(k) (((PHASE_MASK) >> (k)) & 1)
#define PH_ON() (lo <= seq && seq < hi)
#define PH_END() do { if (lo <= seq && seq + 1 < hi) { if (!MK_PER_PHASE) { xcd_barrier(bar); if (((DUP_MASK) >> 16) & 1) xcd_barrier(bar); } } ++seq; } while (0)
    LAS unsigned char* ring = F.lds;
#define SITE_PTRS() GAS unsigned char* ws = F.ws; asm volatile("" : "+s"(ws)); GAS bf16* P = (GAS bf16*)(ws + WS_P); GAS bf16* H = (GAS bf16*)(ws + WS_H); (void)P; (void)H

    if (PH_ON() && EN(0)) REP(0) p0_prologue(F, args);
    PH_END();
    if (PH_ON() && EN(1)) { REP(1) rows_phase<0>(F, args, 0); __syncthreads(); win_to_i8(F, args); }
    PH_END();
    for (int l = 0; l < 2; ++l) {
        const int nM = (l == 0) ? MALL / 256 : NX / 256;
        if (PH_ON() && EN(2)) { SITE_PTRS();
            pg8::Gemm g{H, (const GAS bf16*)(ws + WS_WIN + (size_t)l * INC * D), D, D / 2, D / 2};
            pg8::InSched S; S.G = F.G; S.c = (int)blockIdx.x; S.last = (l == 1);
            LAS float* cml = (LAS float*)(F.lds + 131072);
            { int t2 = F.tid; asm volatile("" : "+v"(t2)); const GAS float* cg = (const GAS float*)(ws + WS_CTL) + CW_CMAX_IN + l * INC; for (int i = t2; i < INC; i += NTHR) cml[i] = cg[i]; }
            __syncthreads();
            if (l == 0) { pg8::EpiIn<true> E{P, (const GAS float*)(ws + WS_LB), (const GAS float*)(ws + WS_RS), cml};
                REP(2) pg8::gemm_phase<pg8::EpiIn<true>, pg8::InSched, false, 127, true>(ring, g, S, E); }
            else { pg8::EpiIn<false> E{P, (const GAS float*)(ws + WS_LB) + 2 * DH, (const GAS float*)(ws + WS_RS), cml};
                REP(2) pg8::gemm_phase<pg8::EpiIn<false>, pg8::InSched, false, 127, true>(ring, g, S, E); }
            if (l == 0) moe_weight_convert(F, args, MOE_C1, MOE_C1 + MOE_C2, F.G / 2);
        }
        PH_END();
        if (PH_ON() && EN(3)) { if ((DUP_MASK >> 3) & 1) scan_phase(F, args, l, false); scan_phase(F, args, l, true); }
        PH_END();
        if (PH_ON() && EN(4)) { if ((DUP_MASK >> 17) & 1) post_phase(F, args, l, 1, true); post_phase(F, args, l); }
        PH_END();
        if (PH_ON() && EN(6)) { SITE_PTRS();
            { pg8::Gemm g{P + C_FF, (const GAS bf16*)(ws + WS_WR) + (size_t)l * D * DH, INC, DH, DH};
              pg8::StaticSched S; S.init(nM, D / 256, F.G, (int)blockIdx.x, 0);
              pg8::EpiRow<1> E{P + C_GA, INC, nullptr, 0};
              REP(6) pg8::gemm_phase(ring, g, S, E); }
            { pg8::Gemm g{P + C_Q, (const GAS bf16*)(ws + WS_WP) + (size_t)l * D * DH, INC, DH, DH};
              pg8::StaticSched S; S.init(nM, D / 256, F.G, (int)blockIdx.x, 0);
              pg8::EpiRow<2> E{P + C_GA, INC, nullptr, C_GB - C_GA};
              REP(6) pg8::gemm_phase(ring, g, S, E); }
        }
        PH_END();
        if (PH_ON() && EN(7)) { SITE_PTRS();
            pg8::Gemm g{P + C_GA, (const GAS bf16*)(ws + WS_WO) + (size_t)l * D * D, INC, D, D};
            pg8::StaticSched S; S.init(nM, D / 256, F.G, (int)blockIdx.x, 0);
            pg8::EpiRow<0> E{H, D, nullptr, 0};
            REP(7) pg8::gemm_phase(ring, g, S, E);
        }
        PH_END();
        if (PH_ON() && EN(8)) { if ((DUP_MASK >> 8) & 1) rows_phase<1>(F, args, l, true); rows_phase<1>(F, args, l); if (l == 1) { __syncthreads(); moe_weight_convert(F, args, MOE_C1 + MOE_C2, MOE_CONV_ITEMS, 0); } }
        PH_END();
        if (l == 0) {
            if (PH_ON() && EN(9)) { SITE_PTRS();
                pg8::Gemm g{H, (const GAS bf16*)(ws + WS_WGU), D, D / 2, D / 2};
                pg8::StaticSched S; S.init(MALL / 256, 2 * DFF / 256, F.G, (int)blockIdx.x, 0);
                LAS float* cmgl = (LAS float*)(F.lds + 131072); LAS float* cmul = cmgl + DFF;
                { int t2 = F.tid; asm volatile("" : "+v"(t2)); const GAS float* cg = (const GAS float*)(ws + WS_CTL) + CW_CMAX_FG; const GAS float* cu = (const GAS float*)(ws + WS_CTL) + CW_CMAX_FU;
                  for (int i = t2; i < DFF; i += NTHR) { cmgl[i] = cg[i]; cmul[i] = cu[i]; } }
                __syncthreads();
                pg8::EpiSwiGLU<true> E{(GAS bf16*)(ws + WS_HH0), DFF, nullptr, (const GAS float*)(ws + WS_RS), cmgl, cmul};
                REP(9) pg8::gemm_phase<pg8::EpiSwiGLU<true>, pg8::StaticSched, false, 127, true>(ring, g, S, E);
            }
            PH_END();
            if (PH_ON() && EN(10)) { SITE_PTRS();
                pg8::Gemm g{(const GAS bf16*)(ws + WS_HH0), (const GAS bf16*)(ws + WS_WD), DFF / 2, DFF / 2, DFF / 2};
                pg8::StaticSched S; S.init(MALL / 256, D / 256, F.G, (int)blockIdx.x, 0);
                pg8::EpiRow<0> E{H, D, nullptr, 0};
                REP(10) pg8::gemm_phase<pg8::EpiRow<0>, pg8::StaticSched, true, 121>(ring, g, S, E);
                moe_weight_convert(F, args, 0, MOE_C1, F.G / 2);
            }
            PH_END();
            if (PH_ON() && EN(11)) { if ((DUP_MASK >> 11) & 1) rows_phase<2>(F, args, 0, true); rows_phase<2>(F, args, 0); }
            PH_END();
        } else {
            if (PH_ON() && EN(12)) gather_phase(F, args, 0);
            PH_END();
            for (int s = 0; s < NSLICE; ++s) {
                if (PH_ON() && EN(13)) { SITE_PTRS();
                    pg8::MoeSched S; S.G = F.G; S.c = (int)blockIdx.x; S.nN = 2 * DEX / 256; S.nrow_e = 2 * DEX; slice_offsets(F, s, S.toff); S.nM = S.toff[8];
                    pg8::Gemm g{(const GAS bf16*)(ws + WS_AS), (const GAS bf16*)(ws + WS_MGU), D / 2, D / 2, D / 2};
                    pg8::EpiSwiGLU8 E{ws + WS_HHS, DEX, nullptr};
                    REP(13) pg8::gemm_phase<pg8::EpiSwiGLU8, pg8::MoeSched, true, 122>(ring, g, S, E);
                    if (s > 0) { if ((DUP_MASK >> 15) & 1) combine_phase(F, args, s - 1, true); combine_phase(F, args, s - 1); }
                }
                PH_END();
                if (PH_ON() && EN(14)) { SITE_PTRS();
                    pg8::MoeSched S; S.G = F.G; S.c = (int)blockIdx.x; S.nN = D / 256; S.nrow_e = D; slice_offsets(F, s, S.toff); S.nM = S.toff[8];
                    pg8::Gemm g{(const GAS bf16*)(ws + WS_HHS), (const GAS bf16*)(ws + WS_MD), DEX / 2, DEX / 2, DEX / 2};
                    pg8::EpiRow<0> E{(GAS bf16*)(ws + WS_YS), D, nullptr, 0};
                    REP(14) pg8::gemm_phase<pg8::EpiRow<0>, pg8::MoeSched, true, 121>(ring, g, S, E);
                    if (s + 1 < NSLICE) gather_phase(F, args, s + 1);
                }
                PH_END();
            }
            if (PH_ON() && EN(15)) { if ((DUP_MASK >> 15) & 1) combine_phase(F, args, NSLICE - 1, true); combine_phase(F, args, NSLICE - 1); }
            PH_END();
        }
    }
}
constexpr int N_PHASES = 2 + 6 + 3 + 6 + 1 + 2 * NSLICE + 1;

extern "C" void kernel_launch(void* const* d_in, const int* in_sizes, int n_in, void* d_out, int out_size, void* d_ws, size_t ws_size, hipStream_t stream) {
    static int grid = 0;
    if (grid == 0) {
        if (n_in != 25 || out_size != NX * D || ws_size < WS_END) { fprintf(stderr, "kernel_launch: unexpected problem (n_in %d, out %d, ws %zu < %zu)\n", n_in, out_size, ws_size, (size_t)WS_END); grid = -1; return; }
        int dev = 0, cus = 0, per_cu = 0;
        if (hipGetDevice(&dev) != hipSuccess || hipDeviceGetAttribute(&cus, hipDeviceAttributeMultiprocessorCount, dev) != hipSuccess) { grid = -1; return; }
        if (hipFuncSetAttribute((const void*)mk_fwd, hipFuncAttributeMaxDynamicSharedMemorySize, LDS_BYTES) != hipSuccess) { fprintf(stderr, "kernel_launch: hipFuncSetAttribute failed\n"); grid = -1; return; }
        if (hipOccupancyMaxActiveBlocksPerMultiprocessor(&per_cu, (const void*)mk_fwd, NTHR, LDS_BYTES) != hipSuccess || per_cu < 1) { fprintf(stderr, "kernel_launch: occupancy query says %d\n", per_cu); }
        (void)hipGetLastError();
        grid = cus;
    }
    if (grid < 0) return;
    (void)in_sizes;
    if (hipMemsetAsync((char*)d_ws + WS_CTL, 0, CTL_BYTES, stream) != hipSuccess) return;
    Args a{};
    for (int i = 0; i < 25; ++i) a.in[i] = (const float*)d_in[i];
    a.out = (float*)d_out; a.ws = (unsigned char*)d_ws;
#if MK_PER_PHASE
    for (int p = 0; p < N_PHASES; ++p) { a.ph_lo = p; a.ph_hi = p + 1; hipLaunchKernelGGL(mk_fwd, dim3(grid), dim3(NTHR), LDS_BYTES, stream, a); }
#else
    a.ph_lo = 0; a.ph_hi = N_PHASES;
    hipLaunchKernelGGL(mk_fwd, dim3(grid), dim3(NTHR), LDS_BYTES, stream, a);
#endif
}
```

```cpp
#include <hip/hip_runtime.h>
#include <cstdio>
#include <cstdint>

#ifndef MK_PER_PHASE
#define MK_PER_PHASE 0
#endif

#ifndef DUP_MASK
#define DUP_MASK 0
#endif
#define REP(k) for (int rep_ = 0; rep_ < 1 + (((DUP_MASK) >> (k)) & 1); ++rep_)
#define GAS __attribute__((address_space(1)))
#define LAS __attribute__((address_space(3)))
#define DI __device__ __forceinline__
typedef unsigned short bf16;
typedef unsigned v4u __attribute__((ext_vector_type(4)));
typedef unsigned v2u __attribute__((ext_vector_type(2)));
typedef float f32x4 __attribute__((ext_vector_type(4)));
typedef float f32x2 __attribute__((ext_vector_type(2)));
typedef float f32x16 __attribute__((ext_vector_type(16)));
typedef short bf16x8 __attribute__((ext_vector_type(8)));
typedef int i32x2 __attribute__((ext_vector_type(2)));

constexpr int D = 1024, BATCH = 32, SEQ = 2048, CTX = 256, GW = 64;
constexpr int NX = BATCH * SEQ, NC = BATCH * CTX, MALL = NX + NC;
constexpr int DH = 512, DK = 128, INC = 5120, DFF = 2816, NE = 8, DEX = 3584;
constexpr int C_Q = 0, C_FF = 512, C_FB = 1024, C_V = 1536, C_G = 2048, C_U = 2560, C_GA = 3072, C_GB = 4096;
constexpr float EPS = 1e-6f;
constexpr int NSLICE = 3, SL1 = 21848, SL2 = 43696, NGRP = NSLICE * NE;
constexpr int SLICE_ROWS = 45824;
DI int slice_of(int r) { return (r >= SL1 ? 1 : 0) + (r >= SL2 ? 1 : 0); }
DI int slice_start(int s) { return s == 0 ? 0 : s == 1 ? SL1 : s == 2 ? SL2 : NX; }
constexpr int NWAVES = 8, NTHR = 512;

constexpr size_t MiB = 1u << 20;
constexpr size_t al256(size_t x) { return (x + 255) & ~(size_t)255; }
constexpr size_t WS_CTL = 0, CTL_BYTES = 1 * MiB;
constexpr size_t WS_MOD = WS_CTL + CTL_BYTES;
constexpr size_t WS_LB = WS_MOD + al256((size_t)2 * 33 * 6144 * 4);
constexpr size_t WS_WIN = WS_LB + al256(2 * 2 * 512 * 4);
constexpr size_t WS_WR = WS_WIN + (size_t)2 * INC * D * 2;
constexpr size_t WS_WP = WS_WR + (size_t)2 * D * DH * 2;
constexpr size_t WS_WO = WS_WP + (size_t)2 * D * DH * 2;
constexpr size_t WS_WGU = WS_WO + (size_t)2 * D * D * 2;
constexpr size_t WS_WD = WS_WGU + (size_t)2 * DFF * D * 2;
constexpr size_t WS_H = WS_WD + (size_t)D * DFF * 2;
constexpr size_t WS_CX = WS_H + (size_t)MALL * D * 2;
constexpr size_t WS_RTOP = WS_CX + (size_t)NC * D * 2;
constexpr size_t WS_RPROB = WS_RTOP + (size_t)NX * 8;
constexpr size_t WS_RRANK = WS_RPROB + (size_t)NX * 8;
constexpr size_t WS_RPOS = WS_RRANK + (size_t)NX * 8;
constexpr size_t WS_RGATE = WS_RPOS + (size_t)NX * 8;
constexpr size_t WS_P = WS_RGATE + al256((size_t)SLICE_ROWS * 4);
constexpr size_t P_BYTES = (size_t)MALL * INC * 2;
constexpr size_t WS_MGU = WS_P + P_BYTES;
constexpr size_t WS_MD = WS_MGU + (size_t)NE * 2 * DEX * D;
constexpr size_t WS_END = WS_MD + (size_t)NE * D * DEX;
constexpr size_t WS_HH0 = WS_P;
constexpr size_t WS_H8 = WS_P;
constexpr size_t WS_AS = WS_H8 + (size_t)NX * D;
constexpr size_t WS_YS = WS_AS + (size_t)SLICE_ROWS * D;
constexpr size_t WS_HHS = WS_YS + (size_t)SLICE_ROWS * D * 2;
static_assert(WS_HHS + (size_t)SLICE_ROWS * DEX <= WS_P + P_BYTES, "moe overlay");
static_assert((size_t)MALL * DFF * 2 <= P_BYTES, "ffn overlay");
constexpr int CW_BAR = 0;
constexpr int CW_GCOUNT = 4096;
constexpr int CW_CMAX_FG = 18432, CW_CMAX_FU = 21248;
constexpr int CW_CMAX_IN = 8192;
constexpr size_t WS_RS = WS_CTL + 524288;
constexpr int LDS_BYTES = 159744, MISC_OFF = 158720;

typedef __bf16 bf16x2_t __attribute__((ext_vector_type(2)));
DI unsigned pk2(float lo, float hi) { bf16x2_t v = {(__bf16)lo, (__bf16)hi}; return __builtin_bit_cast(unsigned, v); }
DI float bflo(unsigned w) { return __uint_as_float(w << 16); }
DI float bfhi(unsigned w) { return __uint_as_float(w & 0xffff0000u); }
DI float wave_sum(float v) {
#pragma unroll
    for (int o = 1; o < 64; o <<= 1) v += __shfl_xor(v, o);
    return v;
}
DI float sat8(float x) { return __builtin_amdgcn_fmed3f(x, -448.f, 448.f); }
DI unsigned pk4_fp8(float a, float b, float c, float d) { int p = __builtin_amdgcn_cvt_pk_fp8_f32(sat8(a), sat8(b), 0, false); p = __builtin_amdgcn_cvt_pk_fp8_f32(sat8(c), sat8(d), p, true); return (unsigned)p; }
DI float wave_max(float v) {
#pragma unroll
    for (int o = 1; o < 64; o <<= 1) v = fmaxf(v, __shfl_xor(v, o));
    return v;
}
DI unsigned pk4_i8(float a, float b, float c, float d) {
    const int qa = (int)rintf(a), qb = (int)rintf(b), qc = (int)rintf(c), qd = (int)rintf(d);
    return (unsigned)(qa & 0xff) | ((unsigned)(qb & 0xff) << 8) | ((unsigned)(qc & 0xff) << 16) | ((unsigned)qd << 24);
}
DI float sigmoidf_(float a) { return __builtin_amdgcn_rcpf(1.0f + __builtin_amdgcn_exp2f(a * -1.4426950408889634f)); }
DI float siluf_(float a) { return a * sigmoidf_(a); }
#define LDS_WAIT() asm volatile("s_waitcnt lgkmcnt(0)" ::: "memory")
#define VM_WAIT() asm volatile("s_waitcnt vmcnt(0)" ::: "memory")

#define XB_TMO      128
#define XB_XCNT(j)  (256  + 64 * (j))
#define XB_XSUB(j)  (1280 + 64 * (j))
#define XB_XGEN(j)  (2304 + 64 * (j))
#define XB_TOP      3328
#define XB_TOPGEN   3392
#define XCD_BAR_WORDS 3456
#define XB_SPIN_CAP (1u << 20)

__device__ __forceinline__ unsigned xb_ld(unsigned* p)              { return __hip_atomic_load(p, __ATOMIC_RELAXED, __HIP_MEMORY_SCOPE_AGENT); }
__device__ __forceinline__ unsigned xb_add(unsigned* p, unsigned v) { return __hip_atomic_fetch_add(p, v, __ATOMIC_RELAXED, __HIP_MEMORY_SCOPE_AGENT); }
__device__ __forceinline__ unsigned xb_xcc_id() { return (unsigned)__builtin_amdgcn_s_getreg((3 << 11) | 20) & 0xFu; }
#define XB_SPIN(cond, bar) do { unsigned _sp = 0; while (cond) { __builtin_amdgcn_s_sleep(1); \
    if ((++_sp & 255u) == 0u) { if (xb_ld(&(bar)[XB_TMO])) break; if (_sp > XB_SPIN_CAP) { atomicAdd(&(bar)[XB_TMO], 1u); break; } } } } while (0)

struct XcdBarrier { unsigned* bar; unsigned x; volatile LAS unsigned* st; };

__device__ __forceinline__ XcdBarrier xcd_barrier_post(unsigned* bar, volatile LAS unsigned* st) {
    XcdBarrier b; b.bar = bar; b.x = xb_xcc_id(); b.st = st;
    if (threadIdx.x == 0) (void)xb_add(&bar[XB_XCNT(b.x)], 1u);
    return b;
}
__device__ __forceinline__ void xcd_barrier_complete(unsigned* bar, unsigned x, unsigned& nloc, unsigned& nx) {
    const unsigned G = gridDim.x * gridDim.y * gridDim.z;
    unsigned sum, cnt, mine, sp = 0u;
    for (;;) {
        sum = 0u; cnt = 0u; mine = 0u;
#pragma unroll
        for (unsigned j = 0; j < 16; ++j) { const unsigned c = xb_ld(&bar[XB_XCNT(j)]); sum += c; cnt += (c > 0u) ? 1u : 0u; mine = (j == x) ? c : mine; }
        if (sum == G) break;
        __builtin_amdgcn_s_sleep(1);
        if ((++sp & 255u) == 0u) { if (xb_ld(&bar[XB_TMO])) break; if (sp > XB_SPIN_CAP) { atomicAdd(&bar[XB_TMO], 1u); break; } }
    }
    nloc = mine > 0u ? mine : 1u; nx = cnt > 0u ? cnt : 1u;
}
__device__ __forceinline__ void xcd_barrier(const XcdBarrier& b) {
    asm volatile("s_waitcnt vmcnt(0)" ::: "memory");
    __syncthreads();
    if (threadIdx.x == 0) {
        unsigned* bar = b.bar;
        __builtin_amdgcn_s_waitcnt(0);
        unsigned nloc = b.st[0], nx = b.st[1];
        if (nloc == 0u) { xcd_barrier_complete(bar, b.x, nloc, nx); b.st[0] = nloc; b.st[1] = nx; }
        const unsigned old = xb_add(&bar[XB_XSUB(b.x)], 1u);
        const unsigned gen = old / nloc;
        if (old + 1u == (gen + 1u) * nloc) {
            __builtin_amdgcn_fence(__ATOMIC_RELEASE, "agent");
            asm volatile("s_waitcnt vmcnt(0)" ::: "memory");
            const unsigned og = xb_add(&bar[XB_TOP], 1u);
            const unsigned tg = og / nx;
            if (og + 1u == (tg + 1u) * nx) xb_add(&bar[XB_TOPGEN], 1u);
            else XB_SPIN(xb_ld(&bar[XB_TOPGEN]) == tg, bar);
            __builtin_amdgcn_fence(__ATOMIC_ACQUIRE, "agent");
            xb_add(&bar[XB_XGEN(b.x)], 1u);
            asm volatile("s_waitcnt vmcnt(0)" ::: "memory");
        } else {
            XB_SPIN(xb_ld(&bar[XB_XGEN(b.x)]) == gen, bar);
            __builtin_amdgcn_fence(__ATOMIC_ACQUIRE, "agent");
            asm volatile("s_waitcnt vmcnt(0)" ::: "memory");
        }
    }
    __syncthreads();
}

namespace pg8 {
constexpr int BM = 256, BK = 64, HALF = 128, HTB = HALF * BK * 2, STAGE_BYTES = 8 * HTB, NXCD = 8, WGM = 4;
__host__ __device__ __forceinline__ int lds_byte(int r, int c) { const int st = (r >> 4) * 2 + (c >> 5), rr = r & 15, cc = c & 31, ob = rr * 64 + cc * 2; return st * 1024 + (ob ^ (((ob >> 9) & 1) << 5)); }
__host__ __device__ __forceinline__ void stage_rc(int b, int& R, int& C) { const int st = b / 1024, sb = b % 1024, swz = sb ^ (((sb >> 9) & 1) << 5); R = (st >> 1) * 16 + swz / 64; C = (st & 1) * 32 + (swz % 64) / 2; }
__host__ __device__ __forceinline__ int perm32(int rho) { const int n = rho >> 4, i = rho & 15; return 8 * (i >> 2) + 4 * n + (i & 3); }

struct Unit { int arow, brow, pn, aux; };
struct Gemm { const GAS bf16* A; const GAS bf16* Bt; int lda, ldb, K; };
typedef int v8i __attribute__((ext_vector_type(8))); typedef int v4i __attribute__((ext_vector_type(4)));
DI v8i cat16(bf16x8 a, bf16x8 b) { const v4i x = __builtin_bit_cast(v4i, a), y = __builtin_bit_cast(v4i, b); return __builtin_shufflevector(x, y, 0, 1, 2, 3, 4, 5, 6, 7); }

DI void tile_order(int L, int nM, int nN, int& pm, int& pn) {
    const int nwg = nM * nN;
    int wgid = L; { const int q = nwg / NXCD, r = nwg % NXCD, xcd = wgid % NXCD, off = wgid / NXCD; wgid = (xcd < r ? xcd * (q + 1) : r * (q + 1) + (xcd - r) * q) + off; }
    const int nig = WGM * nN, gid = wgid / nig, fm = gid * WGM, gsz = (nM - fm) < WGM ? (nM - fm) : WGM;
    pm = fm + ((wgid % nig) % gsz); pn = (wgid % nig) / gsz;
}
struct StaticSched {
    int nM, nN, G, c, arow0;
    DI void init(int nM_, int nN_, int G_, int c_, int arow0_) { nM = nM_; nN = nN_; G = G_; c = c_; arow0 = arow0_; }
    DI bool next(int i, Unit& u) const {
        const long L = (long)i * G + c; if (L >= (long)nM * nN) return false;
        int pm, pn; tile_order((int)L, nM, nN, pm, pn);
        u.arow = arow0 + pm * BM; u.brow = pn * BM; u.pn = pn; u.aux = 0; return true;
    }
};
struct InSched {
    int G, c; bool last;
    DI bool next(int i, Unit& u) const {
        const int L = i * G + c; int pm, pn;
        if (!last) { if (L >= (MALL / 256) * (INC / 256)) return false; tile_order(L, MALL / 256, INC / 256, pm, pn); }
        else if (L < (NX / 256) * (INC / 256)) tile_order(L, NX / 256, INC / 256, pm, pn);
        else { const int L2 = L - (NX / 256) * (INC / 256); if (L2 >= (NC / 256) * 6) return false; pm = NX / 256 + L2 % (NC / 256); pn = 2 + L2 / (NC / 256); }
        u.arow = pm * BM; u.brow = pn * BM; u.pn = pn; u.aux = 0; return true;
    }
};
struct MoeSched {
    int nM, nN, G, c, nrow_e; int toff[9];
    DI bool next(int i, Unit& u) const {
        const long L = (long)i * G + c; if (L >= (long)nM * nN) return false;
        int pm, pn; tile_order((int)L, nM, nN, pm, pn);
        int e = 0;
#pragma unroll
        for (int j = 1; j < 8; ++j) e += (pm >= toff[j]) ? 1 : 0;
        u.arow = pm * BM; u.brow = e * nrow_e + pn * BM; u.pn = pn; u.aux = e; return true;
    }
};

template <class Epi, class Sched, bool FP8 = false, int WSC = 127, bool I8 = false>
DI void gemm_phase(LAS unsigned char* lds, const Gemm g, const Sched& S, const Epi& E) {
    int tid = threadIdx.x; asm volatile("" : "+v"(tid));
    const int wid = __builtin_amdgcn_readfirstlane(tid >> 6), lane = tid & 63, wr = wid >> 2, wc = wid & 3, fr = lane & 15, fq = lane >> 4;
    const int K = g.K, nt = K / BK;
    unsigned voffA[2], voffB[2];
#pragma unroll
    for (int i = 0; i < 2; ++i) { int R, C; stage_rc(tid * 16 + i * 8192, R, C); const int Rb = Epi::PERM ? ((R & ~31) + perm32(R & 31)) : R;
        voffA[i] = (unsigned)(R * g.lda + C) * 2u; voffB[i] = (unsigned)(Rb * g.ldb + C) * 2u; }
    const size_t kstep = (size_t)(BK * 2);
    const size_t hstepA = (size_t)HALF * g.lda * 2, hstepB = (size_t)HALF * g.ldb * 2;
    const size_t rowA = (size_t)g.lda * 2, rowB = (size_t)g.ldb * 2;
    const unsigned ldsw = (unsigned)wid * 1024u;
    const int aoff = lds_byte(wr * 64 + fr, fq * 8), boff = lds_byte(wc * 32 + fr, fq * 8);
#define PG8_SA(b, h) (((b) * 2 + (h)) * HTB)
#define PG8_SB(b, h) ((4 + (b) * 2 + (h)) * HTB)
#define PG8_STAGE(bufoff, gbase, voff) do { _Pragma("unroll") for (int _i = 0; _i < 2; ++_i) \
        __builtin_amdgcn_global_load_lds((const GAS unsigned*)((const GAS char*)(gbase) + (voff)[_i]), (LAS unsigned*)(lds + (bufoff) + ldsw + _i * 8192), 16, 0, 0); } while (0)
#define PG8_LDA(dst, b, h) do { _Pragma("unroll") for (int m = 0; m < 4; ++m) { if constexpr (FP8) dst##8[m] = cat16(*(const LAS bf16x8*)(lds + PG8_SA(b, h) + aoff + m * 2048), *(const LAS bf16x8*)(lds + PG8_SA(b, h) + aoff + m * 2048 + 1024)); \
        else { _Pragma("unroll") for (int k = 0; k < 2; ++k) dst[m][k] = *(const LAS bf16x8*)(lds + PG8_SA(b, h) + aoff + m * 2048 + k * 1024); } } } while (0)
#define PG8_LDB(dst, b, h) do { _Pragma("unroll") for (int n = 0; n < 2; ++n) { if constexpr (FP8) dst##8[n] = cat16(*(const LAS bf16x8*)(lds + PG8_SB(b, h) + boff + n * 2048), *(const LAS bf16x8*)(lds + PG8_SB(b, h) + boff + n * 2048 + 1024)); \
        else { _Pragma("unroll") for (int k = 0; k < 2; ++k) dst[n][k] = *(const LAS bf16x8*)(lds + PG8_SB(b, h) + boff + n * 2048 + k * 1024); } } } while (0)
#define PG8_MMA(ai, bj, At, Bt) do { __builtin_amdgcn_s_setprio(1); _Pragma("unroll") for (int m = 0; m < 4; ++m) _Pragma("unroll") for (int n = 0; n < 2; ++n) { \
        if constexpr (FP8) asm volatile("v_mfma_scale_f32_16x16x128_f8f6f4 %0, %1, %2, %0, %3, %4 op_sel_hi:[0,0,0]" : "+v"(acc[ai][bj][m][n]) : "v"(Bt##8[n]), "v"(At##8[m]), "v"(sc_w), "v"(sc_a)); \
        else if constexpr (I8) { _Pragma("unroll") for (int k = 0; k < 2; ++k) acc[ai][bj][m][n] = __builtin_bit_cast(f32x4, __builtin_amdgcn_mfma_i32_16x16x64_i8(__builtin_bit_cast(v4i, Bt[n][k]), __builtin_bit_cast(v4i, At[m][k]), __builtin_bit_cast(v4i, acc[ai][bj][m][n]), 0, 0, 0)); } \
        else { _Pragma("unroll") for (int k = 0; k < 2; ++k) acc[ai][bj][m][n] = __builtin_amdgcn_mfma_f32_16x16x32_bf16(Bt[n][k], At[m][k], acc[ai][bj][m][n], 0, 0, 0); } } \
        __builtin_amdgcn_s_setprio(0); } while (0)
#define PG8_WAIT_V(n) asm volatile("s_waitcnt vmcnt(" #n ")" ::: "memory")
#define PG8_WAIT_L(n) asm volatile("s_waitcnt lgkmcnt(" #n ")" ::: "memory")
#define PG8_BAR __builtin_amdgcn_s_barrier()
#define PG8_SCHED __builtin_amdgcn_sched_barrier(0)
    Unit cur, nxt; int ui = 0;
    if (!S.next(0, cur)) return;
    f32x4 acc[2][2][4][2];
#pragma unroll
    for (int a = 0; a < 2; ++a)
#pragma unroll
        for (int b = 0; b < 2; ++b)
#pragma unroll
            for (int m = 0; m < 4; ++m)
#pragma unroll
                for (int n = 0; n < 2; ++n) acc[a][b][m][n] = (f32x4){0.f, 0.f, 0.f, 0.f};
    const int sc_w = WSC * 0x01010101, sc_a = 0x7f7f7f7f;
    bf16x8 At[4][2], B0[2][2], B1[2][2]; v8i At8[4], B08[2], B18[2];
    const GAS char* cA = (const GAS char*)g.A + (size_t)cur.arow * rowA; const GAS char* cB = (const GAS char*)g.Bt + (size_t)cur.brow * rowB;
    PG8_STAGE(PG8_SB(0, 0), cB, voffB); PG8_STAGE(PG8_SB(0, 1), cB + hstepB, voffB); PG8_STAGE(PG8_SA(0, 0), cA, voffA); PG8_STAGE(PG8_SA(0, 1), cA + hstepA, voffA);
    if (wr == 1) PG8_BAR;
    PG8_WAIT_V(2); PG8_BAR;
    PG8_STAGE(PG8_SB(1, 0), cB + kstep, voffB); PG8_STAGE(PG8_SA(1, 0), cA + kstep, voffA); PG8_STAGE(PG8_SB(1, 1), cB + hstepB + kstep, voffB);
    PG8_WAIT_V(6); PG8_BAR;
    for (;;) {
        const bool has_next = S.next(ui + 1, nxt);
        const GAS char* nA = has_next ? (const GAS char*)g.A + (size_t)nxt.arow * rowA : cA; const GAS char* nB = has_next ? (const GAS char*)g.Bt + (size_t)nxt.brow * rowB : cB;
        for (int t = 0; t < nt; t += 2) {
            const bool last = (t == nt - 2);
            const GAS char* a1 = cA + (size_t)(t + 1) * kstep;
            const GAS char* a2 = last ? nA : cA + (size_t)(t + 2) * kstep; const GAS char* b2 = last ? nB : cB + (size_t)(t + 2) * kstep;
            const GAS char* a3 = a2 + kstep; const GAS char* b3 = b2 + kstep;
            PG8_LDB(B0, 0, 0); PG8_LDB(B1, 0, 1); PG8_SCHED; PG8_LDA(At, 0, 0); PG8_STAGE(PG8_SA(1, 1), a1 + hstepA, voffA);
            PG8_WAIT_V(8); PG8_WAIT_L(0); PG8_BAR; PG8_MMA(0, 0, At, B0); PG8_MMA(0, 1, At, B1); PG8_BAR; PG8_SCHED;
            PG8_LDA(At, 0, 1); PG8_STAGE(PG8_SB(0, 0), b2, voffB); PG8_STAGE(PG8_SB(0, 1), b2 + hstepB, voffB); PG8_STAGE(PG8_SA(0, 0), a2, voffA);
            PG8_WAIT_V(8); PG8_WAIT_L(0); PG8_BAR; PG8_MMA(1, 0, At, B0); PG8_MMA(1, 1, At, B1); PG8_BAR; PG8_SCHED;
            PG8_LDB(B0, 1, 0); PG8_LDB(B1, 1, 1); PG8_SCHED; PG8_LDA(At, 1, 0); PG8_STAGE(PG8_SA(0, 1), a2 + hstepA, voffA);
            PG8_WAIT_V(8); PG8_WAIT_L(0); PG8_BAR; PG8_MMA(0, 0, At, B0); PG8_MMA(0, 1, At, B1); PG8_BAR; PG8_SCHED;
            PG8_LDA(At, 1, 1); PG8_STAGE(PG8_SB(1, 0), b3, voffB); PG8_STAGE(PG8_SB(1, 1), b3 + hstepB, voffB); PG8_STAGE(PG8_SA(1, 0), a3, voffA);
            PG8_WAIT_V(8); PG8_WAIT_L(0); PG8_BAR; PG8_MMA(1, 0, At, B0); PG8_MMA(1, 1, At, B1); PG8_BAR; PG8_SCHED;
        }
        if (wr == 0) PG8_BAR;
        if constexpr (FP8) asm volatile("s_nop 15\n\ts_nop 15\n\ts_nop 15\n\ts_nop 15" ::: "memory");
        if constexpr (Epi::HAS_PRE) {
            const auto pre = E.preload(cur, wr, fr);
            if constexpr (I8) {
#pragma unroll
                for (int a = 0; a < 2; ++a)
#pragma unroll
                    for (int b = 0; b < 2; ++b)
#pragma unroll
                        for (int m = 0; m < 4; ++m)
#pragma unroll
                            for (int n = 0; n < 2; ++n) { const v4i t = __builtin_bit_cast(v4i, acc[a][b][m][n]); acc[a][b][m][n] = (f32x4){(float)t.x, (float)t.y, (float)t.z, (float)t.w}; } }
            E(acc, cur, wr, wc, fr, fq, pre);
        } else {
        if constexpr (I8) {
#pragma unroll
            for (int a = 0; a < 2; ++a)
#pragma unroll
                for (int b = 0; b < 2; ++b)
#pragma unroll
                    for (int m = 0; m < 4; ++m)
#pragma unroll
                        for (int n = 0; n < 2; ++n) { const v4i t = __builtin_bit_cast(v4i, acc[a][b][m][n]); acc[a][b][m][n] = (f32x4){(float)t.x, (float)t.y, (float)t.z, (float)t.w}; } }
        E(acc, cur, wr, wc, fr, fq);
        }
        if (!has_next) break;
#pragma unroll
        for (int a = 0; a < 2; ++a)
#pragma unroll
            for (int b = 0; b < 2; ++b)
#pragma unroll
                for (int m = 0; m < 4; ++m)
#pragma unroll
                    for (int n = 0; n < 2; ++n) acc[a][b][m][n] = (f32x4){0.f, 0.f, 0.f, 0.f};
        cur = nxt; cA = nA; cB = nB; ++ui;
        if (wr == 1) PG8_BAR;
    }
    PG8_WAIT_V(0);
    PG8_BAR;
#undef PG8_SA
#undef PG8_SB
#undef PG8_STAGE
#undef PG8_LDA
#undef PG8_LDB
#undef PG8_MMA
#undef PG8_WAIT_V
#undef PG8_WAIT_L
#undef PG8_BAR
#undef PG8_SCHED
}

DI f32x2 ex2p(f32x2 x) { return (f32x2){__builtin_amdgcn_exp2f(x.x), __builtin_amdgcn_exp2f(x.y)}; }
DI f32x2 rcpp(f32x2 x) { return (f32x2){__builtin_amdgcn_rcpf(x.x), __builtin_amdgcn_rcpf(x.y)}; }
DI f32x2 lo2(f32x4 v) { return __builtin_shufflevector(v, v, 0, 1); }
DI f32x2 hi2(f32x4 v) { return __builtin_shufflevector(v, v, 2, 3); }
DI v4u pack8p(const f32x2 (&o)[4]) { v4u w; w.x = pk2(o[0].x, o[0].y); w.y = pk2(o[1].x, o[1].y); w.z = pk2(o[2].x, o[2].y); w.w = pk2(o[3].x, o[3].y); return w; }
DI v4u pack8f(const float (&o)[8]) { v4u w; w.x = pk2(o[0], o[1]); w.y = pk2(o[2], o[3]); w.z = pk2(o[4], o[5]); w.w = pk2(o[6], o[7]); return w; }
template <bool LBZ> struct EpiIn {
    static constexpr bool PERM = true; static constexpr bool HAS_PRE = true;
    GAS bf16* P; const GAS float* LB;
    static constexpr bool lbz = LBZ;
    const GAS float* rs; const LAS float* cmax;
    template <int T> DI static void act8(float (&v)[8], const float (&lb)[8]) {
        const float L2E = 1.4426950408889634f, LN2 = 0.6931471805599453f;
        if (T == 2) return;
        if (T == 0 || T == 3 || T == 4) {
            f32x2 a2[4] = {{v[0], v[1]}, {v[2], v[3]}, {v[4], v[5]}, {v[6], v[7]}}, e2[4];
#pragma unroll
            for (int p = 0; p < 4; ++p) e2[p] = ex2p(a2[p] * (f32x2){-L2E, -L2E});
#pragma unroll
            for (int p = 0; p < 4; ++p) { e2[p] = e2[p] + (f32x2){1.0f, 1.0f}; if (T == 0) a2[p] = a2[p] * (f32x2){0.08838834764831845f, 0.08838834764831845f}; }
#pragma unroll
            for (int p = 0; p < 4; ++p) e2[p] = rcpp(e2[p]);
#pragma unroll
            for (int p = 0; p < 4; ++p) { const f32x2 o = (T == 4) ? e2[p] : a2[p] * e2[p]; v[2 * p] = o.x; v[2 * p + 1] = o.y; }
            return;
        }
        f32x2 a2[4] = {{v[0], v[1]}, {v[2], v[3]}, {v[4], v[5]}, {v[6], v[7]}}, t2[4], m2[4];
#pragma unroll
        for (int p = 0; p < 4; ++p) { m2[p] = __builtin_elementwise_min(a2[p], (f32x2){0.f, 0.f}); t2[p] = (a2[p] - m2[p] - m2[p]) * (f32x2){-L2E, -L2E}; }
#pragma unroll
        for (int p = 0; p < 4; ++p) t2[p] = ex2p(t2[p]);
        if constexpr (LBZ) {
#pragma unroll
            for (int p = 0; p < 4; ++p) t2[p] = t2[p] + (f32x2){1.0f, 1.0f};
#pragma unroll
            for (int p = 0; p < 4; ++p) t2[p] = (f32x2){__builtin_amdgcn_logf(t2[p].x), __builtin_amdgcn_logf(t2[p].y)};
#pragma unroll
            for (int p = 0; p < 4; ++p) { const f32x2 o = m2[p] - t2[p] * (f32x2){LN2, LN2}; v[2 * p] = o.x; v[2 * p + 1] = o.y; }
        } else {
            f32x2 r2[4];
#pragma unroll
            for (int p = 0; p < 4; ++p) r2[p] = rcpp(t2[p] + (f32x2){1.0f, 1.0f});
#pragma unroll
            for (int p = 0; p < 4; ++p) { const f32x2 num = (f32x2){a2[p].x >= 0.f ? 1.0f : t2[p].x, a2[p].y >= 0.f ? 1.0f : t2[p].y};
                const f32x2 lbp = (f32x2){lb[2 * p], lb[2 * p + 1]}; r2[p] = lbp + ((f32x2){1.0f, 1.0f} - lbp) * (num * r2[p]); }
#pragma unroll
            for (int p = 0; p < 4; ++p) { v[2 * p] = __builtin_amdgcn_logf(r2[p].x) * LN2; v[2 * p + 1] = __builtin_amdgcn_logf(r2[p].y) * LN2; }
        }
    }
    struct Pre { float r[2][4]; };
    DI Pre preload(const Unit& u, int wr, int fr) const { Pre p; asm volatile("" : "+v"(fr)); const int row0 = u.arow + wr * 64 + fr;
#pragma unroll
        for (int ai = 0; ai < 2; ++ai)
#pragma unroll
            for (int m = 0; m < 4; ++m) p.r[ai][m] = rs[row0 + ai * 128 + m * 16];
        return p; }
    template <int T> DI void run(const f32x4 (&acc)[2][2][4][2], const Unit& u, int wr, int wc, int fr, int fq, const Pre& pre) const {
        const int row0 = u.arow + wr * 64 + fr, colt = u.pn * 256 + wc * 32 + 8 * fq;
        float rsr[2][4];
#pragma unroll
        for (int ai = 0; ai < 2; ++ai)
#pragma unroll
            for (int m = 0; m < 4; ++m) rsr[ai][m] = pre.r[ai][m];
#pragma unroll
        for (int bj = 0; bj < 2; ++bj) {
            float lb[8];
#pragma unroll
            for (int j = 0; j < 8; ++j) lb[j] = (T == 1 && !lbz) ? LB[colt - 512 + bj * 128 + j] : 0.f;
            const f32x4 c0 = *(const LAS f32x4*)(cmax + colt + bj * 128) * (1.0f / 127.0f), c1 = *(const LAS f32x4*)(cmax + colt + bj * 128 + 4) * (1.0f / 127.0f);
#pragma unroll
            for (int ai = 0; ai < 2; ++ai)
#pragma unroll
                for (int m = 0; m < 4; ++m) { GAS bf16* rowp = P + (size_t)(row0 + ai * 128 + m * 16) * INC + colt;
                    const f32x4 w0 = acc[ai][bj][m][0] * (c0 * rsr[ai][m]), w1 = acc[ai][bj][m][1] * (c1 * rsr[ai][m]);
                    float v[8] = {w0[0], w0[1], w0[2], w0[3], w1[0], w1[1], w1[2], w1[3]};
                    act8<T>(v, lb);
                    *(GAS v4u*)(rowp + bj * 128) = pack8f(v);
                    __builtin_amdgcn_sched_barrier(0); }
        }
    }
    DI void operator()(const f32x4 (&acc)[2][2][4][2], const Unit& u, int wr, int wc, int fr, int fq, const Pre& pre) const {
        const int t = u.pn >> 1;
        if (t == 0) run<0>(acc, u, wr, wc, fr, fq, pre);
        else if (t == 1 || t == 2) run<1>(acc, u, wr, wc, fr, fq, pre);
        else if (t == 3 || t == 5) run<2>(acc, u, wr, wc, fr, fq, pre);
        else if (t == 4) run<3>(acc, u, wr, wc, fr, fq, pre);
        else run<4>(acc, u, wr, wc, fr, fq, pre);
    }
};
template <int MODE> struct EpiRow {
    static constexpr bool PERM = true; static constexpr bool HAS_PRE = false;
    GAS bf16* O; int ldc; const GAS float* colscale; int g2off;
    DI void operator()(const f32x4 (&acc)[2][2][4][2], const Unit& u, int wr, int wc, int fr, int fq) const {
        const int row0 = u.arow + wr * 64 + fr, colt = u.pn * 256 + wc * 32 + 8 * fq;
        if constexpr (MODE == 0) {
            float cs[2][8];
#pragma unroll
            for (int bj = 0; bj < 2; ++bj)
#pragma unroll
                for (int j = 0; j < 8; ++j) cs[bj][j] = colscale ? colscale[colt + bj * 128 + j] : 1.f;
#pragma unroll
            for (int ai = 0; ai < 2; ++ai)
#pragma unroll
                for (int m = 0; m < 4; ++m) { GAS bf16* rowp = O + (size_t)(row0 + ai * 128 + m * 16) * ldc + colt;
#pragma unroll
                    for (int bj = 0; bj < 2; ++bj) { const f32x4 v0 = acc[ai][bj][m][0], v1 = acc[ai][bj][m][1];
                        float o[8] = {v0[0], v0[1], v0[2], v0[3], v1[0], v1[1], v1[2], v1[3]};
#pragma unroll
                        for (int j = 0; j < 8; ++j) o[j] *= cs[bj][j];
                        v4u w; w.x = pk2(o[0], o[1]); w.y = pk2(o[2], o[3]); w.z = pk2(o[4], o[5]); w.w = pk2(o[6], o[7]);
                        *(GAS v4u*)(rowp + bj * 128) = w; } }
        } else if constexpr (MODE == 1) {
            v4u gq[2][4], r0[2][4];
#pragma unroll
            for (int ai = 0; ai < 2; ++ai)
#pragma unroll
                for (int m = 0; m < 4; ++m) gq[ai][m] = *(const GAS v4u*)(O + (size_t)(row0 + ai * 128 + m * 16) * ldc + colt);
#pragma unroll
            for (int ai = 0; ai < 2; ++ai)
#pragma unroll
                for (int m = 0; m < 4; ++m) { const f32x4 v0 = acc[ai][0][m][0], v1 = acc[ai][0][m][1]; const v4u g = gq[ai][m];
                    v4u w; w.x = pk2(v0[0] * bflo(g.x), v0[1] * bfhi(g.x)); w.y = pk2(v0[2] * bflo(g.y), v0[3] * bfhi(g.y)); w.z = pk2(v1[0] * bflo(g.z), v1[1] * bfhi(g.z)); w.w = pk2(v1[2] * bflo(g.w), v1[3] * bfhi(g.w));
                    r0[ai][m] = w; }
            __builtin_amdgcn_sched_barrier(0);
#pragma unroll
            for (int ai = 0; ai < 2; ++ai)
#pragma unroll
                for (int m = 0; m < 4; ++m) gq[ai][m] = *(const GAS v4u*)(O + (size_t)(row0 + ai * 128 + m * 16) * ldc + colt + 128);
            __builtin_amdgcn_sched_barrier(0);
#pragma unroll
            for (int ai = 0; ai < 2; ++ai)
#pragma unroll
                for (int m = 0; m < 4; ++m) *(GAS v4u*)(O + (size_t)(row0 + ai * 128 + m * 16) * ldc + colt) = r0[ai][m];
            __builtin_amdgcn_sched_barrier(0);
#pragma unroll
            for (int ai = 0; ai < 2; ++ai)
#pragma unroll
                for (int m = 0; m < 4; ++m) { const f32x4 v0 = acc[ai][1][m][0], v1 = acc[ai][1][m][1]; const v4u g = gq[ai][m];
                    v4u w; w.x = pk2(v0[0] * bflo(g.x), v0[1] * bfhi(g.x)); w.y = pk2(v0[2] * bflo(g.y), v0[3] * bfhi(g.y)); w.z = pk2(v1[0] * bflo(g.z), v1[1] * bfhi(g.z)); w.w = pk2(v1[2] * bflo(g.w), v1[3] * bfhi(g.w));
                    *(GAS v4u*)(O + (size_t)(row0 + ai * 128 + m * 16) * ldc + colt + 128) = w; }
        } else {
            v4u gq[2][4], pq[2][4], rq[4];
            auto LD = [&](int q, int slot) {
#pragma unroll
                for (int m = 0; m < 4; ++m) { const GAS bf16* rp = O + (size_t)(row0 + (q & 1) * 128 + m * 16) * ldc + colt + (q >> 1) * 128; gq[slot][m] = *(const GAS v4u*)(rp + g2off); pq[slot][m] = *(const GAS v4u*)rp; } };
            auto CP = [&](int q, int slot) {
#pragma unroll
                for (int m = 0; m < 4; ++m) { const f32x4 v0 = acc[q & 1][q >> 1][m][0], v1 = acc[q & 1][q >> 1][m][1]; const v4u g = gq[slot][m], t = pq[slot][m];
                    v4u w; w.x = pk2(bflo(t.x) + v0[0] * bflo(g.x), bfhi(t.x) + v0[1] * bfhi(g.x)); w.y = pk2(bflo(t.y) + v0[2] * bflo(g.y), bfhi(t.y) + v0[3] * bfhi(g.y));
                    w.z = pk2(bflo(t.z) + v1[0] * bflo(g.z), bfhi(t.z) + v1[1] * bfhi(g.z)); w.w = pk2(bflo(t.w) + v1[2] * bflo(g.w), bfhi(t.w) + v1[3] * bfhi(g.w));
                    rq[m] = w; } };
            auto ST = [&](int q) {
#pragma unroll
                for (int m = 0; m < 4; ++m) *(GAS v4u*)(O + (size_t)(row0 + (q & 1) * 128 + m * 16) * ldc + colt + (q >> 1) * 128) = rq[m]; };
            LD(0, 0); LD(1, 1); __builtin_amdgcn_sched_barrier(0);
            CP(0, 0); __builtin_amdgcn_sched_barrier(0); LD(2, 0); __builtin_amdgcn_sched_barrier(0); ST(0); __builtin_amdgcn_sched_barrier(0);
            CP(1, 1); __builtin_amdgcn_sched_barrier(0); LD(3, 1); __builtin_amdgcn_sched_barrier(0); ST(1); __builtin_amdgcn_sched_barrier(0);
            CP(2, 0); ST(2); __builtin_amdgcn_sched_barrier(0);
            CP(3, 1); ST(3);
        }
    }
};
template <bool OUT8> struct EpiSwiGLU {
    static constexpr bool PERM = true; static constexpr bool HAS_PRE = true;
    GAS bf16* Hh; int ldc; const GAS float* rowgate;
    const GAS float* rs; const LAS float* cmg; const LAS float* cmu;
    struct Pre { float r[2][4]; };
    DI Pre preload(const Unit& u, int wr, int fr) const { Pre p; asm volatile("" : "+v"(fr)); const int row0 = u.arow + wr * 64 + fr;
#pragma unroll
        for (int ai = 0; ai < 2; ++ai)
#pragma unroll
            for (int m = 0; m < 4; ++m) p.r[ai][m] = rs[row0 + ai * 128 + m * 16];
        return p; }
    DI void operator()(const f32x4 (&acc)[2][2][4][2], const Unit& u, int wr, int wc, int fr, int fq, const Pre& pre) const {
        const int row0 = u.arow + wr * 64 + fr, col0 = u.pn * 128 + wc * 32 + 8 * fq;
        const f32x4 sg4[2] = {*(const LAS f32x4*)(cmg + col0) * (1.0f / 127.0f), *(const LAS f32x4*)(cmg + col0 + 4) * (1.0f / 127.0f)}, su4[2] = {*(const LAS f32x4*)(cmu + col0) * (1.0f / 127.0f), *(const LAS f32x4*)(cmu + col0 + 4) * (1.0f / 127.0f)};
        float rsv[2][4], rgv[2][4];
#pragma unroll
        for (int ai = 0; ai < 2; ++ai)
#pragma unroll
            for (int m = 0; m < 4; ++m) { rsv[ai][m] = pre.r[ai][m]; rgv[ai][m] = rowgate ? rowgate[row0 + ai * 128 + m * 16] : 1.f; }
#pragma unroll
        for (int ai = 0; ai < 2; ++ai)
#pragma unroll
            for (int m = 0; m < 4; ++m) { const int row = row0 + ai * 128 + m * 16; const float rg = rgv[ai][m];
                const f32x4 g0 = acc[ai][0][m][0], g1 = acc[ai][0][m][1], u0 = acc[ai][1][m][0], u1 = acc[ai][1][m][1];
                const float rsr = rsv[ai][m];
                const f32x4 a0 = g0 * (sg4[0] * rsr), a1 = g1 * (sg4[1] * rsr), b0 = u0 * (su4[0] * (rsr * rg)), b1 = u1 * (su4[1] * (rsr * rg));
                f32x2 g2[4] = {lo2(a0), hi2(a0), lo2(a1), hi2(a1)}, u2[4] = {lo2(b0), hi2(b0), lo2(b1), hi2(b1)}, e2[4];
#pragma unroll
                for (int p = 0; p < 4; ++p) e2[p] = ex2p(g2[p] * (f32x2){-1.4426950408889634f, -1.4426950408889634f});
#pragma unroll
                for (int p = 0; p < 4; ++p) e2[p] = e2[p] + (f32x2){1.0f, 1.0f};
#pragma unroll
                for (int p = 0; p < 4; ++p) e2[p] = rcpp(e2[p]);
#pragma unroll
                for (int p = 0; p < 4; ++p) g2[p] = g2[p] * u2[p];
#pragma unroll
                for (int p = 0; p < 4; ++p) g2[p] = g2[p] * e2[p];
                if constexpr (OUT8) { v2u w; w.x = pk4_fp8(g2[0].x, g2[0].y, g2[1].x, g2[1].y); w.y = pk4_fp8(g2[2].x, g2[2].y, g2[3].x, g2[3].y);
                    *(GAS v2u*)((GAS unsigned char*)Hh + (size_t)row * ldc + col0) = w; }
                else *(GAS v4u*)(Hh + (size_t)row * ldc + col0) = pack8p(g2); }
    }
};
template <class E> struct EpiDry { static constexpr bool PERM = E::PERM; static constexpr bool HAS_PRE = false; E e; bool never;
    DI void operator()(const f32x4 (&acc)[2][2][4][2], const Unit& u, int wr, int wc, int fr, int fq) const { if (never) e(acc, u, wr, wc, fr, fq); } };
struct EpiSwiGLU8 {
    static constexpr bool PERM = true; static constexpr bool HAS_PRE = false;
    GAS unsigned char* Hh; int ldc; const GAS float* rowgate;
    DI void operator()(const f32x4 (&acc)[2][2][4][2], const Unit& u, int wr, int wc, int fr, int fq) const {
        const int row0 = u.arow + wr * 64 + fr, col0 = u.pn * 128 + wc * 32 + 8 * fq;
        float rgv[2][4];
#pragma unroll
        for (int ai = 0; ai < 2; ++ai)
#pragma unroll
            for (int m = 0; m < 4; ++m) rgv[ai][m] = rowgate ? rowgate[row0 + ai * 128 + m * 16] : 1.f;
#pragma unroll
        for (int ai = 0; ai < 2; ++ai)
#pragma unroll
            for (int m = 0; m < 4; ++m) { const int row = row0 + ai * 128 + m * 16; const float rg = rgv[ai][m];
                const f32x4 g0 = acc[ai][0][m][0], g1 = acc[ai][0][m][1], u0 = acc[ai][1][m][0], u1 = acc[ai][1][m][1];
                f32x2 g2[4] = {lo2(g0), hi2(g0), lo2(g1), hi2(g1)}, u2[4] = {lo2(u0), hi2(u0), lo2(u1), hi2(u1)}, e2[4];
#pragma unroll
                for (int p = 0; p < 4; ++p) e2[p] = ex2p(g2[p] * (f32x2){-1.4426950408889634f, -1.4426950408889634f});
#pragma unroll
                for (int p = 0; p < 4; ++p) { e2[p] = e2[p] + (f32x2){1.0f, 1.0f}; u2[p] = u2[p] * (f32x2){rg, rg}; }
#pragma unroll
                for (int p = 0; p < 4; ++p) e2[p] = rcpp(e2[p]);
#pragma unroll
                for (int p = 0; p < 4; ++p) g2[p] = g2[p] * u2[p];
#pragma unroll
                for (int p = 0; p < 4; ++p) g2[p] = g2[p] * e2[p];
                v2u w; w.x = pk4_fp8(g2[0].x, g2[0].y, g2[1].x, g2[1].y); w.y = pk4_fp8(g2[2].x, g2[2].y, g2[3].x, g2[3].y);
                *(GAS v2u*)(Hh + (size_t)row * ldc + col0) = w; }
    }
};
}

struct Args { const float* in[25]; float* out; unsigned char* ws; int ph_lo, ph_hi; };
struct Frame {
    LAS unsigned char* lds; int tid, lane, wave, G, gw, NGW; bool never;
    GAS float* out; GAS unsigned char* ws;
};
DI Frame fresh(const Frame& F0) { Frame F = F0; asm volatile("" : "+v"(F.tid)); F.lane = F.tid & 63; asm volatile("" : "+s"(F.ws), "+s"(F.out)); return F; }
enum { I_X = 0, I_C, I_CTX, I_CCTX, I_ADAW, I_ADAB, I_MIXPRE, I_MIXPOST, I_FFNPRE, I_FFNPOST, I_WIN, I_LB, I_GAIN, I_POOLW, I_POOLS, I_WBR, I_WBP, I_WOUT, I_FG, I_FU, I_FD, I_ROUTER, I_MG, I_MU, I_MD };

DI void tr_item(const GAS float* W, int K, int N, GAS bf16* WT, int ldk, int koff, int row_off, int nb, int nstride, LAS float* scr, int item, int lane) {
    const int nblk = N / 32, kb = item / nblk, nbi = item % nblk, k0 = 64 * kb, n0 = 32 * nbi;
    f32x4 ld[8];
#pragma unroll
    for (int i = 0; i < 8; ++i) ld[i] = *(const GAS f32x4*)(W + (size_t)(k0 + (lane >> 3) + 8 * i) * N + n0 + 4 * (lane & 7));
#pragma unroll
    for (int i = 0; i < 8; ++i) { LAS float* d = scr + ((lane >> 3) + 8 * i) * 33 + 4 * (lane & 7); d[0] = ld[i].x; d[1] = ld[i].y; d[2] = ld[i].z; d[3] = ld[i].w; }
    LDS_WAIT(); asm volatile("" ::: "memory");
    const int c = lane & 7;
#pragma unroll
    for (int j = 0; j < 4; ++j) { const int n = (lane >> 3) + 8 * j; const LAS float* s = scr + (8 * c) * 33 + n;
        v4u o; o.x = pk2(s[0 * 33], s[1 * 33]); o.y = pk2(s[2 * 33], s[3 * 33]); o.z = pk2(s[4 * 33], s[5 * 33]); o.w = pk2(s[6 * 33], s[7 * 33]);
        const int ng = n0 + n, drow = row_off + (ng / nb) * nstride + (ng % nb);
        *(GAS v4u*)(WT + (size_t)drow * ldk + koff + k0 + 8 * c) = o; }
    LDS_WAIT(); asm volatile("" ::: "memory");
}

DI void tr_item8(const GAS float* W, int K, int N, GAS unsigned char* WT, int ldk, int row_off, int nb, int nstride, float qs, LAS float* scr, int item, int lane) {
    const int nblk = N / 32, kb = item / nblk, nbi = item % nblk, k0 = 64 * kb, n0 = 32 * nbi;
    f32x4 ld[8];
#pragma unroll
    for (int i = 0; i < 8; ++i) ld[i] = *(const GAS f32x4*)(W + (size_t)(k0 + (lane >> 3) + 8 * i) * N + n0 + 4 * (lane & 7));
#pragma unroll
    for (int i = 0; i < 8; ++i) { LAS float* d = scr + ((lane >> 3) + 8 * i) * 33 + 4 * (lane & 7); d[0] = ld[i].x; d[1] = ld[i].y; d[2] = ld[i].z; d[3] = ld[i].w; }
    LDS_WAIT(); asm volatile("" ::: "memory");
    const int c = lane & 7;
#pragma unroll
    for (int j = 0; j < 4; ++j) { const int n = (lane >> 3) + 8 * j; const LAS float* sp = scr + (8 * c) * 33 + n;
        v2u o; o.x = pk4_fp8(sp[0 * 33] * qs, sp[1 * 33] * qs, sp[2 * 33] * qs, sp[3 * 33] * qs); o.y = pk4_fp8(sp[4 * 33] * qs, sp[5 * 33] * qs, sp[6 * 33] * qs, sp[7 * 33] * qs);
        const int ng = n0 + n, drow = row_off + (ng / nb) * nstride + (ng % nb);
        *(GAS v2u*)(WT + (size_t)drow * ldk + k0 + 8 * c) = o; }
    LDS_WAIT(); asm volatile("" ::: "memory");
}

DI void absmax_item(const GAS float* W, int N, GAS unsigned* cmaxbits, int item, int lane) {
    const int nblk = N / 256, kb = item / nblk, nbi = item % nblk;
    const GAS float* p = W + (size_t)(64 * kb) * N + 256 * nbi + 4 * lane;
    f32x4 m = (f32x4){0.f, 0.f, 0.f, 0.f};
#pragma unroll 8
    for (int k = 0; k < 64; ++k) { const f32x4 w = *(const GAS f32x4*)(p + (size_t)k * N); m.x = fmaxf(m.x, fabsf(w.x)); m.y = fmaxf(m.y, fabsf(w.y)); m.z = fmaxf(m.z, fabsf(w.z)); m.w = fmaxf(m.w, fabsf(w.w)); }
    GAS unsigned* c = cmaxbits + 256 * nbi + 4 * lane;
    __hip_atomic_fetch_max(c + 0, __float_as_uint(m.x), __ATOMIC_RELAXED, __HIP_MEMORY_SCOPE_AGENT); __hip_atomic_fetch_max(c + 1, __float_as_uint(m.y), __ATOMIC_RELAXED, __HIP_MEMORY_SCOPE_AGENT);
    __hip_atomic_fetch_max(c + 2, __float_as_uint(m.z), __ATOMIC_RELAXED, __HIP_MEMORY_SCOPE_AGENT); __hip_atomic_fetch_max(c + 3, __float_as_uint(m.w), __ATOMIC_RELAXED, __HIP_MEMORY_SCOPE_AGENT);
}
DI void tr_item_i8(const GAS float* W, int K, int N, GAS unsigned char* WT, int ldk, const GAS float* cmax, LAS float* scr, int item, int lane, int row_off = 0, int nb = 1 << 30, int nstride = 0) {
    const int nblk = N / 32, kb = item / nblk, nbi = item % nblk, k0 = 64 * kb, n0 = 32 * nbi;
    f32x4 ld[8];
#pragma unroll
    for (int i = 0; i < 8; ++i) ld[i] = *(const GAS f32x4*)(W + (size_t)(k0 + (lane >> 3) + 8 * i) * N + n0 + 4 * (lane & 7));
#pragma unroll
    for (int i = 0; i < 8; ++i) { LAS float* d = scr + ((lane >> 3) + 8 * i) * 33 + 4 * (lane & 7); d[0] = ld[i].x; d[1] = ld[i].y; d[2] = ld[i].z; d[3] = ld[i].w; }
    LDS_WAIT(); asm volatile("" ::: "memory");
    const int c = lane & 7;
#pragma unroll
    for (int j = 0; j < 4; ++j) { const int n = (lane >> 3) + 8 * j; const LAS float* sp = scr + (8 * c) * 33 + n;
        const float q = 127.0f / fmaxf(cmax[n0 + n], 1e-30f);
        v2u o; o.x = pk4_i8(sp[0 * 33] * q, sp[1 * 33] * q, sp[2 * 33] * q, sp[3 * 33] * q); o.y = pk4_i8(sp[4 * 33] * q, sp[5 * 33] * q, sp[6 * 33] * q, sp[7 * 33] * q);
        const int ng = n0 + n, drow = row_off + (ng / nb) * nstride + (ng % nb);
        *(GAS v2u*)(WT + (size_t)drow * ldk + k0 + 8 * c) = o; }
    LDS_WAIT(); asm volatile("" ::: "memory");
}

DI void p0_prologue(const Frame& F0, const Args& A) {
    const Frame F = fresh(F0);
    LAS float* scr = (LAS float*)(F.lds + F.wave * 16384);
    GAS unsigned char* ws = F.ws;
    constexpr int IT_IN = 16 * 160, IT_BR = 8 * 32, IT_O = 16 * 32, IT_F = 16 * 88, IT_FD = 44 * 32;
    constexpr int PER_L = IT_BR + IT_O;
    constexpr int NITEMS = 2 * PER_L + IT_FD;
    for (int it = F.gw; it < NITEMS; it += F.NGW) {
        int r = it;
        if (r < 2 * PER_L) { const int l = r / PER_L; r -= l * PER_L;
            if (r < IT_BR) { tr_item(((const GAS float*)A.in[I_WBR]) + (size_t)l * DH * D, DH, D, (GAS bf16*)(ws + WS_WR) + (size_t)l * D * DH, DH, 0, 0, 1 << 30, 0, scr, r, F.lane); continue; } r -= IT_BR;
            tr_item(((const GAS float*)A.in[I_WOUT]) + (size_t)l * D * D, D, D, (GAS bf16*)(ws + WS_WO) + (size_t)l * D * D, D, 0, 0, 1 << 30, 0, scr, r, F.lane); continue; }
        r -= 2 * PER_L;
        tr_item8(((const GAS float*)A.in[I_FD]), DFF, D, ws + WS_WD, DFF, 0, 1 << 30, 0, 64.f, scr, r, F.lane);
    }
    for (int it = F.gw; it < 2 * 16 * 20; it += F.NGW) { const int l = it / 320;
        absmax_item(((const GAS float*)A.in[I_WIN]) + (size_t)l * D * INC, INC, (GAS unsigned*)(ws + WS_CTL) + CW_CMAX_IN + l * INC, it % 320, F.lane); }
    for (int it = F.gw; it < 2 * 16 * 11; it += F.NGW) { const int w = it / 176;
        absmax_item((const GAS float*)A.in[w ? I_FU : I_FG], DFF, (GAS unsigned*)(ws + WS_CTL) + (w ? CW_CMAX_FU : CW_CMAX_FG), it % 176, F.lane); }
    for (int item = blockIdx.x; item < 2 * 4 * 16 * 2; item += F.G) {
        const int l = item >> 7, g = (item >> 5) & 3, cb = (item >> 1) & 15, n = (item & 1) * 512 + F.tid;
        const GAS float* pw = ((const GAS float*)A.in[I_POOLW]) + (((size_t)l * 4 + g) * 128 + cb * 8) * 128;
        const GAS float* ps = ((const GAS float*)A.in[I_POOLS]) + l * DH + g * 128;
        const GAS float* wp = ((const GAS float*)A.in[I_WBP]) + ((size_t)l * DH + g * 128) * D + n;
        float acc[8];
#pragma unroll
        for (int j = 0; j < 8; ++j) acc[j] = 0.f;
#pragma unroll 8
        for (int e = 0; e < 128; ++e) { const float w = wp[(size_t)e * D] * ps[e];
#pragma unroll
            for (int j = 0; j < 8; ++j) acc[j] += pw[j * 128 + e] * w; }
        v4u o; o.x = pk2(acc[0], acc[1]); o.y = pk2(acc[2], acc[3]); o.z = pk2(acc[4], acc[5]); o.w = pk2(acc[6], acc[7]);
        *(GAS v4u*)((GAS bf16*)(ws + WS_WP) + ((size_t)l * D + n) * DH + g * 128 + cb * 8) = o;
    }
    for (int i = blockIdx.x * NTHR + F.tid; i < 2 * 2 * DH; i += F.G * NTHR) {
        const int l = i / (2 * DH), rem = i % (2 * DH);
        float v = 0.f;
        if (l == 1) { const float h0 = ((const GAS float*)A.in[I_LB])[rem], h1 = ((const GAS float*)A.in[I_LB])[2 * DH + rem]; v = 1.f / (1.f + expf(h0 - h1)); }
        ((GAS float*)(ws + WS_LB))[i] = v;
    }
    __syncthreads();
    constexpr int TP = 1026;
    LAS float* T = (LAS float*)F.lds;
    for (int item = blockIdx.x; item < 2 * 96; item += F.G) {
        const int l = item / 96, e0 = (item % 96) * 64;
        for (int i = F.tid; i < 33 * 1024; i += NTHR) { const int bb = i >> 10, k = i & 1023; const float cv = bb < 32 ? ((const GAS float*)A.in[I_C])[bb * 1024 + k] : ((const GAS float*)A.in[I_CCTX])[k];
            T[bb * TP + k] = cv * __builtin_amdgcn_rcpf(1.0f + __builtin_amdgcn_exp2f(-1.4426950408889634f * cv)); }
        __syncthreads();
        const int kq = F.wave, j = F.lane & 31, kk = F.lane >> 5;
        const GAS float* wp = ((const GAS float*)A.in[I_ADAW]) + (size_t)l * D * 6144 + (size_t)(128 * kq + kk) * 6144 + e0 + 2 * j;
        const LAS float* tp = T + j * TP + 128 * kq + kk; const LAS float* t32 = T + 32 * TP + 128 * kq + kk;
        f32x16 acc0, acc1;
#pragma unroll
        for (int r = 0; r < 16; ++r) { acc0[r] = 0.f; acc1[r] = 0.f; }
        float c0 = 0.f, c1 = 0.f;
#pragma unroll 1
        for (int bt = 0; bt < 8; ++bt) { f32x2 wb[8];
#pragma unroll
            for (int u = 0; u < 8; ++u) wb[u] = *(const GAS f32x2*)(wp + (size_t)(2 * (8 * bt + u)) * 6144);
#pragma unroll
            for (int u = 0; u < 8; ++u) { const int s2 = 8 * bt + u; const float a = tp[2 * s2], tc = t32[2 * s2]; const f32x2 w = wb[u];
                acc0 = __builtin_amdgcn_mfma_f32_32x32x2f32(a, w.x, acc0, 0, 0, 0);
                acc1 = __builtin_amdgcn_mfma_f32_32x32x2f32(a, w.y, acc1, 0, 0, 0);
                c0 += tc * w.x; c1 += tc * w.y; }
        }
        c0 += __shfl_xor(c0, 32); c1 += __shfl_xor(c1, 32);
        __syncthreads();
        LAS float* R = (LAS float*)F.lds;
#pragma unroll
        for (int r = 0; r < 16; ++r) { const int i = 8 * (r >> 2) + 4 * kk + (r & 3); R[(kq * 33 + i) * 64 + 2 * j] = acc0[r]; R[(kq * 33 + i) * 64 + 2 * j + 1] = acc1[r]; }
        if (kk == 0) { R[(kq * 33 + 32) * 64 + 2 * j] = c0; R[(kq * 33 + 32) * 64 + 2 * j + 1] = c1; }
        __syncthreads();
        for (int i = F.tid; i < 33 * 64; i += NTHR) { const int b = i >> 6, c = i & 63; float sm = 0.f;
#pragma unroll
            for (int q = 0; q < 8; ++q) sm += R[(q * 33 + b) * 64 + c];
            ((GAS float*)(ws + WS_MOD))[((size_t)l * 33 + b) * 6144 + e0 + c] = sm + ((const GAS float*)A.in[I_ADAB])[l * 6144 + e0 + c]; }
        __syncthreads();
    }
}

DI void win_to_i8(const Frame& F0, const Args& A) {
    const Frame F = fresh(F0);
    LAS float* scr = (LAS float*)(F.lds + F.wave * 16384);
    for (int it = F.gw; it < 2 * 16 * 160; it += F.NGW) { const int l = it / 2560;
        tr_item_i8(((const GAS float*)A.in[I_WIN]) + (size_t)l * D * INC, D, INC, F.ws + WS_WIN + (size_t)l * INC * D, D, (const GAS float*)(F.ws + WS_CTL) + CW_CMAX_IN + l * INC, scr, it % 2560, F.lane); }
    for (int it = F.gw; it < 2 * 16 * 88; it += F.NGW) { const int w = it / 1408;
        tr_item_i8((const GAS float*)A.in[w ? I_FU : I_FG], D, DFF, F.ws + WS_WGU, D, (const GAS float*)(F.ws + WS_CTL) + (w ? CW_CMAX_FU : CW_CMAX_FG), scr, it % 1408, F.lane, w ? 128 : 0, 128, 256); }
}
constexpr int MOE_CONV_ITEMS = NE * (2 * 16 * 112 + 56 * 32), MOE_C1 = 16000, MOE_C2 = 8000;
DI void moe_weight_convert(const Frame& F0, const Args& A, int it0, int it1, int wg0) {
    const Frame F = fresh(F0);
    if ((int)blockIdx.x < wg0) return;
    LAS float* scr = (LAS float*)(F.lds + F.wave * 16384);
    constexpr int IT_G = 16 * 112, IT_D = 56 * 32, PER_E = 2 * IT_G + IT_D;
    for (int it = it0 + ((int)blockIdx.x - wg0) * NWAVES + F.wave; it < it1; it += (F.G - wg0) * NWAVES) {
        const int e = it / PER_E; int r = it % PER_E;
        GAS unsigned char* gu = F.ws + WS_MGU + (size_t)e * 2 * DEX * D;
        if (r < IT_G) { tr_item8(((const GAS float*)A.in[I_MG]) + (size_t)e * D * DEX, D, DEX, gu, D, 0, 128, 256, 32.f, scr, r, F.lane); continue; } r -= IT_G;
        if (r < IT_G) { tr_item8(((const GAS float*)A.in[I_MU]) + (size_t)e * D * DEX, D, DEX, gu, D, 128, 128, 256, 32.f, scr, r, F.lane); continue; } r -= IT_G;
        tr_item8(((const GAS float*)A.in[I_MD]) + (size_t)e * DEX * D, DEX, D, F.ws + WS_MD + (size_t)e * D * DEX, DEX, 0, 1 << 30, 0, 64.f, scr, r, F.lane);
    }
}

struct RowVecs { f32x4 a1[4], a2[4], a3[4]; };
DI void load_rowvecs(RowVecs& V, const GAS float* gatev, const GAS float* postg, const GAS float* preg, const GAS float* sc, const GAS float* sh, int lane) {
#pragma unroll
    for (int j = 0; j < 4; ++j) { const int e = 4 * lane + 256 * j;
        if (gatev) { const f32x4 g = *(const GAS f32x4*)(gatev + e), p = *(const GAS f32x4*)(postg + e); V.a1[j] = g * p; } else V.a1[j] = (f32x4){0.f, 0.f, 0.f, 0.f};
        if (preg) { const f32x4 p = *(const GAS f32x4*)(preg + e), s = *(const GAS f32x4*)(sc + e); V.a2[j] = p * (s + 1.0f); V.a3[j] = *(const GAS f32x4*)(sh + e); }
        else { V.a2[j] = (f32x4){0.f, 0.f, 0.f, 0.f}; V.a3[j] = V.a2[j]; } }
}
struct RowData { f32x4 x[4]; v2u y[4]; };
DI GAS bf16* xb_row(GAS float* out, int r) { return (GAS bf16*)(out + (size_t)r * D) + D; }
DI void row_load(RowData& R, const GAS float* xin, const GAS bf16* xinb, const GAS bf16* y, int lane) {
    if (xinb) {
#pragma unroll
        for (int j = 0; j < 4; ++j) { const v2u w = *(const GAS v2u*)(xinb + 4 * lane + 256 * j); R.x[j] = (f32x4){bflo(w.x), bfhi(w.x), bflo(w.y), bfhi(w.y)}; }
    } else {
#pragma unroll
        for (int j = 0; j < 4; ++j) R.x[j] = *(const GAS f32x4*)(xin + 4 * lane + 256 * j);
    }
    if (y) {
#pragma unroll
        for (int j = 0; j < 4; ++j) R.y[j] = *(const GAS v2u*)(y + 4 * lane + 256 * j);
    }
}
DI void row_compute(const RowData& R, bool hasy, GAS float* xout, GAS bf16* xoutb, GAS bf16* hout, const RowVecs& V, int lane, f32x4 (&hv)[4], GAS unsigned char* hout8 = nullptr, GAS unsigned char* hout_i8 = nullptr, GAS float* rs_out = nullptr) {
    f32x4 v[4];
#pragma unroll
    for (int j = 0; j < 4; ++j) v[j] = R.x[j];
    if (hasy) {
        f32x4 yv[4]; float ss = 0.f;
#pragma unroll
        for (int j = 0; j < 4; ++j) { const v2u w = R.y[j]; yv[j] = (f32x4){bflo(w.x), bfhi(w.x), bflo(w.y), bfhi(w.y)};
            ss += (yv[j].x * yv[j].x + yv[j].y * yv[j].y) + (yv[j].z * yv[j].z + yv[j].w * yv[j].w); }
        const float r = 1.0f / sqrtf(wave_sum(ss) * (1.0f / D) + EPS);
#pragma unroll
        for (int j = 0; j < 4; ++j) v[j] += V.a1[j] * (yv[j] * r);
    }
    if (xout) {
#pragma unroll
        for (int j = 0; j < 4; ++j) *(GAS f32x4*)(xout + 4 * lane + 256 * j) = v[j];
    }
    if (xoutb) {
#pragma unroll
        for (int j = 0; j < 4; ++j) { v2u w; w.x = pk2(v[j].x, v[j].y); w.y = pk2(v[j].z, v[j].w); *(GAS v2u*)(xoutb + 4 * lane + 256 * j) = w; }
    }
    if (hout || hout8 || hout_i8) {
        float ss = 0.f;
#pragma unroll
        for (int j = 0; j < 4; ++j) ss += (v[j].x * v[j].x + v[j].y * v[j].y) + (v[j].z * v[j].z + v[j].w * v[j].w);
        const float r = 1.0f / sqrtf(wave_sum(ss) * (1.0f / D) + EPS);
#pragma unroll
        for (int j = 0; j < 4; ++j) hv[j] = (v[j] * r) * V.a2[j] + V.a3[j];
        if (hout_i8) {
            float m = 0.f;
#pragma unroll
            for (int j = 0; j < 4; ++j) m = fmaxf(m, fmaxf(fmaxf(fabsf(hv[j].x), fabsf(hv[j].y)), fmaxf(fabsf(hv[j].z), fabsf(hv[j].w))));
            m = fmaxf(wave_max(m), 1e-30f); const float isc = 127.0f / m;
#pragma unroll
            for (int j = 0; j < 4; ++j) *(GAS unsigned*)(hout_i8 + 4 * lane + 256 * j) = pk4_i8(hv[j].x * isc, hv[j].y * isc, hv[j].z * isc, hv[j].w * isc);
            if (lane == 0) *rs_out = m * (1.0f / 127.0f);
        } else
#pragma unroll
        for (int j = 0; j < 4; ++j) {
            if (hout8) *(GAS unsigned*)(hout8 + 4 * lane + 256 * j) = pk4_fp8(hv[j].x, hv[j].y, hv[j].z, hv[j].w);
            else { v2u w; w.x = pk2(hv[j].x, hv[j].y); w.y = pk2(hv[j].z, hv[j].w); *(GAS v2u*)(hout + 4 * lane + 256 * j) = w; } }
    }
}
DI const GAS float* modp(const Frame& F, int l, int bb, int which) { return (const GAS float*)(F.ws + WS_MOD) + ((size_t)l * 33 + bb) * 6144 + which * 1024; }

DI void route_row(const Frame& F, const LAS float* RT, LAS unsigned* lcount, const f32x4 (&hv)[4], int r) {
                float lg[8];
#pragma unroll
                for (int e = 0; e < 8; ++e) lg[e] = 0.f;
#pragma unroll
                for (int j = 0; j < 4; ++j)
#pragma unroll
                    for (int i = 0; i < 4; ++i) { const LAS float* rp = RT + (4 * F.lane + 256 * j + i) * 8; const f32x4 ra = *(const LAS f32x4*)rp, rb = *(const LAS f32x4*)(rp + 4); const float hx = hv[j][i];
                        lg[0] += hx * ra.x; lg[1] += hx * ra.y; lg[2] += hx * ra.z; lg[3] += hx * ra.w; lg[4] += hx * rb.x; lg[5] += hx * rb.y; lg[6] += hx * rb.z; lg[7] += hx * rb.w; }
#pragma unroll
                for (int e = 0; e < 8; ++e) lg[e] = wave_sum(lg[e]);
                int e0 = 0; float v0 = lg[0];
#pragma unroll
                for (int e = 1; e < 8; ++e) if (lg[e] > v0) { v0 = lg[e]; e0 = e; }
                int e1 = -1; float v1 = -3.0e38f;
#pragma unroll
                for (int e = 0; e < 8; ++e) if (e != e0 && lg[e] > v1) { v1 = lg[e]; e1 = e; }
                if (F.lane == 0) {
                    const float p1 = 1.0f / (1.0f + expf(v0 - v1)), p0 = 1.0f - p1;
                    const int sl = slice_of(r);
                    const unsigned k0 = __hip_atomic_fetch_add(lcount + sl * 8 + e0, 1u, __ATOMIC_RELAXED, __HIP_MEMORY_SCOPE_WORKGROUP), k1 = __hip_atomic_fetch_add(lcount + sl * 8 + e1, 1u, __ATOMIC_RELAXED, __HIP_MEMORY_SCOPE_WORKGROUP);
                    ((GAS i32x2*)(F.ws + WS_RTOP))[r] = (i32x2){e0, e1};
                    ((GAS f32x2*)(F.ws + WS_RPROB))[r] = (f32x2){p0, p1};
                    ((GAS i32x2*)(F.ws + WS_RRANK))[r] = (i32x2){(int)k0, (int)k1};
                }
}
template <int MODE>
DI void rows_phase(const Frame& F0, const Args& A, int l, bool dry = false) {
    const Frame F = fresh(F0);
    GAS bf16* H = (GAS bf16*)(F.ws + WS_H); GAS bf16* CX = (GAS bf16*)(F.ws + WS_CX);
    const bool route = (MODE == 1 && l == 1) && (!dry || F.never);
    const bool st = !dry || F.never;
    LAS unsigned* lcount = (LAS unsigned*)(F.lds + 64);
    LAS unsigned* lbase = (LAS unsigned*)(F.lds + 256);
    LAS float* RT = (LAS float*)(F.lds + 1024);
    if (route) {
        if (F.tid < 32) lcount[F.tid] = 0u;
        for (int i = F.tid; i < 1024 * 8; i += NTHR) RT[i] = ((const GAS float*)A.in[I_ROUTER])[i];
        __syncthreads();
    }
    RowVecs V; f32x4 hv[4];
    for (int r0 = F.gw * 32; r0 < NX; r0 += F.NGW * 32) {
        const int b = r0 >> 11;
        if (MODE == 0) load_rowvecs(V, nullptr, nullptr, ((const GAS float*)A.in[I_MIXPRE]), modp(F, 0, b, 1), modp(F, 0, b, 0), F.lane);
        if (MODE == 1) load_rowvecs(V, modp(F, l, b, 2), ((const GAS float*)A.in[I_MIXPOST]) + l * D, ((const GAS float*)A.in[I_FFNPRE]) + l * D, modp(F, l, b, 4), modp(F, l, b, 3), F.lane);
        if (MODE == 2) load_rowvecs(V, modp(F, 0, b, 5), ((const GAS float*)A.in[I_FFNPOST]), ((const GAS float*)A.in[I_MIXPRE]) + D, modp(F, 1, b, 1), modp(F, 1, b, 0), F.lane);
        const bool toi = (MODE == 0 || MODE == 2 || (MODE == 1 && l == 0)); GAS float* RS = (GAS float*)(F.ws + WS_RS);
        const bool to8 = (MODE == 1 && l == 1); GAS unsigned char* H8 = F.ws + WS_H8;
        const bool xf32 = (MODE == 0 || (MODE == 1 && l == 0));
        const GAS float* xbase = (const GAS float*)A.in[I_X];
#define XIN_F(r) (xf32 ? xbase + (size_t)(r) * D : (const GAS float*)nullptr)
#define XIN_B(r) (xf32 ? (const GAS bf16*)nullptr : (const GAS bf16*)xb_row(F.out, (r)))
        RowData Ra, Rb;
        row_load(Ra, XIN_F(r0), XIN_B(r0), MODE == 0 ? nullptr : H + (size_t)r0 * D, F.lane);
        for (int r = r0; r < r0 + 32; r += 2) {
            row_load(Rb, XIN_F(r + 1), XIN_B(r + 1), MODE == 0 ? nullptr : H + (size_t)(r + 1) * D, F.lane);
            row_compute(Ra, MODE != 0, nullptr, (MODE == 0 || !st) ? nullptr : xb_row(F.out, r), (st && !to8 && !toi) ? H + (size_t)r * D : nullptr, V, F.lane, hv, (st && to8) ? H8 + (size_t)r * D : nullptr, (st && toi) ? (GAS unsigned char*)(H + (size_t)r * D) : nullptr, RS + r);
            if (route) route_row(F, RT, lcount, hv, r);
            if (r + 2 < r0 + 32) row_load(Ra, XIN_F(r + 2), XIN_B(r + 2), MODE == 0 ? nullptr : H + (size_t)(r + 2) * D, F.lane);
            row_compute(Rb, MODE != 0, nullptr, (MODE == 0 || !st) ? nullptr : xb_row(F.out, r + 1), (st && !to8 && !toi) ? H + (size_t)(r + 1) * D : nullptr, V, F.lane, hv, (st && to8) ? H8 + (size_t)(r + 1) * D : nullptr, (st && toi) ? (GAS unsigned char*)(H + (size_t)(r + 1) * D) : nullptr, RS + r + 1);
            if (route) route_row(F, RT, lcount, hv, r + 1);
        }
#undef XIN_F
#undef XIN_B
    }
    if (route) {
        __syncthreads();
        if (F.tid < 32) lbase[F.tid] = __hip_atomic_fetch_add((GAS unsigned*)(F.ws + WS_CTL) + CW_GCOUNT + 64 * F.tid, lcount[F.tid], __ATOMIC_RELAXED, __HIP_MEMORY_SCOPE_AGENT);
        __syncthreads();
        VM_WAIT();
        if (F.lane < 32) {
            for (int r0 = F.gw * 32; r0 < NX; r0 += F.NGW * 32) { const int r = r0 + F.lane; const int sl = slice_of(r); const i32x2 t = ((GAS i32x2*)(F.ws + WS_RTOP))[r]; i32x2 k = ((GAS i32x2*)(F.ws + WS_RRANK))[r];
                    k.x += (int)lbase[sl * 8 + t.x]; k.y += (int)lbase[sl * 8 + t.y]; ((GAS i32x2*)(F.ws + WS_RRANK))[r] = k; }
        }
    }
    if (MODE == 0 || MODE == 2 || (MODE == 1 && l == 0)) {
        if (MODE == 0) load_rowvecs(V, nullptr, nullptr, ((const GAS float*)A.in[I_MIXPRE]), modp(F, 0, 32, 1), modp(F, 0, 32, 0), F.lane);
        if (MODE == 1) load_rowvecs(V, modp(F, 0, 32, 2), ((const GAS float*)A.in[I_MIXPOST]), ((const GAS float*)A.in[I_FFNPRE]), modp(F, 0, 32, 4), modp(F, 0, 32, 3), F.lane);
        if (MODE == 2) load_rowvecs(V, modp(F, 0, 32, 5), ((const GAS float*)A.in[I_FFNPOST]), ((const GAS float*)A.in[I_MIXPRE]) + D, modp(F, 1, 32, 1), modp(F, 1, 32, 0), F.lane);
        const GAS float* cbase = (const GAS float*)A.in[I_CTX];
        for (int r0 = F.gw * 4; r0 < NC; r0 += F.NGW * 4) {
            RowData Rd[4];
#pragma unroll
            for (int i = 0; i < 4; ++i) row_load(Rd[i], cbase + (size_t)(r0 + i) * D, MODE == 2 ? (const GAS bf16*)CX + (size_t)(r0 + i) * D : (const GAS bf16*)nullptr, MODE == 0 ? nullptr : H + (size_t)(NX + r0 + i) * D, F.lane);
#pragma unroll
            for (int i = 0; i < 4; ++i) { const int r = r0 + i;
                row_compute(Rd[i], MODE != 0, nullptr, (MODE == 1 && st) ? CX + (size_t)r * D : nullptr, nullptr, V, F.lane, hv, nullptr,
                            st ? (GAS unsigned char*)(H + (size_t)(NX + r) * D) : nullptr, (GAS float*)(F.ws + WS_RS) + NX + r); }
        }
    }
}

constexpr int SC_CUM = 0, SC_TOT = 32768, SC_VT = 34816, SC_QM = 53248, SC_KM = 70656, SC_QD = 70656, SC_KDT = 88064, SC_AL = 114176, SC_ST = 123392, SC_DEC = 158208, SC_END = 158720;
constexpr int PQ = 272, PV = 144;
static_assert(SC_KDT + 128 * PV <= SC_AL && SC_QD + 64 * PQ <= SC_KDT && SC_KM + 160 * PQ <= SC_AL && SC_AL + 64 * PV <= SC_ST && SC_ST + 128 * PQ <= SC_DEC, "scan LDS map");
DI int scan_row(int b, int dir, int s) { return s < CTX ? NX + b * CTX + (dir ? CTX - 1 - s : s) : b * SEQ + (dir ? SEQ - 1 - (s - CTX) : (s - CTX)); }
DI float ex2(float x) { return __builtin_amdgcn_exp2f(x); }
DI void unpack8(const v4u w, float (&o)[8]) { o[0] = bflo(w.x); o[1] = bfhi(w.x); o[2] = bflo(w.y); o[3] = bfhi(w.y); o[4] = bflo(w.z); o[5] = bfhi(w.z); o[6] = bflo(w.w); o[7] = bfhi(w.w); }
DI v4u pack8(const float (&o)[8]) { v4u w; w.x = pk2(o[0], o[1]); w.y = pk2(o[2], o[3]); w.z = pk2(o[4], o[5]); w.w = pk2(o[6], o[7]); return w; }
DI void scan_phase(const Frame& F0, const Args& A, int l, bool dostore) {
    const Frame F = fresh(F0);
    (void)A;
    GAS bf16* P = (GAS bf16*)(F.ws + WS_P);
    LAS unsigned char* L = F.lds;
    const int tid = F.tid, lane = F.lane, w = F.wave, r = lane & 15, q4 = lane >> 4;
    const float L2E = 1.4426950408889634f;
    for (int ch = blockIdx.x; ch < 256; ch += F.G) {
        const int b = ch >> 3, h = (ch >> 1) & 3, dir = ch & 1;
        const int colq = C_Q + h * DK, colf = C_FF + dir * DH + h * DK, colv = C_V + h * DK;
        __syncthreads();
        for (int i = tid; i < (SC_DEC - SC_AL) / 16; i += NTHR) *(LAS v4u*)(L + SC_AL + 16 * i) = (v4u){0u, 0u, 0u, 0u};
        f32x4 accS[8];
#pragma unroll
        for (int t = 0; t < 8; ++t) accS[t] = (f32x4){0.f, 0.f, 0.f, 0.f};
        v4u qreg[2], lfreg[2]; unsigned vreg[8];
#pragma unroll
        for (int pi = 0; pi < 2; ++pi) { const int i = (tid >> 4) + 32 * pi, k0 = 8 * (tid & 15); const GAS bf16* rp = P + (size_t)scan_row(b, dir, i) * INC + k0;
            qreg[pi] = *(const GAS v4u*)(rp + colq); lfreg[pi] = *(const GAS v4u*)(rp + colf); }
#pragma unroll
        for (int e = 0; e < 8; ++e) vreg[e] = *(const GAS unsigned*)(P + (size_t)scan_row(b, dir, 8 * w + e) * INC + colv + 2 * lane);
        __syncthreads();
#pragma unroll 1
        for (int c = 0; c < (CTX + SEQ) / 64; ++c) {
            float qf[2][8], kk[2][8];
#pragma unroll
            for (int pi = 0; pi < 2; ++pi) { const int i = (tid >> 4) + 32 * pi, k0 = 8 * (tid & 15);
                float lf[8]; unpack8(lfreg[pi], lf); unpack8(qreg[pi], qf[pi]);
#pragma unroll
                for (int e = 0; e < 8; ++e) { lf[e] *= L2E; kk[pi][e] = 1.0f - ex2(lf[e]); }
                *(LAS f32x4*)(L + SC_CUM + (i * 128 + k0) * 4) = (f32x4){lf[0], lf[1], lf[2], lf[3]};
                *(LAS f32x4*)(L + SC_CUM + (i * 128 + k0) * 4 + 16) = (f32x4){lf[4], lf[5], lf[6], lf[7]}; }
            { v4u lo, hi;
              lo.x = (vreg[0] & 0xffffu) | (vreg[1] << 16); lo.y = (vreg[2] & 0xffffu) | (vreg[3] << 16); lo.z = (vreg[4] & 0xffffu) | (vreg[5] << 16); lo.w = (vreg[6] & 0xffffu) | (vreg[7] << 16);
              hi.x = (vreg[0] >> 16) | (vreg[1] & 0xffff0000u); hi.y = (vreg[2] >> 16) | (vreg[3] & 0xffff0000u); hi.z = (vreg[4] >> 16) | (vreg[5] & 0xffff0000u); hi.w = (vreg[6] >> 16) | (vreg[7] & 0xffff0000u);
              *(LAS v4u*)(L + SC_VT + (2 * lane) * PV + 16 * w) = lo; *(LAS v4u*)(L + SC_VT + (2 * lane + 1) * PV + 16 * w) = hi; }
            __syncthreads();
            { const int k = tid & 127, qd = tid >> 7; float run = 0.f;
#pragma unroll
              for (int s2 = 0; s2 < 16; ++s2) { LAS float* cp = (LAS float*)(L + SC_CUM) + (16 * qd + s2) * 128 + k; run += *cp; *cp = run; }
              ((LAS float*)(L + SC_TOT))[qd * 128 + k] = run; }
            __syncthreads();
            { const int k = tid & 127, I = tid >> 7; const LAS float* tp = (const LAS float*)(L + SC_TOT) + k; const LAS float* cm = (const LAS float*)(L + SC_CUM) + 7 * 128 + k;
              const float t0 = tp[0], t1 = tp[128], t2 = tp[256], t3 = tp[384];
              const float p1 = t0, p2 = t0 + t1, p3 = p2 + t2, tt = p3 + t3;
              const float R0 = cm[0], R1 = cm[16 * 128] + p1, R2 = cm[32 * 128] + p2, R3 = cm[48 * 128] + p3;
              const float RI = (I == 0) ? R0 : (I == 1) ? R1 : (I == 2) ? R2 : R3;
              LAS float* QF = (LAS float*)(L + SC_AL); LAS float* FT = QF + 512;
              QF[I * 128 + k] = ex2(RI);
              if (I == 0) { FT[0 * 128 + k] = ex2(R1 - R0); FT[1 * 128 + k] = ex2(R2 - R0); FT[3 * 128 + k] = ex2(R3 - R0); }
              if (I == 1) { FT[2 * 128 + k] = ex2(R2 - R1); FT[4 * 128 + k] = ex2(R3 - R1); }
              if (I == 2) { FT[5 * 128 + k] = ex2(R3 - R2); }
              if (I == 3) ((LAS float*)(L + SC_DEC))[k] = ex2(tt); }
            __syncthreads();
            v4u qdreg[2];
#pragma unroll
            for (int pi = 0; pi < 2; ++pi) { const int i = (tid >> 4) + 32 * pi, k0 = 8 * (tid & 15), I = i >> 4;
                float cl[8], cmid[8], qm[8], km[8], o8[8];
                { const f32x4 a = *(const LAS f32x4*)(L + SC_CUM + (i * 128 + k0) * 4), bq = *(const LAS f32x4*)(L + SC_CUM + (i * 128 + k0) * 4 + 16);
                  cl[0] = a.x; cl[1] = a.y; cl[2] = a.z; cl[3] = a.w; cl[4] = bq.x; cl[5] = bq.y; cl[6] = bq.z; cl[7] = bq.w; }
                { const f32x4 a = *(const LAS f32x4*)(L + SC_CUM + ((16 * I + 7) * 128 + k0) * 4), bq = *(const LAS f32x4*)(L + SC_CUM + ((16 * I + 7) * 128 + k0) * 4 + 16);
                  cmid[0] = a.x; cmid[1] = a.y; cmid[2] = a.z; cmid[3] = a.w; cmid[4] = bq.x; cmid[5] = bq.y; cmid[6] = bq.z; cmid[7] = bq.w; }
#pragma unroll
                for (int e = 0; e < 8; ++e) { const float dlt = cl[e] - cmid[e]; qm[e] = qf[pi][e] * ex2(fminf(dlt, 86.f)); km[e] = kk[pi][e] * ex2(fminf(-dlt, 86.f)); }
                *(LAS v4u*)(L + SC_QM + i * PQ + 2 * k0) = pack8(qm);
                *(LAS v4u*)(L + SC_KM + (8 * I * (I + 1) + i) * PQ + 2 * k0) = pack8(km);
                { const f32x4 a = *(const LAS f32x4*)(L + SC_AL + (I * 128 + k0) * 4), bq = *(const LAS f32x4*)(L + SC_AL + (I * 128 + k0) * 4 + 16);
                  o8[0] = qm[0] * a.x; o8[1] = qm[1] * a.y; o8[2] = qm[2] * a.z; o8[3] = qm[3] * a.w; o8[4] = qm[4] * bq.x; o8[5] = qm[5] * bq.y; o8[6] = qm[6] * bq.z; o8[7] = qm[7] * bq.w; }
                qdreg[pi] = pack8(o8);
#pragma unroll
                for (int Ip = 1; Ip < 4; ++Ip) if (Ip > I) { const int pr = Ip * (Ip - 1) / 2 + I;
                    const f32x4 a = *(const LAS f32x4*)(L + SC_AL + 2048 + (pr * 128 + k0) * 4), bq = *(const LAS f32x4*)(L + SC_AL + 2048 + (pr * 128 + k0) * 4 + 16);
                    o8[0] = km[0] * a.x; o8[1] = km[1] * a.y; o8[2] = km[2] * a.z; o8[3] = km[3] * a.w; o8[4] = km[4] * bq.x; o8[5] = km[5] * bq.y; o8[6] = km[6] * bq.z; o8[7] = km[7] * bq.w;
                    *(LAS v4u*)(L + SC_KM + (8 * Ip * (Ip + 1) + i) * PQ + 2 * k0) = pack8(o8); } }
            __syncthreads();
            if (c + 1 < (CTX + SEQ) / 64) {
#pragma unroll
                for (int pi = 0; pi < 2; ++pi) { const int i = (tid >> 4) + 32 * pi, k0 = 8 * (tid & 15); const GAS bf16* rp = P + (size_t)scan_row(b, dir, 64 * (c + 1) + i) * INC + k0;
                    qreg[pi] = *(const GAS v4u*)(rp + colq); lfreg[pi] = *(const GAS v4u*)(rp + colf); }
#pragma unroll
                for (int e = 0; e < 8; ++e) vreg[e] = *(const GAS unsigned*)(P + (size_t)scan_row(b, dir, 64 * (c + 1) + 8 * w + e) * INC + colv + 2 * lane);
            }
#pragma unroll 1
            for (int bl = w; bl < 10; bl += 8) {
                const int I = (bl >= 6) ? 3 : (bl >= 3) ? 2 : (bl >= 1) ? 1 : 0, J = bl - I * (I + 1) / 2;
                f32x4 acc = (f32x4){0.f, 0.f, 0.f, 0.f};
#pragma unroll
                for (int ks = 0; ks < 4; ++ks) { const bf16x8 a = *(const LAS bf16x8*)(L + SC_QM + (16 * I + r) * PQ + 64 * ks + 16 * q4);
                    const bf16x8 bb = *(const LAS bf16x8*)(L + SC_KM + (8 * I * (I + 1) + 16 * J + r) * PQ + 64 * ks + 16 * q4);
                    acc = __builtin_amdgcn_mfma_f32_16x16x32_bf16(a, bb, acc, 0, 0, 0); }
#pragma unroll
                for (int jj = 0; jj < 4; ++jj) { float x = acc[jj]; if (I == J && r > 4 * q4 + jj) x = 0.f;
                    *(LAS bf16*)(L + SC_AL + (16 * I + 4 * q4 + jj) * PV + 2 * (16 * J + r)) = (bf16)(pk2(x, 0.f) & 0xffffu); }
            }
            if (w == 2 || w == 3) { const int I = (w == 2) ? 0 : 2, J = I + 1;
#pragma unroll
                for (int jj = 0; jj < 4; ++jj) *(LAS bf16*)(L + SC_AL + (16 * I + 4 * q4 + jj) * PV + 2 * (16 * J + r)) = (bf16)0; }
            __syncthreads();
#pragma unroll
            for (int pi = 0; pi < 2; ++pi) { const int i = (tid >> 4) + 32 * pi, k0 = 8 * (tid & 15); *(LAS v4u*)(L + SC_QD + i * PQ + 2 * k0) = qdreg[pi]; }
            { const int k = tid & 127, qd = tid >> 7; const LAS float* tp = (const LAS float*)(L + SC_TOT) + k;
              const float t1 = tp[128], t2 = tp[256], t3 = tp[384];
              const float rest = (qd == 0) ? (t1 + t2) + t3 : (qd == 1) ? t2 + t3 : (qd == 2) ? t3 : 0.f;
              float cl[16], kd[16];
#pragma unroll
              for (int s2 = 0; s2 < 16; ++s2) cl[s2] = ((const LAS float*)(L + SC_CUM))[(16 * qd + s2) * 128 + k];
              float g = ex2(fminf(rest, 0.f));
#pragma unroll
              for (int s2 = 15; s2 >= 0; --s2) { const float f = ex2(cl[s2] - (s2 ? cl[s2 - 1] : 0.f)); kd[s2] = (1.0f - f) * g; g *= f; }
              v4u w0, w1; w0.x = pk2(kd[0], kd[1]); w0.y = pk2(kd[2], kd[3]); w0.z = pk2(kd[4], kd[5]); w0.w = pk2(kd[6], kd[7]);
              w1.x = pk2(kd[8], kd[9]); w1.y = pk2(kd[10], kd[11]); w1.z = pk2(kd[12], kd[13]); w1.w = pk2(kd[14], kd[15]);
              *(LAS v4u*)(L + SC_KDT + k * PV + 32 * qd) = w0; *(LAS v4u*)(L + SC_KDT + k * PV + 32 * qd + 16) = w1; }
            __syncthreads();
            { const int ip = w & 1, vp = w >> 1;
              f32x4 acc[2][2];
#pragma unroll
              for (int ii = 0; ii < 2; ++ii)
#pragma unroll
                  for (int tt = 0; tt < 2; ++tt) acc[ii][tt] = (f32x4){0.f, 0.f, 0.f, 0.f};
#pragma unroll
              for (int ks = 0; ks < 4; ++ks) { bf16x8 bq[2], a[2];
#pragma unroll
                  for (int ii = 0; ii < 2; ++ii) bq[ii] = *(const LAS bf16x8*)(L + SC_QD + (16 * (2 * ip + ii) + r) * PQ + 64 * ks + 16 * q4);
#pragma unroll
                  for (int tt = 0; tt < 2; ++tt) a[tt] = *(const LAS bf16x8*)(L + SC_ST + (16 * (2 * vp + tt) + r) * PQ + 64 * ks + 16 * q4);
#pragma unroll
                  for (int ii = 0; ii < 2; ++ii)
#pragma unroll
                      for (int tt = 0; tt < 2; ++tt) acc[ii][tt] = __builtin_amdgcn_mfma_f32_16x16x32_bf16(a[tt], bq[ii], acc[ii][tt], 0, 0, 0); }
#pragma unroll
              for (int js = 0; js < 2; ++js) if (js == 0 || ip == 1) { bf16x8 bA[2], a[2];
#pragma unroll
                  for (int ii = 0; ii < 2; ++ii) bA[ii] = *(const LAS bf16x8*)(L + SC_AL + (16 * (2 * ip + ii) + r) * PV + 64 * js + 16 * q4);
#pragma unroll
                  for (int tt = 0; tt < 2; ++tt) a[tt] = *(const LAS bf16x8*)(L + SC_VT + (16 * (2 * vp + tt) + r) * PV + 64 * js + 16 * q4);
#pragma unroll
                  for (int ii = 0; ii < 2; ++ii)
#pragma unroll
                      for (int tt = 0; tt < 2; ++tt) acc[ii][tt] = __builtin_amdgcn_mfma_f32_16x16x32_bf16(a[tt], bA[ii], acc[ii][tt], 0, 0, 0); }
              if (dostore && !(l == 1 && c < CTX / 64)) {
#pragma unroll
                  for (int ii = 0; ii < 2; ++ii) { GAS bf16* op = P + (size_t)scan_row(b, dir, 64 * c + 16 * (2 * ip + ii) + r) * INC + colf + 4 * q4;
#pragma unroll
                      for (int tt = 0; tt < 2; ++tt) { v2u o2; o2.x = pk2(acc[ii][tt][0], acc[ii][tt][1]); o2.y = pk2(acc[ii][tt][2], acc[ii][tt][3]); *(GAS v2u*)(op + 16 * (2 * vp + tt)) = o2; } }
              }
              const int kp = w >> 1, vh = w & 1;
#pragma unroll
              for (int kk = 0; kk < 2; ++kk) { const f32x4 dv = *(const LAS f32x4*)(L + SC_DEC + (16 * (2 * kp + kk) + 4 * q4) * 4);
#pragma unroll
                  for (int t4 = 0; t4 < 4; ++t4) accS[kk * 4 + t4] *= dv; }
#pragma unroll
              for (int js = 0; js < 2; ++js) { bf16x8 a[2], bv[4];
#pragma unroll
                  for (int kk = 0; kk < 2; ++kk) a[kk] = *(const LAS bf16x8*)(L + SC_KDT + (16 * (2 * kp + kk) + r) * PV + 64 * js + 16 * q4);
#pragma unroll
                  for (int t4 = 0; t4 < 4; ++t4) bv[t4] = *(const LAS bf16x8*)(L + SC_VT + (16 * (4 * vh + t4) + r) * PV + 64 * js + 16 * q4);
#pragma unroll
                  for (int kk = 0; kk < 2; ++kk)
#pragma unroll
                      for (int t4 = 0; t4 < 4; ++t4) accS[kk * 4 + t4] = __builtin_amdgcn_mfma_f32_16x16x32_bf16(a[kk], bv[t4], accS[kk * 4 + t4], 0, 0, 0); }
            }
            __syncthreads();
            { const int kp = w >> 1, vh = w & 1;
#pragma unroll
              for (int kk = 0; kk < 2; ++kk)
#pragma unroll
                  for (int t4 = 0; t4 < 4; ++t4) { const f32x4 sv = accS[kk * 4 + t4]; v2u s2; s2.x = pk2(sv[0], sv[1]); s2.y = pk2(sv[2], sv[3]);
                      *(LAS v2u*)(L + SC_ST + (16 * (4 * vh + t4) + r) * PQ + 2 * (16 * (2 * kp + kk) + 4 * q4)) = s2; } }
        }
    }
    __syncthreads();
}

DI void post_phase(const Frame& F0, const Args& A, int l, int part = 3, bool dry = false) {
    const Frame F = fresh(F0);
    GAS bf16* P = (GAS bf16*)(F.ws + WS_P);
    const int nrows = (l == 0) ? MALL : NX;
    if (part & 1) {
        const GAS float* gp = ((const GAS float*)A.in[I_GAIN]) + l * DH + 8 * F.lane;
        const f32x4 ga = *(const GAS f32x4*)gp, gb = *(const GAS f32x4*)(gp + 4);
        const float gn[8] = {ga.x, ga.y, ga.z, ga.w, gb.x, gb.y, gb.z, gb.w};
        v4u cur[6], nxt[6];
        if (F.gw < nrows) { const int r = F.gw; const bool two = (r + F.NGW) < nrows;
            const GAS bf16* q0 = P + (size_t)r * INC + 8 * F.lane; const GAS bf16* q1 = P + (size_t)(two ? r + F.NGW : r) * INC + 8 * F.lane;
            cur[0] = *(const GAS v4u*)(q0 + C_FF); cur[1] = *(const GAS v4u*)(q0 + C_FB); cur[2] = *(const GAS v4u*)(q0 + C_G);
            cur[3] = *(const GAS v4u*)(q1 + C_FF); cur[4] = *(const GAS v4u*)(q1 + C_FB); cur[5] = *(const GAS v4u*)(q1 + C_G); }
        for (int r = F.gw; r < nrows; r += 2 * F.NGW) {
            const bool two = (r + F.NGW) < nrows;
            GAS bf16* rp0 = P + (size_t)r * INC + 8 * F.lane; GAS bf16* rp1 = P + (size_t)(two ? r + F.NGW : r) * INC + 8 * F.lane;
            { const int rn = r + 2 * F.NGW;
              if (rn < nrows) { const bool twon = (rn + F.NGW) < nrows;
                  const GAS bf16* q0 = P + (size_t)rn * INC + 8 * F.lane; const GAS bf16* q1 = P + (size_t)(twon ? rn + F.NGW : rn) * INC + 8 * F.lane;
                  nxt[0] = *(const GAS v4u*)(q0 + C_FF); nxt[1] = *(const GAS v4u*)(q0 + C_FB); nxt[2] = *(const GAS v4u*)(q0 + C_G);
                  nxt[3] = *(const GAS v4u*)(q1 + C_FF); nxt[4] = *(const GAS v4u*)(q1 + C_FB); nxt[5] = *(const GAS v4u*)(q1 + C_G); } }
#pragma unroll
            for (int half = 0; half < 2; ++half) {
                if (half == 1 && !two) break;
                const v4u a = cur[3 * half], bq = cur[3 * half + 1], g = cur[3 * half + 2]; GAS bf16* rp = half ? rp1 : rp0;
                float o[8] = {bflo(a.x) + bflo(bq.x), bfhi(a.x) + bfhi(bq.x), bflo(a.y) + bflo(bq.y), bfhi(a.y) + bfhi(bq.y), bflo(a.z) + bflo(bq.z), bfhi(a.z) + bfhi(bq.z), bflo(a.w) + bflo(bq.w), bfhi(a.w) + bfhi(bq.w)};
                const float sg[8] = {bflo(g.x), bfhi(g.x), bflo(g.y), bfhi(g.y), bflo(g.z), bfhi(g.z), bflo(g.w), bfhi(g.w)};
                float ss = 0.f;
#pragma unroll
                for (int j = 0; j < 8; ++j) ss += o[j] * o[j];
                ss += __shfl_xor(ss, 1); ss += __shfl_xor(ss, 2); ss += __shfl_xor(ss, 4); ss += __shfl_xor(ss, 8);
                const float rr = 1.0f / sqrtf(ss * (1.0f / DK) + EPS);
#pragma unroll
                for (int j = 0; j < 8; ++j) o[j] = o[j] * rr * gn[j] * sg[j];
                v4u w; w.x = pk2(o[0], o[1]); w.y = pk2(o[2], o[3]); w.z = pk2(o[4], o[5]); w.w = pk2(o[6], o[7]);
                if (!dry || F.never) *(GAS v4u*)(rp + C_FF) = w;
            }
#pragma unroll
            for (int i = 0; i < 6; ++i) cur[i] = nxt[i];
        }
    }
    if (!(part & 2)) return;
    constexpr int PP = 520;
    LAS unsigned* U = (LAS unsigned*)F.lds;
    LAS unsigned* Vs = U + 32 * PP;
    v4u pre[8];
    { const int un = blockIdx.x;
      if (un < BATCH * 32) {
#pragma unroll
          for (int i = 0; i < 4; ++i) { const int t = F.tid + 512 * i; const GAS bf16* gp = P + (size_t)((un >> 5) * SEQ + t) * INC + C_U + (un & 31) * 16;
              pre[2 * i] = *(const GAS v4u*)gp; pre[2 * i + 1] = *(const GAS v4u*)(gp + 8); } } }
    REP(4) for (int un = blockIdx.x; un < BATCH * 32; un += F.G) {
        const int b = un >> 5, hx = un & 31, w = 2 << (hx >> 3), hw = w >> 1;
        __syncthreads();
#pragma unroll
        for (int i = 0; i < 4; ++i) { const int t = F.tid + 512 * i, gy = t >> 6, gx = t & 63;
            *(LAS v4u*)(U + gy * PP + gx * 8) = pre[2 * i]; *(LAS v4u*)(U + gy * PP + gx * 8 + 4) = pre[2 * i + 1]; }
        __syncthreads();
        { const int un2 = un + F.G;
          if (un2 < BATCH * 32) {
#pragma unroll
              for (int i = 0; i < 4; ++i) { const int t = F.tid + 512 * i; const GAS bf16* gp = P + (size_t)((un2 >> 5) * SEQ + t) * INC + C_U + (un2 & 31) * 16;
                  pre[2 * i] = *(const GAS v4u*)gp; pre[2 * i + 1] = *(const GAS v4u*)(gp + 8); } } }
        { float s0 = 0.f, s1 = 0.f;
          for (int y = 0; y < hw; ++y) { const unsigned u = U[y * PP + F.tid]; s0 += bflo(u); s1 += bfhi(u); }
#pragma unroll 4
          for (int gy = 0; gy < 32; ++gy) {
              Vs[gy * PP + F.tid] = pk2(s0, s1);
              if (gy + hw < 32) { const unsigned u = U[(gy + hw) * PP + F.tid]; s0 += bflo(u); s1 += bfhi(u); }
              if (gy - hw >= 0) { const unsigned u = U[(gy - hw) * PP + F.tid]; s0 -= bflo(u); s1 -= bfhi(u); }
          } }
        __syncthreads();
        { const int c4 = F.lane & 3, gy = (F.wave & 1) * 16 + (F.lane >> 2), x0 = (F.wave >> 1) * 16;
          const int cy = min(gy + hw, 32) - max(gy - hw, 0);
          const LAS unsigned* vr = Vs + gy * PP + c4 * 2; LAS unsigned* ur = U + gy * PP + c4 * 2;
          float s[4] = {0.f, 0.f, 0.f, 0.f};
          for (int x = max(x0 - hw, 0); x < min(x0 + hw, 64); ++x) { const v2u q = *(const LAS v2u*)(vr + x * 8); s[0] += bflo(q.x); s[1] += bfhi(q.x); s[2] += bflo(q.y); s[3] += bfhi(q.y); }
#pragma unroll 4
          for (int gx = x0; gx < x0 + 16; ++gx) {
              const int cx = min(gx + hw, 64) - max(gx - hw, 0);
              const float inv = __builtin_amdgcn_rcpf((float)(cy * cx));
              const v2u uc = *(const LAS v2u*)(ur + gx * 8);
              v2u o; o.x = pk2(s[0] * inv - bflo(uc.x), s[1] * inv - bfhi(uc.x)); o.y = pk2(s[2] * inv - bflo(uc.y), s[3] * inv - bfhi(uc.y));
              *(LAS v2u*)(ur + gx * 8) = o;
              if (gx + hw < 64) { const v2u q = *(const LAS v2u*)(vr + (gx + hw) * 8); s[0] += bflo(q.x); s[1] += bfhi(q.x); s[2] += bflo(q.y); s[3] += bfhi(q.y); }
              if (gx - hw >= 0) { const v2u q = *(const LAS v2u*)(vr + (gx - hw) * 8); s[0] -= bflo(q.x); s[1] -= bfhi(q.x); s[2] -= bflo(q.y); s[3] -= bfhi(q.y); }
          } }
        __syncthreads();
#pragma unroll
        for (int i = 0; i < 4; ++i) { const int t = F.tid + 512 * i, gy = t >> 6, gx = t & 63;
            const v4u q0 = *(const LAS v4u*)(U + gy * PP + gx * 8), q1 = *(const LAS v4u*)(U + gy * PP + gx * 8 + 4);
            GAS bf16* op = P + (size_t)(b * SEQ + t) * INC + C_Q + hx * 16;
            *(GAS v4u*)op = q0; *(GAS v4u*)(op + 8) = q1; }
    }
    __syncthreads();
    if (l == 0) { LAS unsigned char* Uc = F.lds;
        for (int un = blockIdx.x; un < BATCH * 32; un += F.G) {
            const int b = un >> 5, hx = un & 31, w = 2 << (hx >> 3), hw = w >> 1;
            __syncthreads();
            if (F.tid < CTX) { const GAS bf16* gp = P + (size_t)(NX + b * CTX + F.tid) * INC + C_U + hx * 16;
                const v4u q0 = *(const GAS v4u*)gp, q1 = *(const GAS v4u*)(gp + 8);
                *(LAS v4u*)(Uc + F.tid * 32) = q0; *(LAS v4u*)(Uc + F.tid * 32 + 16) = q1; }
            __syncthreads();
            if (F.tid < CTX) { const int t = F.tid, t0 = max(t - hw, 0), t1 = min(t - hw + w, CTX);
                float a[16];
#pragma unroll
                for (int j = 0; j < 16; ++j) a[j] = 0.f;
                for (int s2 = t0; s2 < t1; ++s2) { float v0[8], v1[8]; unpack8(*(const LAS v4u*)(Uc + s2 * 32), v0); unpack8(*(const LAS v4u*)(Uc + s2 * 32 + 16), v1);
#pragma unroll
                    for (int j = 0; j < 8; ++j) { a[j] += v0[j]; a[8 + j] += v1[j]; } }
                const float inv = 1.0f / (float)(t1 - t0);
                float u0[8], u1[8]; unpack8(*(const LAS v4u*)(Uc + t * 32), u0); unpack8(*(const LAS v4u*)(Uc + t * 32 + 16), u1);
                float lo[8], hi[8];
#pragma unroll
                for (int j = 0; j < 8; ++j) { lo[j] = a[j] * inv - u0[j]; hi[j] = a[8 + j] * inv - u1[j]; }
                GAS bf16* op = P + (size_t)(NX + b * CTX + t) * INC + C_Q + hx * 16;
                *(GAS v4u*)op = pack8(lo); *(GAS v4u*)(op + 8) = pack8(hi); }
        }
    }
    __syncthreads();
}

DI void slice_offsets(const Frame& F, int s, int (&toff)[9]) {
    const GAS unsigned* gc = (const GAS unsigned*)(F.ws + WS_CTL) + CW_GCOUNT;
    int acc = 0;
#pragma unroll
    for (int e = 0; e < 8; ++e) { toff[e] = acc; const unsigned c = __builtin_amdgcn_readfirstlane(__hip_atomic_load(gc + 64 * (s * 8 + e), __ATOMIC_RELAXED, __HIP_MEMORY_SCOPE_AGENT)); acc += (int)((c + 255u) >> 8); }
    toff[8] = acc < SLICE_ROWS / 256 ? acc : SLICE_ROWS / 256;
}
DI void gather_phase(const Frame& F0, const Args& A, int s) {
    const Frame F = fresh(F0);
    (void)A;
    int toff[9]; slice_offsets(F, s, toff);
    const GAS unsigned char* H8 = F.ws + WS_H8; GAS unsigned char* AS = F.ws + WS_AS; GAS float* RG = (GAS float*)(F.ws + WS_RGATE);
    const int rend = slice_start(s + 1);
    int r = slice_start(s) + F.gw;
    i32x2 t = {0, 0}, k = {0, 0}; v4u a = {0u, 0u, 0u, 0u};
    if (r < rend) { t = ((const GAS i32x2*)(F.ws + WS_RTOP))[r]; k = ((const GAS i32x2*)(F.ws + WS_RRANK))[r]; a = *(const GAS v4u*)(H8 + (size_t)r * D + 16 * F.lane); }
    for (; r < rend; r += F.NGW) {
        const int rn = r + F.NGW;
        i32x2 tn = t, kn = k; v4u an = a;
        if (rn < rend) { tn = ((const GAS i32x2*)(F.ws + WS_RTOP))[rn]; kn = ((const GAS i32x2*)(F.ws + WS_RRANK))[rn]; an = *(const GAS v4u*)(H8 + (size_t)rn * D + 16 * F.lane); }
        int p0 = k.x, p1 = k.y;
#pragma unroll
        for (int e = 0; e < 8; ++e) { if (t.x == e) p0 += toff[e] * 256; if (t.y == e) p1 += toff[e] * 256; }
        p0 = min(max(p0, 0), SLICE_ROWS - 1); p1 = min(max(p1, 0), SLICE_ROWS - 1);
        *(GAS v4u*)(AS + (size_t)p0 * D + 16 * F.lane) = a;
        *(GAS v4u*)(AS + (size_t)p1 * D + 16 * F.lane) = a;
        if (F.lane == 0) ((GAS i32x2*)(F.ws + WS_RPOS))[r] = (i32x2){p0, p1};
        t = tn; k = kn; a = an;
    }
    (void)RG;
}
DI void combine_phase(const Frame& F0, const Args& A, int s, bool dry = false) {
    const Frame F = fresh(F0);
    const GAS bf16* YS = (const GAS bf16*)(F.ws + WS_YS);
    RowVecs V; f32x4 hv[4];
    constexpr int CB = 4;
    for (int r0 = slice_start(s) + F.gw * CB; r0 < slice_start(s + 1); r0 += F.NGW * CB) {
        const int b = r0 >> 11;
        load_rowvecs(V, modp(F, 1, b, 5), ((const GAS float*)A.in[I_FFNPOST]) + D, nullptr, nullptr, nullptr, F.lane);
        i32x2 pp[CB]; f32x2 pr[CB];
#pragma unroll
        for (int k = 0; k < CB; ++k) { pp[k] = ((const GAS i32x2*)(F.ws + WS_RPOS))[r0 + k]; pr[k] = ((const GAS f32x2*)(F.ws + WS_RPROB))[r0 + k]; }
        v2u wa[4], wb[4], wx[4], na[4], nb[4], nx[4];
#pragma unroll
        for (int j = 0; j < 4; ++j) { wa[j] = *(const GAS v2u*)(YS + (size_t)pp[0].x * D + 4 * F.lane + 256 * j); wb[j] = *(const GAS v2u*)(YS + (size_t)pp[0].y * D + 4 * F.lane + 256 * j); wx[j] = *(const GAS v2u*)(xb_row(F.out, r0) + 4 * F.lane + 256 * j); }
#pragma unroll
        for (int k = 0; k < CB; ++k) { const int r = r0 + k;
            if (k < CB - 1) {
#pragma unroll
                for (int j = 0; j < 4; ++j) { na[j] = *(const GAS v2u*)(YS + (size_t)pp[k + 1 < CB ? k + 1 : CB - 1].x * D + 4 * F.lane + 256 * j); nb[j] = *(const GAS v2u*)(YS + (size_t)pp[k + 1 < CB ? k + 1 : CB - 1].y * D + 4 * F.lane + 256 * j); nx[j] = *(const GAS v2u*)(xb_row(F.out, r + 1) + 4 * F.lane + 256 * j); }
            }
            VM_WAIT();
            GAS float* xr = F.out + (size_t)r * D;
            f32x4 yv[4]; float ss = 0.f;
#pragma unroll
            for (int j = 0; j < 4; ++j) { const v2u w0 = wa[j], w1 = wb[j];
                yv[j] = (f32x4){bflo(w0.x) * pr[k].x + bflo(w1.x) * pr[k].y, bfhi(w0.x) * pr[k].x + bfhi(w1.x) * pr[k].y, bflo(w0.y) * pr[k].x + bflo(w1.y) * pr[k].y, bfhi(w0.y) * pr[k].x + bfhi(w1.y) * pr[k].y};
                ss += (yv[j].x * yv[j].x + yv[j].y * yv[j].y) + (yv[j].z * yv[j].z + yv[j].w * yv[j].w); }
            const float rr = 1.0f / sqrtf(wave_sum(ss) * (1.0f / D) + EPS);
#pragma unroll
            for (int j = 0; j < 4; ++j) { const v2u w = wx[j]; const f32x4 xv = (f32x4){bflo(w.x), bfhi(w.x), bflo(w.y), bfhi(w.y)};
                const f32x4 x = xv + V.a1[j] * (yv[j] * rr); if (!dry || F.never) *(GAS f32x4*)(xr + 4 * F.lane + 256 * j) = x; }
#pragma unroll
            for (int j = 0; j < 4; ++j) { wa[j] = na[j]; wb[j] = nb[j]; wx[j] = nx[j]; }
        }
    }
    (void)hv;
}

__global__ void __launch_bounds__(NTHR, 2) mk_fwd(Args args) {
    extern __shared__ __attribute__((aligned(16))) unsigned char lds_raw[];
    Frame F;
    F.lds = (LAS unsigned char*)lds_raw;
    F.tid = threadIdx.x; F.lane = F.tid & 63; F.wave = __builtin_amdgcn_readfirstlane(F.tid >> 6);
    F.G = gridDim.x; F.gw = blockIdx.x * NWAVES + F.wave; F.NGW = F.G * NWAVES; F.never = args.ph_lo < 0;
    F.out = (GAS float*)args.out; F.ws = (GAS unsigned char*)args.ws;
    volatile LAS unsigned* MISC = (volatile LAS unsigned*)(F.lds + MISC_OFF);
    if (F.tid < 16) MISC[F.tid] = 0u;
    __syncthreads();
    XcdBarrier bar; bar.bar = (unsigned*)(F.ws + WS_CTL) + CW_BAR; bar.x = 0; bar.st = nullptr;
    if (!MK_PER_PHASE) bar = xcd_barrier_post((unsigned*)(F.ws + WS_CTL) + CW_BAR, MISC + 8);
    const int lo = args.ph_lo, hi = args.ph_hi;
    int seq = 0;
#ifndef PHASE_MASK
#define PHASE_MASK 0xffff
#endif
#define EN(k) (((PHASE_MASK) >> (k)) & 1)
#define PH_ON() (lo <= seq && seq < hi)
#define PH_END() do { if (lo <= seq && seq + 1 < hi) { if (!MK_PER_PHASE) { xcd_barrier(bar); if (((DUP_MASK) >> 16) & 1) xcd_barrier(bar); } } ++seq; } while (0)
    LAS unsigned char* ring = F.lds;
#define SITE_PTRS() GAS unsigned char* ws = F.ws; asm volatile("" : "+s"(ws)); GAS bf16* P = (GAS bf16*)(ws + WS_P); GAS bf16* H = (GAS bf16*)(ws + WS_H); (void)P; (void)H

    if (PH_ON() && EN(0)) REP(0) p0_prologue(F, args);
    PH_END();
    if (PH_ON() && EN(1)) { REP(1) rows_phase<0>(F, args, 0); __syncthreads(); win_to_i8(F, args); }
    PH_END();
    for (int l = 0; l < 2; ++l) {
        const int nM = (l == 0) ? MALL / 256 : NX / 256;
        if (PH_ON() && EN(2)) { SITE_PTRS();
            pg8::Gemm g{H, (const GAS bf16*)(ws + WS_WIN + (size_t)l * INC * D), D, D / 2, D / 2};
            pg8::InSched S; S.G = F.G; S.c = (int)blockIdx.x; S.last = (l == 1);
            LAS float* cml = (LAS float*)(F.lds + 131072);
            { int t2 = F.tid; asm volatile("" : "+v"(t2)); const GAS float* cg = (const GAS float*)(ws + WS_CTL) + CW_CMAX_IN + l * INC; for (int i = t2; i < INC; i += NTHR) cml[i] = cg[i]; }
            __syncthreads();
            if (l == 0) { pg8::EpiIn<true> E{P, (const GAS float*)(ws + WS_LB), (const GAS float*)(ws + WS_RS), cml};
                REP(2) pg8::gemm_phase<pg8::EpiIn<true>, pg8::InSched, false, 127, true>(ring, g, S, E); }
            else { pg8::EpiIn<false> E{P, (const GAS float*)(ws + WS_LB) + 2 * DH, (const GAS float*)(ws + WS_RS), cml};
                REP(2) pg8::gemm_phase<pg8::EpiIn<false>, pg8::InSched, false, 127, true>(ring, g, S, E); }
            if (l == 0) moe_weight_convert(F, args, MOE_C1, MOE_C1 + MOE_C2, F.G / 2);
        }
        PH_END();
        if (PH_ON() && EN(3)) { if ((DUP_MASK >> 3) & 1) scan_phase(F, args, l, false); scan_phase(F, args, l, true); }
        PH_END();
        if (PH_ON() && EN(4)) { if ((DUP_MASK >> 17) & 1) post_phase(F, args, l, 1, true); post_phase(F, args, l); }
        PH_END();
        if (PH_ON() && EN(6)) { SITE_PTRS();
            { pg8::Gemm g{P + C_FF, (const GAS bf16*)(ws + WS_WR) + (size_t)l * D * DH, INC, DH, DH};
              pg8::StaticSched S; S.init(nM, D / 256, F.G, (int)blockIdx.x, 0);
              pg8::EpiRow<1> E{P + C_GA, INC, nullptr, 0};
              REP(6) pg8::gemm_phase(ring, g, S, E); }
            { pg8::Gemm g{P + C_Q, (const GAS bf16*)(ws + WS_WP) + (size_t)l * D * DH, INC, DH, DH};
              pg8::StaticSched S; S.init(nM, D / 256, F.G, (int)blockIdx.x, 0);
              pg8::EpiRow<2> E{P + C_GA, INC, nullptr, C_GB - C_GA};
              REP(6) pg8::gemm_phase(ring, g, S, E); }
        }
        PH_END();
        if (PH_ON() && EN(7)) { SITE_PTRS();
            pg8::Gemm g{P + C_GA, (const GAS bf16*)(ws + WS_WO) + (size_t)l * D * D, INC, D, D};
            pg8::StaticSched S; S.init(nM, D / 256, F.G, (int)blockIdx.x, 0);
            pg8::EpiRow<0> E{H, D, nullptr, 0};
            REP(7) pg8::gemm_phase(ring, g, S, E);
        }
        PH_END();
        if (PH_ON() && EN(8)) { if ((DUP_MASK >> 8) & 1) rows_phase<1>(F, args, l, true); rows_phase<1>(F, args, l); if (l == 1) { __syncthreads(); moe_weight_convert(F, args, MOE_C1 + MOE_C2, MOE_CONV_ITEMS, 0); } }
        PH_END();
        if (l == 0) {
            if (PH_ON() && EN(9)) { SITE_PTRS();
                pg8::Gemm g{H, (const GAS bf16*)(ws + WS_WGU), D, D / 2, D / 2};
                pg8::StaticSched S; S.init(MALL / 256, 2 * DFF / 256, F.G, (int)blockIdx.x, 0);
                LAS float* cmgl = (LAS float*)(F.lds + 131072); LAS float* cmul = cmgl + DFF;
                { int t2 = F.tid; asm volatile("" : "+v"(t2)); const GAS float* cg = (const GAS float*)(ws + WS_CTL) + CW_CMAX_FG; const GAS float* cu = (const GAS float*)(ws + WS_CTL) + CW_CMAX_FU;
                  for (int i = t2; i < DFF; i += NTHR) { cmgl[i] = cg[i]; cmul[i] = cu[i]; } }
                __syncthreads();
                pg8::EpiSwiGLU<true> E{(GAS bf16*)(ws + WS_HH0), DFF, nullptr, (const GAS float*)(ws + WS_RS), cmgl, cmul};
                REP(9) pg8::gemm_phase<pg8::EpiSwiGLU<true>, pg8::StaticSched, false, 127, true>(ring, g, S, E);
            }
            PH_END();
            if (PH_ON() && EN(10)) { SITE_PTRS();
                pg8::Gemm g{(const GAS bf16*)(ws + WS_HH0), (const GAS bf16*)(ws + WS_WD), DFF / 2, DFF / 2, DFF / 2};
                pg8::StaticSched S; S.init(MALL / 256, D / 256, F.G, (int)blockIdx.x, 0);
                pg8::EpiRow<0> E{H, D, nullptr, 0};
                REP(10) pg8::gemm_phase<pg8::EpiRow<0>, pg8::StaticSched, true, 121>(ring, g, S, E);
                moe_weight_convert(F, args, 0, MOE_C1, F.G / 2);
            }
            PH_END();
            if (PH_ON() && EN(11)) { if ((DUP_MASK >> 11) & 1) rows_phase<2>(F, args, 0, true); rows_phase<2>(F, args, 0); }
            PH_END();
        } else {
            if (PH_ON() && EN(12)) gather_phase(F, args, 0);
            PH_END();
            for (int s = 0; s < NSLICE; ++s) {
                if (PH_ON() && EN(13)) { SITE_PTRS();
                    pg8::MoeSched S; S.G = F.G; S.c = (int)blockIdx.x; S.nN = 2 * DEX / 256; S.nrow_e = 2 * DEX; slice_offsets(F, s, S.toff); S.nM = S.toff[8];
                    pg8::Gemm g{(const GAS bf16*)(ws + WS_AS), (const GAS bf16*)(ws + WS_MGU), D / 2, D / 2, D / 2};
                    pg8::EpiSwiGLU8 E{ws + WS_HHS, DEX, nullptr};
                    REP(13) pg8::gemm_phase<pg8::EpiSwiGLU8, pg8::MoeSched, true, 122>(ring, g, S, E);
                    if (s > 0) { if ((DUP_MASK >> 15) & 1) combine_phase(F, args, s - 1, true); combine_phase(F, args, s - 1); }
                }
                PH_END();
                if (PH_ON() && EN(14)) { SITE_PTRS();
                    pg8::MoeSched S; S.G = F.G; S.c = (int)blockIdx.x; S.nN = D / 256; S.nrow_e = D; slice_offsets(F, s, S.toff); S.nM = S.toff[8];
                    pg8::Gemm g{(const GAS bf16*)(ws + WS_HHS), (const GAS bf16*)(ws + WS_MD), DEX / 2, DEX / 2, DEX / 2};
                    pg8::EpiRow<0> E{(GAS bf16*)(ws + WS_YS), D, nullptr, 0};
                    REP(14) pg8::gemm_phase<pg8::EpiRow<0>, pg8::MoeSched, true, 121>(ring, g, S, E);
                    if (s + 1 < NSLICE) gather_phase(F, args, s + 1);
                }
                PH_END();
            }
            if (PH_ON() && EN(15)) { if ((DUP_MASK >> 15) & 1) combine_phase(F, args, NSLICE - 1, true); combine_phase(F, args, NSLICE - 1); }
            PH_END();
        }
    }
}
constexpr int N_PHASES = 2 + 6 + 3 + 6 + 1 + 2 * NSLICE + 1;

extern "C" void kernel_launch(void* const* d_in, const int* in_sizes, int n_in, void* d_out, int out_size, void* d_ws, size_t ws_size, hipStream_t stream) {
    static int grid = 0;
    if (grid == 0) {
        if (n_in != 25 || out_size != NX * D || ws_size < WS_END) { fprintf(stderr, "kernel_launch: unexpected problem (n_in %d, out %d, ws %zu < %zu)\n", n_in, out_size, ws_size, (size_t)WS_END); grid = -1; return; }
        int dev = 0, cus = 0, per_cu = 0;
        if (hipGetDevice(&dev) != hipSuccess || hipDeviceGetAttribute(&cus, hipDeviceAttributeMultiprocessorCount, dev) != hipSuccess) { grid = -1; return; }
        if (hipFuncSetAttribute((const void*)mk_fwd, hipFuncAttributeMaxDynamicSharedMemorySize, LDS_BYTES) != hipSuccess) { fprintf(stderr, "kernel_launch: hipFuncSetAttribute failed\n"); grid = -1; return; }
        if (hipOccupancyMaxActiveBlocksPerMultiprocessor(&per_cu, (const void*)mk_fwd, NTHR, LDS_BYTES) != hipSuccess || per_cu < 1) { fprintf(stderr, "kernel_launch: occupancy query says %d\n", per_cu); }
        (void)hipGetLastError();
        grid = cus;
    }
    if (grid < 0) return;
    (void)in_sizes;
    if (hipMemsetAsync((char*)d_ws + WS_CTL, 0, CTL_BYTES, stream) != hipSuccess) return;
    Args a{};
    for (int i = 0; i < 25; ++i) a.in[i] = (const float*)d_in[i];
    a.out = (float*)d_out; a.ws = (unsigned char*)d_ws;
#if MK_PER_PHASE
    for (int p = 0; p < N_PHASES; ++p) { a.ph_lo = p; a.ph_hi = p + 1; hipLaunchKernelGGL(mk_fwd, dim3(grid), dim3(NTHR), LDS_BYTES, stream, a); }
#else
    a.ph_lo = 0; a.ph_hi = N_PHASES;
    hipLaunchKernelGGL(mk_fwd, dim3(grid), dim3(NTHR), LDS_BYTES, stream, a);
#endif
}
```

```cpp
#include <hip/hip_runtime.h>
#include <cstdio>
#include <cstdint>

#ifndef MK_PER_PHASE
#define MK_PER_PHASE 0
#endif

#ifndef DUP_MASK
#define DUP_MASK 0
#endif
#define REP(k) for (int rep_ = 0; rep_ < 1 + (((DUP_MASK) >> (k)) & 1); ++rep_)
#define GAS __attribute__((address_space(1)))
#define LAS __attribute__((address_space(3)))
#define DI __device__ __forceinline__
typedef unsigned short bf16;
typedef unsigned v4u __attribute__((ext_vector_type(4)));
typedef unsigned v2u __attribute__((ext_vector_type(2)));
typedef float f32x4 __attribute__((ext_vector_type(4)));
typedef float f32x2 __attribute__((ext_vector_type(2)));
typedef float f32x16 __attribute__((ext_vector_type(16)));
typedef short bf16x8 __attribute__((ext_vector_type(8)));
typedef int i32x2 __attribute__((ext_vector_type(2)));

constexpr int D = 1024, BATCH = 32, SEQ = 2048, CTX = 256, GW = 64;
constexpr int NX = BATCH * SEQ, NC = BATCH * CTX, MALL = NX + NC;
constexpr int DH = 512, DK = 128, INC = 5120, DFF = 2816, NE = 8, DEX = 3584;
constexpr int C_Q = 0, C_FF = 512, C_FB = 1024, C_V = 1536, C_G = 2048, C_U = 2560, C_GA = 3072, C_GB = 4096;
constexpr float EPS = 1e-6f;
constexpr int NSLICE = 3, SL1 = 21848, SL2 = 43696, NGRP = NSLICE * NE;
constexpr int SLICE_ROWS = 45824;
DI int slice_of(int r) { return (r >= SL1 ? 1 : 0) + (r >= SL2 ? 1 : 0); }
DI int slice_start(int s) { return s == 0 ? 0 : s == 1 ? SL1 : s == 2 ? SL2 : NX; }
constexpr int NWAVES = 8, NTHR = 512;

constexpr size_t MiB = 1u << 20;
constexpr size_t al256(size_t x) { return (x + 255) & ~(size_t)255; }
constexpr size_t WS_CTL = 0, CTL_BYTES = 1 * MiB;
constexpr size_t WS_MOD = WS_CTL + CTL_BYTES;
constexpr size_t WS_LB = WS_MOD + al256((size_t)2 * 33 * 6144 * 4);
constexpr size_t WS_WIN = WS_LB + al256(2 * 2 * 512 * 4);
constexpr size_t WS_WR = WS_WIN + (size_t)2 * INC * D * 2;
constexpr size_t WS_WP = WS_WR + (size_t)2 * D * DH * 2;
constexpr size_t WS_WO = WS_WP + (size_t)2 * D * DH * 2;
constexpr size_t WS_WGU = WS_WO + (size_t)2 * D * D * 2;
constexpr size_t WS_WD = WS_WGU + (size_t)2 * DFF * D * 2;
constexpr size_t WS_H = WS_WD + (size_t)D * DFF * 2;
constexpr size_t WS_CX = WS_H + (size_t)MALL * D * 2;
constexpr size_t WS_RTOP = WS_CX + (size_t)NC * D * 2;
constexpr size_t WS_RPROB = WS_RTOP + (size_t)NX * 8;
constexpr size_t WS_RRANK = WS_RPROB + (size_t)NX * 8;
constexpr size_t WS_RPOS = WS_RRANK + (size_t)NX * 8;
constexpr size_t WS_RGATE = WS_RPOS + (size_t)NX * 8;
constexpr size_t WS_P = WS_RGATE + al256((size_t)SLICE_ROWS * 4);
constexpr size_t P_BYTES = (size_t)MALL * INC * 2;
constexpr size_t WS_MGU = WS_P + P_BYTES;
constexpr size_t WS_MD = WS_MGU + (size_t)NE * 2 * DEX * D;
constexpr size_t WS_END = WS_MD + (size_t)NE * D * DEX;
constexpr size_t WS_HH0 = WS_P;
constexpr size_t WS_H8 = WS_P;
constexpr size_t WS_AS = WS_H8 + (size_t)NX * D;
constexpr size_t WS_YS = WS_AS + (size_t)SLICE_ROWS * D;
constexpr size_t WS_HHS = WS_YS + (size_t)SLICE_ROWS * D * 2;
static_assert(WS_HHS + (size_t)SLICE_ROWS * DEX <= WS_P + P_BYTES, "moe overlay");
static_assert((size_t)MALL * DFF * 2 <= P_BYTES, "ffn overlay");
constexpr int CW_BAR = 0;
constexpr int CW_GCOUNT = 4096;
constexpr int CW_CMAX_FG = 18432, CW_CMAX_FU = 21248;
constexpr int CW_CMAX_IN = 8192;
constexpr size_t WS_RS = WS_CTL + 524288;
constexpr int LDS_BYTES = 159744, MISC_OFF = 158720;

typedef __bf16 bf16x2_t __attribute__((ext_vector_type(2)));
DI unsigned pk2(float lo, float hi) { bf16x2_t v = {(__bf16)lo, (__bf16)hi}; return __builtin_bit_cast(unsigned, v); }
DI float bflo(unsigned w) { return __uint_as_float(w << 16); }
DI float bfhi(unsigned w) { return __uint_as_float(w & 0xffff0000u); }
DI float wave_sum(float v) {
#pragma unroll
    for (int o = 1; o < 64; o <<= 1) v += __shfl_xor(v, o);
    return v;
}
DI float sat8(float x) { return __builtin_amdgcn_fmed3f(x, -448.f, 448.f); }
DI unsigned pk4_fp8(float a, float b, float c, float d) { int p = __builtin_amdgcn_cvt_pk_fp8_f32(sat8(a), sat8(b), 0, false); p = __builtin_amdgcn_cvt_pk_fp8_f32(sat8(c), sat8(d), p, true); return (unsigned)p; }
DI float wave_max(float v) {
#pragma unroll
    for (int o = 1; o < 64; o <<= 1) v = fmaxf(v, __shfl_xor(v, o));
    return v;
}
DI unsigned pk4_i8(float a, float b, float c, float d) {
    const int qa = (int)rintf(a), qb = (int)rintf(b), qc = (int)rintf(c), qd = (int)rintf(d);
    return (unsigned)(qa & 0xff) | ((unsigned)(qb & 0xff) << 8) | ((unsigned)(qc & 0xff) << 16) | ((unsigned)qd << 24);
}
DI float sigmoidf_(float a) { return __builtin_amdgcn_rcpf(1.0f + __builtin_amdgcn_exp2f(a * -1.4426950408889634f)); }
DI float siluf_(float a) { return a * sigmoidf_(a); }
#define LDS_WAIT() asm volatile("s_waitcnt lgkmcnt(0)" ::: "memory")
#define VM_WAIT() asm volatile("s_waitcnt vmcnt(0)" ::: "memory")

#define XB_TMO      128
#define XB_XCNT(j)  (256  + 64 * (j))
#define XB_XSUB(j)  (1280 + 64 * (j))
#define XB_XGEN(j)  (2304 + 64 * (j))
#define XB_TOP      3328
#define XB_TOPGEN   3392
#define XCD_BAR_WORDS 3456
#define XB_SPIN_CAP (1u << 20)

__device__ __forceinline__ unsigned xb_ld(unsigned* p)              { return __hip_atomic_load(p, __ATOMIC_RELAXED, __HIP_MEMORY_SCOPE_AGENT); }
__device__ __forceinline__ unsigned xb_add(unsigned* p, unsigned v) { return __hip_atomic_fetch_add(p, v, __ATOMIC_RELAXED, __HIP_MEMORY_SCOPE_AGENT); }
__device__ __forceinline__ unsigned xb_xcc_id() { return (unsigned)__builtin_amdgcn_s_getreg((3 << 11) | 20) & 0xFu; }
#define XB_SPIN(cond, bar) do { unsigned _sp = 0; while (cond) { __builtin_amdgcn_s_sleep(1); \
    if ((++_sp & 255u) == 0u) { if (xb_ld(&(bar)[XB_TMO])) break; if (_sp > XB_SPIN_CAP) { atomicAdd(&(bar)[XB_TMO], 1u); break; } } } } while (0)

struct XcdBarrier { unsigned* bar; unsigned x; volatile LAS unsigned* st; };

__device__ __forceinline__ XcdBarrier xcd_barrier_post(unsigned* bar, volatile LAS unsigned* st) {
    XcdBarrier b; b.bar = bar; b.x = xb_xcc_id(); b.st = st;
    if (threadIdx.x == 0) (void)xb_add(&bar[XB_XCNT(b.x)], 1u);
    return b;
}
__device__ __forceinline__ void xcd_barrier_complete(unsigned* bar, unsigned x, unsigned& nloc, unsigned& nx) {
    const unsigned G = gridDim.x * gridDim.y * gridDim.z;
    unsigned sum, cnt, mine, sp = 0u;
    for (;;) {
        sum = 0u; cnt = 0u; mine = 0u;
#pragma unroll
        for (unsigned j = 0; j < 16; ++j) { const unsigned c = xb_ld(&bar[XB_XCNT(j)]); sum += c; cnt += (c > 0u) ? 1u : 0u; mine = (j == x) ? c : mine; }
        if (sum == G) break;
        __builtin_amdgcn_s_sleep(1);
        if ((++sp & 255u) == 0u) { if (xb_ld(&bar[XB_TMO])) break; if (sp > XB_SPIN_CAP) { atomicAdd(&bar[XB_TMO], 1u); break; } }
    }
    nloc = mine > 0u ? mine : 1u; nx = cnt > 0u ? cnt : 1u;
}
__device__ __forceinline__ void xcd_barrier(const XcdBarrier& b) {
    asm volatile("s_waitcnt vmcnt(0)" ::: "memory");
    __syncthreads();
    if (threadIdx.x == 0) {
        unsigned* bar = b.bar;
        __builtin_amdgcn_s_waitcnt(0);
        unsigned nloc = b.st[0], nx = b.st[1];
        if (nloc == 0u) { xcd_barrier_complete(bar, b.x, nloc, nx); b.st[0] = nloc; b.st[1] = nx; }
        const unsigned old = xb_add(&bar[XB_XSUB(b.x)], 1u);
        const unsigned gen = old / nloc;
        if (old + 1u == (gen + 1u) * nloc) {
            __builtin_amdgcn_fence(__ATOMIC_RELEASE, "agent");
            asm volatile("s_waitcnt vmcnt(0)" ::: "memory");
            const unsigned og = xb_add(&bar[XB_TOP], 1u);
            const unsigned tg = og / nx;
            if (og + 1u == (tg + 1u) * nx) xb_add(&bar[XB_TOPGEN], 1u);
            else XB_SPIN(xb_ld(&bar[XB_TOPGEN]) == tg, bar);
            __builtin_amdgcn_fence(__ATOMIC_ACQUIRE, "agent");
            xb_add(&bar[XB_XGEN(b.x)], 1u);
            asm volatile("s_waitcnt vmcnt(0)" ::: "memory");
        } else {
            XB_SPIN(xb_ld(&bar[XB_XGEN(b.x)]) == gen, bar);
            __builtin_amdgcn_fence(__ATOMIC_ACQUIRE, "agent");
            asm volatile("s_waitcnt vmcnt(0)" ::: "memory");
        }
    }
    __syncthreads();
}

namespace pg8 {
constexpr int BM = 256, BK = 64, HALF = 128, HTB = HALF * BK * 2, STAGE_BYTES = 8 * HTB, NXCD = 8, WGM = 4;
__host__ __device__ __forceinline__ int lds_byte(int r, int c) { const int st = (r >> 4) * 2 + (c >> 5), rr = r & 15, cc = c & 31, ob = rr * 64 + cc * 2; return st * 1024 + (ob ^ (((ob >> 9) & 1) << 5)); }
__host__ __device__ __forceinline__ void stage_rc(int b, int& R, int& C) { const int st = b / 1024, sb = b % 1024, swz = sb ^ (((sb >> 9) & 1) << 5); R = (st >> 1) * 16 + swz / 64; C = (st & 1) * 32 + (swz % 64) / 2; }
__host__ __device__ __forceinline__ int perm32(int rho) { const int n = rho >> 4, i = rho & 15; return 8 * (i >> 2) + 4 * n + (i & 3); }

struct Unit { int arow, brow, pn, aux; };
struct Gemm { const GAS bf16* A; const GAS bf16* Bt; int lda, ldb, K; };
typedef int v8i __attribute__((ext_vector_type(8))); typedef int v4i __attribute__((ext_vector_type(4)));
DI v8i cat16(bf16x8 a, bf16x8 b) { const v4i x = __builtin_bit_cast(v4i, a), y = __builtin_bit_cast(v4i, b); return __builtin_shufflevector(x, y, 0, 1, 2, 3, 4, 5, 6, 7); }

DI void tile_order(int L, int nM, int nN, int& pm, int& pn) {
    const int nwg = nM * nN;
    int wgid = L; { const int q = nwg / NXCD, r = nwg % NXCD, xcd = wgid % NXCD, off = wgid / NXCD; wgid = (xcd < r ? xcd * (q + 1) : r * (q + 1) + (xcd - r) * q) + off; }
    const int nig = WGM * nN, gid = wgid / nig, fm = gid * WGM, gsz = (nM - fm) < WGM ? (nM - fm) : WGM;
    pm = fm + ((wgid % nig) % gsz); pn = (wgid % nig) / gsz;
}
struct StaticSched {
    int nM, nN, G, c, arow0;
    DI void init(int nM_, int nN_, int G_, int c_, int arow0_) { nM = nM_; nN = nN_; G = G_; c = c_; arow0 = arow0_; }
    DI bool next(int i, Unit& u) const {
        const long L = (long)i * G + c; if (L >= (long)nM * nN) return false;
        int pm, pn; tile_order((int)L, nM, nN, pm, pn);
        u.arow = arow0 + pm * BM; u.brow = pn * BM; u.pn = pn; u.aux = 0; return true;
    }
};
struct InSched {
    int G, c; bool last;
    DI bool next(int i, Unit& u) const {
        const int L = i * G + c; int pm, pn;
        if (!last) { if (L >= (MALL / 256) * (INC / 256)) return false; tile_order(L, MALL / 256, INC / 256, pm, pn); }
        else if (L < (NX / 256) * (INC / 256)) tile_order(L, NX / 256, INC / 256, pm, pn);
        else { const int L2 = L - (NX / 256) * (INC / 256); if (L2 >= (NC / 256) * 6) return false; pm = NX / 256 + L2 % (NC / 256); pn = 2 + L2 / (NC / 256); }
        u.arow = pm * BM; u.brow = pn * BM; u.pn = pn; u.aux = 0; return true;
    }
};
struct MoeSched {
    int nM, nN, G, c, nrow_e; int toff[9];
    DI bool next(int i, Unit& u) const {
        const long L = (long)i * G + c; if (L >= (long)nM * nN) return false;
        int pm, pn; tile_order((int)L, nM, nN, pm, pn);
        int e = 0;
#pragma unroll
        for (int j = 1; j < 8; ++j) e += (pm >= toff[j]) ? 1 : 0;
        u.arow = pm * BM; u.brow = e * nrow_e + pn * BM; u.pn = pn; u.aux = e; return true;
    }
};

template <class Epi, class Sched, bool FP8 = false, int WSC = 127, bool I8 = false>
DI void gemm_phase(LAS unsigned char* lds, const Gemm g, const Sched& S, const Epi& E) {
    int tid = threadIdx.x; asm volatile("" : "+v"(tid));
    const int wid = __builtin_amdgcn_readfirstlane(tid >> 6), lane = tid & 63, wr = wid >> 2, wc = wid & 3, fr = lane & 15, fq = lane >> 4;
    const int K = g.K, nt = K / BK;
    unsigned voffA[2], voffB[2];
#pragma unroll
    for (int i = 0; i < 2; ++i) { int R, C; stage_rc(tid * 16 + i * 8192, R, C); const int Rb = Epi::PERM ? ((R & ~31) + perm32(R & 31)) : R;
        voffA[i] = (unsigned)(R * g.lda + C) * 2u; voffB[i] = (unsigned)(Rb * g.ldb + C) * 2u; }
    const size_t kstep = (size_t)(BK * 2);
    const size_t hstepA = (size_t)HALF * g.lda * 2, hstepB = (size_t)HALF * g.ldb * 2;
    const size_t rowA = (size_t)g.lda * 2, rowB = (size_t)g.ldb * 2;
    const unsigned ldsw = (unsigned)wid * 1024u;
    const int aoff = lds_byte(wr * 64 + fr, fq * 8), boff = lds_byte(wc * 32 + fr, fq * 8);
#define PG8_SA(b, h) (((b) * 2 + (h)) * HTB)
#define PG8_SB(b, h) ((4 + (b) * 2 + (h)) * HTB)
#define PG8_STAGE(bufoff, gbase, voff) do { _Pragma("unroll") for (int _i = 0; _i < 2; ++_i) \
        __builtin_amdgcn_global_load_lds((const GAS unsigned*)((const GAS char*)(gbase) + (voff)[_i]), (LAS unsigned*)(lds + (bufoff) + ldsw + _i * 8192), 16, 0, 0); } while (0)
#define PG8_LDA(dst, b, h) do { _Pragma("unroll") for (int m = 0; m < 4; ++m) { if constexpr (FP8) dst##8[m] = cat16(*(const LAS bf16x8*)(lds + PG8_SA(b, h) + aoff + m * 2048), *(const LAS bf16x8*)(lds + PG8_SA(b, h) + aoff + m * 2048 + 1024)); \
        else { _Pragma("unroll") for (int k = 0; k < 2; ++k) dst[m][k] = *(const LAS bf16x8*)(lds + PG8_SA(b, h) + aoff + m * 2048 + k * 1024); } } } while (0)
#define PG8_LDB(dst, b, h) do { _Pragma("unroll") for (int n = 0; n < 2; ++n) { if constexpr (FP8) dst##8[n] = cat16(*(const LAS bf16x8*)(lds + PG8_SB(b, h) + boff + n * 2048), *(const LAS bf16x8*)(lds + PG8_SB(b, h) + boff + n * 2048 + 1024)); \
        else { _Pragma("unroll") for (int k = 0; k < 2; ++k) dst[n][k] = *(const LAS bf16x8*)(lds + PG8_SB(b, h) + boff + n * 2048 + k * 1024); } } } while (0)
#define PG8_MMA(ai, bj, At, Bt) do { __builtin_amdgcn_s_setprio(1); _Pragma("unroll") for (int m = 0; m < 4; ++m) _Pragma("unroll") for (int n = 0; n < 2; ++n) { \
        if constexpr (FP8) asm volatile("v_mfma_scale_f32_16x16x128_f8f6f4 %0, %1, %2, %0, %3, %4 op_sel_hi:[0,0,0]" : "+v"(acc[ai][bj][m][n]) : "v"(Bt##8[n]), "v"(At##8[m]), "v"(sc_w), "v"(sc_a)); \
        else if constexpr (I8) { _Pragma("unroll") for (int k = 0; k < 2; ++k) acc[ai][bj][m][n] = __builtin_bit_cast(f32x4, __builtin_amdgcn_mfma_i32_16x16x64_i8(__builtin_bit_cast(v4i, Bt[n][k]), __builtin_bit_cast(v4i, At[m][k]), __builtin_bit_cast(v4i, acc[ai][bj][m][n]), 0, 0, 0)); } \
        else { _Pragma("unroll") for (int k = 0; k < 2; ++k) acc[ai][bj][m][n] = __builtin_amdgcn_mfma_f32_16x16x32_bf16(Bt[n][k], At[m][k], acc[ai][bj][m][n], 0, 0, 0); } } \
        __builtin_amdgcn_s_setprio(0); } while (0)
#define PG8_WAIT_V(n) asm volatile("s_waitcnt vmcnt(" #n ")" ::: "memory")
#define PG8_WAIT_L(n) asm volatile("s_waitcnt lgkmcnt(" #n ")" ::: "memory")
#define PG8_BAR __builtin_amdgcn_s_barrier()
#define PG8_SCHED __builtin_amdgcn_sched_barrier(0)
    Unit cur, nxt; int ui = 0;
    if (!S.next(0, cur)) return;
    f32x4 acc[2][2][4][2];
#pragma unroll
    for (int a = 0; a < 2; ++a)
#pragma unroll
        for (int b = 0; b < 2; ++b)
#pragma unroll
            for (int m = 0; m < 4; ++m)
#pragma unroll
                for (int n = 0; n < 2; ++n) acc[a][b][m][n] = (f32x4){0.f, 0.f, 0.f, 0.f};
    const int sc_w = WSC * 0x01010101, sc_a = 0x7f7f7f7f;
    bf16x8 At[4][2], B0[2][2], B1[2][2]; v8i At8[4], B08[2], B18[2];
    const GAS char* cA = (const GAS char*)g.A + (size_t)cur.arow * rowA; const GAS char* cB = (const GAS char*)g.Bt + (size_t)cur.brow * rowB;
    PG8_STAGE(PG8_SB(0, 0), cB, voffB); PG8_STAGE(PG8_SB(0, 1), cB + hstepB, voffB); PG8_STAGE(PG8_SA(0, 0), cA, voffA); PG8_STAGE(PG8_SA(0, 1), cA + hstepA, voffA);
    if (wr == 1) PG8_BAR;
    PG8_WAIT_V(2); PG8_BAR;
    PG8_STAGE(PG8_SB(1, 0), cB + kstep, voffB); PG8_STAGE(PG8_SA(1, 0), cA + kstep, voffA); PG8_STAGE(PG8_SB(1, 1), cB + hstepB + kstep, voffB);
    PG8_WAIT_V(6); PG8_BAR;
    for (;;) {
        const bool has_next = S.next(ui + 1, nxt);
        const GAS char* nA = has_next ? (const GAS char*)g.A + (size_t)nxt.arow * rowA : cA; const GAS char* nB = has_next ? (const GAS char*)g.Bt + (size_t)nxt.brow * rowB : cB;
        for (int t = 0; t < nt; t += 2) {
            const bool last = (t == nt - 2);
            const GAS char* a1 = cA + (size_t)(t + 1) * kstep;
            const GAS char* a2 = last ? nA : cA + (size_t)(t + 2) * kstep; const GAS char* b2 = last ? nB : cB + (size_t)(t + 2) * kstep;
            const GAS char* a3 = a2 + kstep; const GAS char* b3 = b2 + kstep;
            PG8_LDB(B0, 0, 0); PG8_LDB(B1, 0, 1); PG8_SCHED; PG8_LDA(At, 0, 0); PG8_STAGE(PG8_SA(1, 1), a1 + hstepA, voffA);
            PG8_WAIT_V(8); PG8_WAIT_L(0); PG8_BAR; PG8_MMA(0, 0, At, B0); PG8_MMA(0, 1, At, B1); PG8_BAR; PG8_SCHED;
            PG8_LDA(At, 0, 1); PG8_STAGE(PG8_SB(0, 0), b2, voffB); PG8_STAGE(PG8_SB(0, 1), b2 + hstepB, voffB); PG8_STAGE(PG8_SA(0, 0), a2, voffA);
            PG8_WAIT_V(8); PG8_WAIT_L(0); PG8_BAR; PG8_MMA(1, 0, At, B0); PG8_MMA(1, 1, At, B1); PG8_BAR; PG8_SCHED;
            PG8_LDB(B0, 1, 0); PG8_LDB(B1, 1, 1); PG8_SCHED; PG8_LDA(At, 1, 0); PG8_STAGE(PG8_SA(0, 1), a2 + hstepA, voffA);
            PG8_WAIT_V(8); PG8_WAIT_L(0); PG8_BAR; PG8_MMA(0, 0, At, B0); PG8_MMA(0, 1, At, B1); PG8_BAR; PG8_SCHED;
            PG8_LDA(At, 1, 1); PG8_STAGE(PG8_SB(1, 0), b3, voffB); PG8_STAGE(PG8_SB(1, 1), b3 + hstepB, voffB); PG8_STAGE(PG8_SA(1, 0), a3, voffA);
            PG8_WAIT_V(8); PG8_WAIT_L(0); PG8_BAR; PG8_MMA(1, 0, At, B0); PG8_MMA(1, 1, At, B1); PG8_BAR; PG8_SCHED;
        }
        if (wr == 0) PG8_BAR;
        if constexpr (FP8) asm volatile("s_nop 15\n\ts_nop 15\n\ts_nop 15\n\ts_nop 15" ::: "memory");
        if constexpr (Epi::HAS_PRE) {
            const auto pre = E.preload(cur, wr, fr);
            if constexpr (I8) {
#pragma unroll
                for (int a = 0; a < 2; ++a)
#pragma unroll
                    for (int b = 0; b < 2; ++b)
#pragma unroll
                        for (int m = 0; m < 4; ++m)
#pragma unroll
                            for (int n = 0; n < 2; ++n) { const v4i t = __builtin_bit_cast(v4i, acc[a][b][m][n]); acc[a][b][m][n] = (f32x4){(float)t.x, (float)t.y, (float)t.z, (float)t.w}; } }
            E(acc, cur, wr, wc, fr, fq, pre);
        } else {
        if constexpr (I8) {
#pragma unroll
            for (int a = 0; a < 2; ++a)
#pragma unroll
                for (int b = 0; b < 2; ++b)
#pragma unroll
                    for (int m = 0; m < 4; ++m)
#pragma unroll
                        for (int n = 0; n < 2; ++n) { const v4i t = __builtin_bit_cast(v4i, acc[a][b][m][n]); acc[a][b][m][n] = (f32x4){(float)t.x, (float)t.y, (float)t.z, (float)t.w}; } }
        E(acc, cur, wr, wc, fr, fq);
        }
        if (!has_next) break;
#pragma unroll
        for (int a = 0; a < 2; ++a)
#pragma unroll
            for (int b = 0; b < 2; ++b)
#pragma unroll
                for (int m = 0; m < 4; ++m)
#pragma unroll
                    for (int n = 0; n < 2; ++n) acc[a][b][m][n] = (f32x4){0.f, 0.f, 0.f, 0.f};
        cur = nxt; cA = nA; cB = nB; ++ui;
        if (wr == 1) PG8_BAR;
    }
    PG8_WAIT_V(0);
    PG8_BAR;
#undef PG8_SA
#undef PG8_SB
#undef PG8_STAGE
#undef PG8_LDA
#undef PG8_LDB
#undef PG8_MMA
#undef PG8_WAIT_V
#undef PG8_WAIT_L
#undef PG8_BAR
#undef PG8_SCHED
}

DI f32x2 ex2p(f32x2 x) { return (f32x2){__builtin_amdgcn_exp2f(x.x), __builtin_amdgcn_exp2f(x.y)}; }
DI f32x2 rcpp(f32x2 x) { return (f32x2){__builtin_amdgcn_rcpf(x.x), __builtin_amdgcn_rcpf(x.y)}; }
DI f32x2 lo2(f32x4 v) { return __builtin_shufflevector(v, v, 0, 1); }
DI f32x2 hi2(f32x4 v) { return __builtin_shufflevector(v, v, 2, 3); }
DI v4u pack8p(const f32x2 (&o)[4]) { v4u w; w.x = pk2(o[0].x, o[0].y); w.y = pk2(o[1].x, o[1].y); w.z = pk2(o[2].x, o[2].y); w.w = pk2(o[3].x, o[3].y); return w; }
DI v4u pack8f(const float (&o)[8]) { v4u w; w.x = pk2(o[0], o[1]); w.y = pk2(o[2], o[3]); w.z = pk2(o[4], o[5]); w.w = pk2(o[6], o[7]); return w; }
template <bool LBZ> struct EpiIn {
    static constexpr bool PERM = true; static constexpr bool HAS_PRE = true;
    GAS bf16* P; const GAS float* LB;
    static constexpr bool lbz = LBZ;
    const GAS float* rs; const LAS float* cmax;
    template <int T> DI static void act8(float (&v)[8], const float (&lb)[8]) {
        const float L2E = 1.4426950408889634f, LN2 = 0.6931471805599453f;
        if (T == 2) return;
        if (T == 0 || T == 3 || T == 4) {
            f32x2 a2[4] = {{v[0], v[1]}, {v[2], v[3]}, {v[4], v[5]}, {v[6], v[7]}}, e2[4];
#pragma unroll
            for (int p = 0; p < 4; ++p) e2[p] = ex2p(a2[p] * (f32x2){-L2E, -L2E});
#pragma unroll
            for (int p = 0; p < 4; ++p) { e2[p] = e2[p] + (f32x2){1.0f, 1.0f}; if (T == 0) a2[p] = a2[p] * (f32x2){0.08838834764831845f, 0.08838834764831845f}; }
#pragma unroll
            for (int p = 0; p < 4; ++p) e2[p] = rcpp(e2[p]);
#pragma unroll
            for (int p = 0; p < 4; ++p) { const f32x2 o = (T == 4) ? e2[p] : a2[p] * e2[p]; v[2 * p] = o.x; v[2 * p + 1] = o.y; }
            return;
        }
        f32x2 a2[4] = {{v[0], v[1]}, {v[2], v[3]}, {v[4], v[5]}, {v[6], v[7]}}, t2[4], m2[4];
#pragma unroll
        for (int p = 0; p < 4; ++p) { m2[p] = __builtin_elementwise_min(a2[p], (f32x2){0.f, 0.f}); t2[p] = (a2[p] - m2[p] - m2[p]) * (f32x2){-L2E, -L2E}; }
#pragma unroll
        for (int p = 0; p < 4; ++p) t2[p] = ex2p(t2[p]);
        if constexpr (LBZ) {
#pragma unroll
            for (int p = 0; p < 4; ++p) t2[p] = t2[p] + (f32x2){1.0f, 1.0f};
#pragma unroll
            for (int p = 0; p < 4; ++p) t2[p] = (f32x2){__builtin_amdgcn_logf(t2[p].x), __builtin_amdgcn_logf(t2[p].y)};
#pragma unroll
            for (int p = 0; p < 4; ++p) { const f32x2 o = m2[p] - t2[p] * (f32x2){LN2, LN2}; v[2 * p] = o.x; v[2 * p + 1] = o.y; }
        } else {
            f32x2 r2[4];
#pragma unroll
            for (int p = 0; p < 4; ++p) r2[p] = rcpp(t2[p] + (f32x2){1.0f, 1.0f});
#pragma unroll
            for (int p = 0; p < 4; ++p) { const f32x2 num = (f32x2){a2[p].x >= 0.f ? 1.0f : t2[p].x, a2[p].y >= 0.f ? 1.0f : t2[p].y};
                const f32x2 lbp = (f32x2){lb[2 * p], lb[2 * p + 1]}; r2[p] = lbp + ((f32x2){1.0f, 1.0f} - lbp) * (num * r2[p]); }
#pragma unroll
            for (int p = 0; p < 4; ++p) { v[2 * p] = __builtin_amdgcn_logf(r2[p].x) * LN2; v[2 * p + 1] = __builtin_amdgcn_logf(r2[p].y) * LN2; }
        }
    }
    struct Pre { float r[2][4]; };
    DI Pre preload(const Unit& u, int wr, int fr) const { Pre p; asm volatile("" : "+v"(fr)); const int row0 = u.arow + wr * 64 + fr;
#pragma unroll
        for (int ai = 0; ai < 2; ++ai)
#pragma unroll
            for (int m = 0; m < 4; ++m) p.r[ai][m] = rs[row0 + ai * 128 + m * 16];
        return p; }
    template <int T> DI void run(const f32x4 (&acc)[2][2][4][2], const Unit& u, int wr, int wc, int fr, int fq, const Pre& pre) const {
        const int row0 = u.arow + wr * 64 + fr, colt = u.pn * 256 + wc * 32 + 8 * fq;
        float rsr[2][4];
#pragma unroll
        for (int ai = 0; ai < 2; ++ai)
#pragma unroll
            for (int m = 0; m < 4; ++m) rsr[ai][m] = pre.r[ai][m];
#pragma unroll
        for (int bj = 0; bj < 2; ++bj) {
            float lb[8];
#pragma unroll
            for (int j = 0; j < 8; ++j) lb[j] = (T == 1 && !lbz) ? LB[colt - 512 + bj * 128 + j] : 0.f;
            const f32x4 c0 = *(const LAS f32x4*)(cmax + colt + bj * 128) * (1.0f / 127.0f), c1 = *(const LAS f32x4*)(cmax + colt + bj * 128 + 4) * (1.0f / 127.0f);
#pragma unroll
            for (int ai = 0; ai < 2; ++ai)
#pragma unroll
                for (int m = 0; m < 4; ++m) { GAS bf16* rowp = P + (size_t)(row0 + ai * 128 + m * 16) * INC + colt;
                    const f32x4 w0 = acc[ai][bj][m][0] * (c0 * rsr[ai][m]), w1 = acc[ai][bj][m][1] * (c1 * rsr[ai][m]);
                    float v[8] = {w0[0], w0[1], w0[2], w0[3], w1[0], w1[1], w1[2], w1[3]};
                    act8<T>(v, lb);
                    *(GAS v4u*)(rowp + bj * 128) = pack8f(v);
                    __builtin_amdgcn_sched_barrier(0); }
        }
    }
    DI void operator()(const f32x4 (&acc)[2][2][4][2], const Unit& u, int wr, int wc, int fr, int fq, const Pre& pre) const {
        const int t = u.pn >> 1;
        if (t == 0) run<0>(acc, u, wr, wc, fr, fq, pre);
        else if (t == 1 || t == 2) run<1>(acc, u, wr, wc, fr, fq, pre);
        else if (t == 3 || t == 5) run<2>(acc, u, wr, wc, fr, fq, pre);
        else if (t == 4) run<3>(acc, u, wr, wc, fr, fq, pre);
        else run<4>(acc, u, wr, wc, fr, fq, pre);
    }
};
template <int MODE> struct EpiRow {
    static constexpr bool PERM = true; static constexpr bool HAS_PRE = false;
    GAS bf16* O; int ldc; const GAS float* colscale; int g2off;
    DI void operator()(const f32x4 (&acc)[2][2][4][2], const Unit& u, int wr, int wc, int fr, int fq) const {
        const int row0 = u.arow + wr * 64 + fr, colt = u.pn * 256 + wc * 32 + 8 * fq;
        if constexpr (MODE == 0) {
            float cs[2][8];
#pragma unroll
            for (int bj = 0; bj < 2; ++bj)
#pragma unroll
                for (int j = 0; j < 8; ++j) cs[bj][j] = colscale ? colscale[colt + bj * 128 + j] : 1.f;
#pragma unroll
            for (int ai = 0; ai < 2; ++ai)
#pragma unroll
                for (int m = 0; m < 4; ++m) { GAS bf16* rowp = O + (size_t)(row0 + ai * 128 + m * 16) * ldc + colt;
#pragma unroll
                    for (int bj = 0; bj < 2; ++bj) { const f32x4 v0 = acc[ai][bj][m][0], v1 = acc[ai][bj][m][1];
                        float o[8] = {v0[0], v0[1], v0[2], v0[3], v1[0], v1[1], v1[2], v1[3]};
#pragma unroll
                        for (int j = 0; j < 8; ++j) o[j] *= cs[bj][j];
                        v4u w; w.x = pk2(o[0], o[1]); w.y = pk2(o[2], o[3]); w.z = pk2(o[4], o[5]); w.w = pk2(o[6], o[7]);
                        *(GAS v4u*)(rowp + bj * 128) = w; } }
        } else if constexpr (MODE == 1) {
            v4u gq[2][4], r0[2][4];
#pragma unroll
            for (int ai = 0; ai < 2; ++ai)
#pragma unroll
                for (int m = 0; m < 4; ++m) gq[ai][m] = *(const GAS v4u*)(O + (size_t)(row0 + ai * 128 + m * 16) * ldc + colt);
#pragma unroll
            for (int ai = 0; ai < 2; ++ai)
#pragma unroll
                for (int m = 0; m < 4; ++m) { const f32x4 v0 = acc[ai][0][m][0], v1 = acc[ai][0][m][1]; const v4u g = gq[ai][m];
                    v4u w; w.x = pk2(v0[0] * bflo(g.x), v0[1] * bfhi(g.x)); w.y = pk2(v0[2] * bflo(g.y), v0[3] * bfhi(g.y)); w.z = pk2(v1[0] * bflo(g.z), v1[1] * bfhi(g.z)); w.w = pk2(v1[2] * bflo(g.w), v1[3] * bfhi(g.w));
                    r0[ai][m] = w; }
            __builtin_amdgcn_sched_barrier(0);
#pragma unroll
            for (int ai = 0; ai < 2; ++ai)
#pragma unroll
                for (int m = 0; m < 4; ++m) gq[ai][m] = *(const GAS v4u*)(O + (size_t)(row0 + ai * 128 + m * 16) * ldc + colt + 128);
            __builtin_amdgcn_sched_barrier(0);
#pragma unroll
            for (int ai = 0; ai < 2; ++ai)
#pragma unroll
                for (int m = 0; m < 4; ++m) *(GAS v4u*)(O + (size_t)(row0 + ai * 128 + m * 16) * ldc + colt) = r0[ai][m];
            __builtin_amdgcn_sched_barrier(0);
#pragma unroll
            for (int ai = 0; ai < 2; ++ai)
#pragma unroll
                for (int m = 0; m < 4; ++m) { const f32x4 v0 = acc[ai][1][m][0], v1 = acc[ai][1][m][1]; const v4u g = gq[ai][m];
                    v4u w; w.x = pk2(v0[0] * bflo(g.x), v0[1] * bfhi(g.x)); w.y = pk2(v0[2] * bflo(g.y), v0[3] * bfhi(g.y)); w.z = pk2(v1[0] * bflo(g.z), v1[1] * bfhi(g.z)); w.w = pk2(v1[2] * bflo(g.w), v1[3] * bfhi(g.w));
                    *(GAS v4u*)(O + (size_t)(row0 + ai * 128 + m * 16) * ldc + colt + 128) = w; }
        } else {
            v4u gq[2][4], pq[2][4], rq[4];
            auto LD = [&](int q, int slot) {
#pragma unroll
                for (int m = 0; m < 4; ++m) { const GAS bf16* rp = O + (size_t)(row0 + (q & 1) * 128 + m * 16) * ldc + colt + (q >> 1) * 128; gq[slot][m] = *(const GAS v4u*)(rp + g2off); pq[slot][m] = *(const GAS v4u*)rp; } };
            auto CP = [&](int q, int slot) {
#pragma unroll
                for (int m = 0; m < 4; ++m) { const f32x4 v0 = acc[q & 1][q >> 1][m][0], v1 = acc[q & 1][q >> 1][m][1]; const v4u g = gq[slot][m], t = pq[slot][m];
                    v4u w; w.x = pk2(bflo(t.x) + v0[0] * bflo(g.x), bfhi(t.x) + v0[1] * bfhi(g.x)); w.y = pk2(bflo(t.y) + v0[2] * bflo(g.y), bfhi(t.y) + v0[3] * bfhi(g.y));
                    w.z = pk2(bflo(t.z) + v1[0] * bflo(g.z), bfhi(t.z) + v1[1] * bfhi(g.z)); w.w = pk2(bflo(t.w) + v1[2] * bflo(g.w), bfhi(t.w) + v1[3] * bfhi(g.w));
                    rq[m] = w; } };
            auto ST = [&](int q) {
#pragma unroll
                for (int m = 0; m < 4; ++m) *(GAS v4u*)(O + (size_t)(row0 + (q & 1) * 128 + m * 16) * ldc + colt + (q >> 1) * 128) = rq[m]; };
            LD(0, 0); LD(1, 1); __builtin_amdgcn_sched_barrier(0);
            CP(0, 0); __builtin_amdgcn_sched_barrier(0); LD(2, 0); __builtin_amdgcn_sched_barrier(0); ST(0); __builtin_amdgcn_sched_barrier(0);
            CP(1, 1); __builtin_amdgcn_sched_barrier(0); LD(3, 1); __builtin_amdgcn_sched_barrier(0); ST(1); __builtin_amdgcn_sched_barrier(0);
            CP(2, 0); ST(2); __builtin_amdgcn_sched_barrier(0);
            CP(3, 1); ST(3);
        }
    }
};
template <bool OUT8> struct EpiSwiGLU {
    static constexpr bool PERM = true; static constexpr bool HAS_PRE = true;
    GAS bf16* Hh; int ldc; const GAS float* rowgate;
    const GAS float* rs; const LAS float* cmg; const LAS float* cmu;
    struct Pre { float r[2][4]; };
    DI Pre preload(const Unit& u, int wr, int fr) const { Pre p; asm volatile("" : "+v"(fr)); const int row0 = u.arow + wr * 64 + fr;
#pragma unroll
        for (int ai = 0; ai < 2; ++ai)
#pragma unroll
            for (int m = 0; m < 4; ++m) p.r[ai][m] = rs[row0 + ai * 128 + m * 16];
        return p; }
    DI void operator()(const f32x4 (&acc)[2][2][4][2], const Unit& u, int wr, int wc, int fr, int fq, const Pre& pre) const {
        const int row0 = u.arow + wr * 64 + fr, col0 = u.pn * 128 + wc * 32 + 8 * fq;
        const f32x4 sg4[2] = {*(const LAS f32x4*)(cmg + col0) * (1.0f / 127.0f), *(const LAS f32x4*)(cmg + col0 + 4) * (1.0f / 127.0f)}, su4[2] = {*(const LAS f32x4*)(cmu + col0) * (1.0f / 127.0f), *(const LAS f32x4*)(cmu + col0 + 4) * (1.0f / 127.0f)};
        float rsv[2][4], rgv[2][4];
#pragma unroll
        for (int ai = 0; ai < 2; ++ai)
#pragma unroll
            for (int m = 0; m < 4; ++m) { rsv[ai][m] = pre.r[ai][m]; rgv[ai][m] = rowgate ? rowgate[row0 + ai * 128 + m * 16] : 1.f; }
#pragma unroll
        for (int ai = 0; ai < 2; ++ai)
#pragma unroll
            for (int m = 0; m < 4; ++m) { const int row = row0 + ai * 128 + m * 16; const float rg = rgv[ai][m];
                const f32x4 g0 = acc[ai][0][m][0], g1 = acc[ai][0][m][1], u0 = acc[ai][1][m][0], u1 = acc[ai][1][m][1];
                const float rsr = rsv[ai][m];
                const f32x4 a0 = g0 * (sg4[0] * rsr), a1 = g1 * (sg4[1] * rsr), b0 = u0 * (su4[0] * (rsr * rg)), b1 = u1 * (su4[1] * (rsr * rg));
                f32x2 g2[4] = {lo2(a0), hi2(a0), lo2(a1), hi2(a1)}, u2[4] = {lo2(b0), hi2(b0), lo2(b1), hi2(b1)}, e2[4];
#pragma unroll
                for (int p = 0; p < 4; ++p) e2[p] = ex2p(g2[p] * (f32x2){-1.4426950408889634f, -1.4426950408889634f});
#pragma unroll
                for (int p = 0; p < 4; ++p) e2[p] = e2[p] + (f32x2){1.0f, 1.0f};
#pragma unroll
                for (int p = 0; p < 4; ++p) e2[p] = rcpp(e2[p]);
#pragma unroll
                for (int p = 0; p < 4; ++p) g2[p] = g2[p] * u2[p];
#pragma unroll
                for (int p = 0; p < 4; ++p) g2[p] = g2[p] * e2[p];
                if constexpr (OUT8) { v2u w; w.x = pk4_fp8(g2[0].x, g2[0].y, g2[1].x, g2[1].y); w.y = pk4_fp8(g2[2].x, g2[2].y, g2[3].x, g2[3].y);
                    *(GAS v2u*)((GAS unsigned char*)Hh + (size_t)row * ldc + col0) = w; }
                else *(GAS v4u*)(Hh + (size_t)row * ldc + col0) = pack8p(g2); }
    }
};
template <class E> struct EpiDry { static constexpr bool PERM = E::PERM; static constexpr bool HAS_PRE = false; E e; bool never;
    DI void operator()(const f32x4 (&acc)[2][2][4][2], const Unit& u, int wr, int wc, int fr, int fq) const { if (never) e(acc, u, wr, wc, fr, fq); } };
struct EpiSwiGLU8 {
    static constexpr bool PERM = true; static constexpr bool HAS_PRE = false;
    GAS unsigned char* Hh; int ldc; const GAS float* rowgate;
    DI void operator()(const f32x4 (&acc)[2][2][4][2], const Unit& u, int wr, int wc, int fr, int fq) const {
        const int row0 = u.arow + wr * 64 + fr, col0 = u.pn * 128 + wc * 32 + 8 * fq;
        float rgv[2][4];
#pragma unroll
        for (int ai = 0; ai < 2; ++ai)
#pragma unroll
            for (int m = 0; m < 4; ++m) rgv[ai][m] = rowgate ? rowgate[row0 + ai * 128 + m * 16] : 1.f;
#pragma unroll
        for (int ai = 0; ai < 2; ++ai)
#pragma unroll
            for (int m = 0; m < 4; ++m) { const int row = row0 + ai * 128 + m * 16; const float rg = rgv[ai][m];
                const f32x4 g0 = acc[ai][0][m][0], g1 = acc[ai][0][m][1], u0 = acc[ai][1][m][0], u1 = acc[ai][1][m][1];
                f32x2 g2[4] = {lo2(g0), hi2(g0), lo2(g1), hi2(g1)}, u2[4] = {lo2(u0), hi2(u0), lo2(u1), hi2(u1)}, e2[4];
#pragma unroll
                for (int p = 0; p < 4; ++p) e2[p] = ex2p(g2[p] * (f32x2){-1.4426950408889634f, -1.4426950408889634f});
#pragma unroll
                for (int p = 0; p < 4; ++p) { e2[p] = e2[p] + (f32x2){1.0f, 1.0f}; u2[p] = u2[p] * (f32x2){rg, rg}; }
#pragma unroll
                for (int p = 0; p < 4; ++p) e2[p] = rcpp(e2[p]);
#pragma unroll
                for (int p = 0; p < 4; ++p) g2[p] = g2[p] * u2[p];
#pragma unroll
                for (int p = 0; p < 4; ++p) g2[p] = g2[p] * e2[p];
                v2u w; w.x = pk4_fp8(g2[0].x, g2[0].y, g2[1].x, g2[1].y); w.y = pk4_fp8(g2[2].x, g2[2].y, g2[3].x, g2[3].y);
                *(GAS v2u*)(Hh + (size_t)row * ldc + col0) = w; }
    }
};
}

struct Args { const float* in[25]; float* out; unsigned char* ws; int ph_lo, ph_hi; };
struct Frame {
    LAS unsigned char* lds; int tid, lane, wave, G, gw, NGW; bool never;
    GAS float* out; GAS unsigned char* ws;
};
DI Frame fresh(const Frame& F0) { Frame F = F0; asm volatile("" : "+v"(F.tid)); F.lane = F.tid & 63; asm volatile("" : "+s"(F.ws), "+s"(F.out)); return F; }
enum { I_X = 0, I_C, I_CTX, I_CCTX, I_ADAW, I_ADAB, I_MIXPRE, I_MIXPOST, I_FFNPRE, I_FFNPOST, I_WIN, I_LB, I_GAIN, I_POOLW, I_POOLS, I_WBR, I_WBP, I_WOUT, I_FG, I_FU, I_FD, I_ROUTER, I_MG, I_MU, I_MD };

DI void tr_item(const GAS float* W, int K, int N, GAS bf16* WT, int ldk, int koff, int row_off, int nb, int nstride, LAS float* scr, int item, int lane) {
    const int nblk = N / 32, kb = item / nblk, nbi = item % nblk, k0 = 64 * kb, n0 = 32 * nbi;
    f32x4 ld[8];
#pragma unroll
    for (int i = 0; i < 8; ++i) ld[i] = *(const GAS f32x4*)(W + (size_t)(k0 + (lane >> 3) + 8 * i) * N + n0 + 4 * (lane & 7));
#pragma unroll
    for (int i = 0; i < 8; ++i) { LAS float* d = scr + ((lane >> 3) + 8 * i) * 33 + 4 * (lane & 7); d[0] = ld[i].x; d[1] = ld[i].y; d[2] = ld[i].z; d[3] = ld[i].w; }
    LDS_WAIT(); asm volatile("" ::: "memory");
    const int c = lane & 7;
#pragma unroll
    for (int j = 0; j < 4; ++j) { const int n = (lane >> 3) + 8 * j; const LAS float* s = scr + (8 * c) * 33 + n;
        v4u o; o.x = pk2(s[0 * 33], s[1 * 33]); o.y = pk2(s[2 * 33], s[3 * 33]); o.z = pk2(s[4 * 33], s[5 * 33]); o.w = pk2(s[6 * 33], s[7 * 33]);
        const int ng = n0 + n, drow = row_off + (ng / nb) * nstride + (ng % nb);
        *(GAS v4u*)(WT + (size_t)drow * ldk + koff + k0 + 8 * c) = o; }
    LDS_WAIT(); asm volatile("" ::: "memory");
}

DI void tr_item8(const GAS float* W, int K, int N, GAS unsigned char* WT, int ldk, int row_off, int nb, int nstride, float qs, LAS float* scr, int item, int lane) {
    const int nblk = N / 32, kb = item / nblk, nbi = item % nblk, k0 = 64 * kb, n0 = 32 * nbi;
    f32x4 ld[8];
#pragma unroll
    for (int i = 0; i < 8; ++i) ld[i] = *(const GAS f32x4*)(W + (size_t)(k0 + (lane >> 3) + 8 * i) * N + n0 + 4 * (lane & 7));
#pragma unroll
    for (int i = 0; i < 8; ++i) { LAS float* d = scr + ((lane >> 3) + 8 * i) * 33 + 4 * (lane & 7); d[0] = ld[i].x; d[1] = ld[i].y; d[2] = ld[i].z; d[3] = ld[i].w; }
    LDS_WAIT(); asm volatile("" ::: "memory");
    const int c = lane & 7;
#pragma unroll
    for (int j = 0; j < 4; ++j) { const int n = (lane >> 3) + 8 * j; const LAS float* sp = scr + (8 * c) * 33 + n;
        v2u o; o.x = pk4_fp8(sp[0 * 33] * qs, sp[1 * 33] * qs, sp[2 * 33] * qs, sp[3 * 33] * qs); o.y = pk4_fp8(sp[4 * 33] * qs, sp[5 * 33] * qs, sp[6 * 33] * qs, sp[7 * 33] * qs);
        const int ng = n0 + n, drow = row_off + (ng / nb) * nstride + (ng % nb);
        *(GAS v2u*)(WT + (size_t)drow * ldk + k0 + 8 * c) = o; }
    LDS_WAIT(); asm volatile("" ::: "memory");
}

DI void absmax_item(const GAS float* W, int N, GAS unsigned* cmaxbits, int item, int lane) {
    const int nblk = N / 256, kb = item / nblk, nbi = item % nblk;
    const GAS float* p = W + (size_t)(64 * kb) * N + 256 * nbi + 4 * lane;
    f32x4 m = (f32x4){0.f, 0.f, 0.f, 0.f};
#pragma unroll 8
    for (int k = 0; k < 64; ++k) { const f32x4 w = *(const GAS f32x4*)(p + (size_t)k * N); m.x = fmaxf(m.x, fabsf(w.x)); m.y = fmaxf(m.y, fabsf(w.y)); m.z = fmaxf(m.z, fabsf(w.z)); m.w = fmaxf(m.w, fabsf(w.w)); }
    GAS unsigned* c = cmaxbits + 256 * nbi + 4 * lane;
    __hip_atomic_fetch_max(c + 0, __float_as_uint(m.x), __ATOMIC_RELAXED, __HIP_MEMORY_SCOPE_AGENT); __hip_atomic_fetch_max(c + 1, __float_as_uint(m.y), __ATOMIC_RELAXED, __HIP_MEMORY_SCOPE_AGENT);
    __hip_atomic_fetch_max(c + 2, __float_as_uint(m.z), __ATOMIC_RELAXED, __HIP_MEMORY_SCOPE_AGENT); __hip_atomic_fetch_max(c + 3, __float_as_uint(m.w), __ATOMIC_RELAXED, __HIP_MEMORY_SCOPE_AGENT);
}
DI void tr_item_i8(const GAS float* W, int K, int N, GAS unsigned char* WT, int ldk, const GAS float* cmax, LAS float* scr, int item, int lane, int row_off = 0, int nb = 1 << 30, int nstride = 0) {
    const int nblk = N / 32, kb = item / nblk, nbi = item % nblk, k0 = 64 * kb, n0 = 32 * nbi;
    f32x4 ld[8];
#pragma unroll
    for (int i = 0; i < 8; ++i) ld[i] = *(const GAS f32x4*)(W + (size_t)(k0 + (lane >> 3) + 8 * i) * N + n0 + 4 * (lane & 7));
#pragma unroll
    for (int i = 0; i < 8; ++i) { LAS float* d = scr + ((lane >> 3) + 8 * i) * 33 + 4 * (lane & 7); d[0] = ld[i].x; d[1] = ld[i].y; d[2] = ld[i].z; d[3] = ld[i].w; }
    LDS_WAIT(); asm volatile("" ::: "memory");
    const int c = lane & 7;
#pragma unroll
    for (int j = 0; j < 4; ++j) { const int n = (lane >> 3) + 8 * j; const LAS float* sp = scr + (8 * c) * 33 + n;
        const float q = 127.0f / fmaxf(cmax[n0 + n], 1e-30f);
        v2u o; o.x = pk4_i8(sp[0 * 33] * q, sp[1 * 33] * q, sp[2 * 33] * q, sp[3 * 33] * q); o.y = pk4_i8(sp[4 * 33] * q, sp[5 * 33] * q, sp[6 * 33] * q, sp[7 * 33] * q);
        const int ng = n0 + n, drow = row_off + (ng / nb) * nstride + (ng % nb);
        *(GAS v2u*)(WT + (size_t)drow * ldk + k0 + 8 * c) = o; }
    LDS_WAIT(); asm volatile("" ::: "memory");
}

DI void p0_prologue(const Frame& F0, const Args& A) {
    const Frame F = fresh(F0);
    LAS float* scr = (LAS float*)(F.lds + F.wave * 16384);
    GAS unsigned char* ws = F.ws;
    constexpr int IT_IN = 16 * 160, IT_BR = 8 * 32, IT_O = 16 * 32, IT_F = 16 * 88, IT_FD = 44 * 32;
    constexpr int PER_L = IT_BR + IT_O;
    constexpr int NITEMS = 2 * PER_L + IT_FD;
    for (int it = F.gw; it < NITEMS; it += F.NGW) {
        int r = it;
        if (r < 2 * PER_L) { const int l = r / PER_L; r -= l * PER_L;
            if (r < IT_BR) { tr_item(((const GAS float*)A.in[I_WBR]) + (size_t)l * DH * D, DH, D, (GAS bf16*)(ws + WS_WR) + (size_t)l * D * DH, DH, 0, 0, 1 << 30, 0, scr, r, F.lane); continue; } r -= IT_BR;
            tr_item(((const GAS float*)A.in[I_WOUT]) + (size_t)l * D * D, D, D, (GAS bf16*)(ws + WS_WO) + (size_t)l * D * D, D, 0, 0, 1 << 30, 0, scr, r, F.lane); continue; }
        r -= 2 * PER_L;
        tr_item8(((const GAS float*)A.in[I_FD]), DFF, D, ws + WS_WD, DFF, 0, 1 << 30, 0, 64.f, scr, r, F.lane);
    }
    for (int it = F.NGW - 1 - F.gw; it < 2 * 16 * 20 + 2 * 16 * 11; it += F.NGW) {
        if (it < 640) { const int l = it / 320;
            absmax_item(((const GAS float*)A.in[I_WIN]) + (size_t)l * D * INC, INC, (GAS unsigned*)(ws + WS_CTL) + CW_CMAX_IN + l * INC, it % 320, F.lane); }
        else { const int i2 = it - 640, w = i2 / 176;
            absmax_item((const GAS float*)A.in[w ? I_FU : I_FG], DFF, (GAS unsigned*)(ws + WS_CTL) + (w ? CW_CMAX_FU : CW_CMAX_FG), i2 % 176, F.lane); }
    }
    for (int item = blockIdx.x; item < 2 * 4 * 16 * 2; item += F.G) {
        const int l = item >> 7, g = (item >> 5) & 3, cb = (item >> 1) & 15, n = (item & 1) * 512 + F.tid;
        const GAS float* pw = ((const GAS float*)A.in[I_POOLW]) + (((size_t)l * 4 + g) * 128 + cb * 8) * 128;
        const GAS float* ps = ((const GAS float*)A.in[I_POOLS]) + l * DH + g * 128;
        const GAS float* wp = ((const GAS float*)A.in[I_WBP]) + ((size_t)l * DH + g * 128) * D + n;
        float acc[8];
#pragma unroll
        for (int j = 0; j < 8; ++j) acc[j] = 0.f;
#pragma unroll 8
        for (int e = 0; e < 128; ++e) { const float w = wp[(size_t)e * D] * ps[e];
#pragma unroll
            for (int j = 0; j < 8; ++j) acc[j] += pw[j * 128 + e] * w; }
        v4u o; o.x = pk2(acc[0], acc[1]); o.y = pk2(acc[2], acc[3]); o.z = pk2(acc[4], acc[5]); o.w = pk2(acc[6], acc[7]);
        *(GAS v4u*)((GAS bf16*)(ws + WS_WP) + ((size_t)l * D + n) * DH + g * 128 + cb * 8) = o;
    }
    for (int i = blockIdx.x * NTHR + F.tid; i < 2 * 2 * DH; i += F.G * NTHR) {
        const int l = i / (2 * DH), rem = i % (2 * DH);
        float v = 0.f;
        if (l == 1) { const float h0 = ((const GAS float*)A.in[I_LB])[rem], h1 = ((const GAS float*)A.in[I_LB])[2 * DH + rem]; v = 1.f / (1.f + expf(h0 - h1)); }
        ((GAS float*)(ws + WS_LB))[i] = v;
    }
    __syncthreads();
    constexpr int TP = 1026;
    LAS float* T = (LAS float*)F.lds;
    for (int item = blockIdx.x; item < 2 * 96; item += F.G) {
        const int l = item / 96, e0 = (item % 96) * 64;
        for (int i = F.tid; i < 33 * 1024; i += NTHR) { const int bb = i >> 10, k = i & 1023; const float cv = bb < 32 ? ((const GAS float*)A.in[I_C])[bb * 1024 + k] : ((const GAS float*)A.in[I_CCTX])[k];
            T[bb * TP + k] = cv * __builtin_amdgcn_rcpf(1.0f + __builtin_amdgcn_exp2f(-1.4426950408889634f * cv)); }
        __syncthreads();
        const int kq = F.wave, j = F.lane & 31, kk = F.lane >> 5;
        const GAS float* wp = ((const GAS float*)A.in[I_ADAW]) + (size_t)l * D * 6144 + (size_t)(128 * kq + kk) * 6144 + e0 + 2 * j;
        const LAS float* tp = T + j * TP + 128 * kq + kk; const LAS float* t32 = T + 32 * TP + 128 * kq + kk;
        f32x16 acc0, acc1;
#pragma unroll
        for (int r = 0; r < 16; ++r) { acc0[r] = 0.f; acc1[r] = 0.f; }
        float c0 = 0.f, c1 = 0.f;
#pragma unroll 1
        for (int bt = 0; bt < 8; ++bt) { f32x2 wb[8];
#pragma unroll
            for (int u = 0; u < 8; ++u) wb[u] = *(const GAS f32x2*)(wp + (size_t)(2 * (8 * bt + u)) * 6144);
#pragma unroll
            for (int u = 0; u < 8; ++u) { const int s2 = 8 * bt + u; const float a = tp[2 * s2], tc = t32[2 * s2]; const f32x2 w = wb[u];
                acc0 = __builtin_amdgcn_mfma_f32_32x32x2f32(a, w.x, acc0, 0, 0, 0);
                acc1 = __builtin_amdgcn_mfma_f32_32x32x2f32(a, w.y, acc1, 0, 0, 0);
                c0 += tc * w.x; c1 += tc * w.y; }
        }
        c0 += __shfl_xor(c0, 32); c1 += __shfl_xor(c1, 32);
        __syncthreads();
        LAS float* R = (LAS float*)F.lds;
#pragma unroll
        for (int r = 0; r < 16; ++r) { const int i = 8 * (r >> 2) + 4 * kk + (r & 3); R[(kq * 33 + i) * 64 + 2 * j] = acc0[r]; R[(kq * 33 + i) * 64 + 2 * j + 1] = acc1[r]; }
        if (kk == 0) { R[(kq * 33 + 32) * 64 + 2 * j] = c0; R[(kq * 33 + 32) * 64 + 2 * j + 1] = c1; }
        __syncthreads();
        for (int i = F.tid; i < 33 * 64; i += NTHR) { const int b = i >> 6, c = i & 63; float sm = 0.f;
#pragma unroll
            for (int q = 0; q < 8; ++q) sm += R[(q * 33 + b) * 64 + c];
            ((GAS float*)(ws + WS_MOD))[((size_t)l * 33 + b) * 6144 + e0 + c] = sm + ((const GAS float*)A.in[I_ADAB])[l * 6144 + e0 + c]; }
        __syncthreads();
    }
}

DI void win_to_i8(const Frame& F0, const Args& A) {
    const Frame F = fresh(F0);
    LAS float* scr = (LAS float*)(F.lds + F.wave * 16384);
    for (int it = F.gw; it < 2 * 16 * 160; it += F.NGW) { const int l = it / 2560;
        tr_item_i8(((const GAS float*)A.in[I_WIN]) + (size_t)l * D * INC, D, INC, F.ws + WS_WIN + (size_t)l * INC * D, D, (const GAS float*)(F.ws + WS_CTL) + CW_CMAX_IN + l * INC, scr, it % 2560, F.lane); }
    for (int it = F.gw; it < 2 * 16 * 88; it += F.NGW) { const int w = it / 1408;
        tr_item_i8((const GAS float*)A.in[w ? I_FU : I_FG], D, DFF, F.ws + WS_WGU, D, (const GAS float*)(F.ws + WS_CTL) + (w ? CW_CMAX_FU : CW_CMAX_FG), scr, it % 1408, F.lane, w ? 128 : 0, 128, 256); }
}
constexpr int MOE_CONV_ITEMS = NE * (2 * 16 * 112 + 56 * 32), MOE_C1 = 16000, MOE_C2 = 8000;
DI void moe_weight_convert(const Frame& F0, const Args& A, int it0, int it1, int wg0) {
    const Frame F = fresh(F0);
    if ((int)blockIdx.x < wg0) return;
    LAS float* scr = (LAS float*)(F.lds + F.wave * 16384);
    constexpr int IT_G = 16 * 112, IT_D = 56 * 32, PER_E = 2 * IT_G + IT_D;
    for (int it = it0 + ((int)blockIdx.x - wg0) * NWAVES + F.wave; it < it1; it += (F.G - wg0) * NWAVES) {
        const int e = it / PER_E; int r = it % PER_E;
        GAS unsigned char* gu = F.ws + WS_MGU + (size_t)e * 2 * DEX * D;
        if (r < IT_G) { tr_item8(((const GAS float*)A.in[I_MG]) + (size_t)e * D * DEX, D, DEX, gu, D, 0, 128, 256, 32.f, scr, r, F.lane); continue; } r -= IT_G;
        if (r < IT_G) { tr_item8(((const GAS float*)A.in[I_MU]) + (size_t)e * D * DEX, D, DEX, gu, D, 128, 128, 256, 32.f, scr, r, F.lane); continue; } r -= IT_G;
        tr_item8(((const GAS float*)A.in[I_MD]) + (size_t)e * DEX * D, DEX, D, F.ws + WS_MD + (size_t)e * D * DEX, DEX, 0, 1 << 30, 0, 64.f, scr, r, F.lane);
    }
}

struct RowVecs { f32x4 a1[4], a2[4], a3[4]; };
DI void load_rowvecs(RowVecs& V, const GAS float* gatev, const GAS float* postg, const GAS float* preg, const GAS float* sc, const GAS float* sh, int lane) {
#pragma unroll
    for (int j = 0; j < 4; ++j) { const int e = 4 * lane + 256 * j;
        if (gatev) { const f32x4 g = *(const GAS f32x4*)(gatev + e), p = *(const GAS f32x4*)(postg + e); V.a1[j] = g * p; } else V.a1[j] = (f32x4){0.f, 0.f, 0.f, 0.f};
        if (preg) { const f32x4 p = *(const GAS f32x4*)(preg + e), s = *(const GAS f32x4*)(sc + e); V.a2[j] = p * (s + 1.0f); V.a3[j] = *(const GAS f32x4*)(sh + e); }
        else { V.a2[j] = (f32x4){0.f, 0.f, 0.f, 0.f}; V.a3[j] = V.a2[j]; } }
}
struct RowData { f32x4 x[4]; v2u y[4]; };
DI GAS bf16* xb_row(GAS float* out, int r) { return (GAS bf16*)(out + (size_t)r * D) + D; }
DI void row_load(RowData& R, const GAS float* xin, const GAS bf16* xinb, const GAS bf16* y, int lane) {
    if (xinb) {
#pragma unroll
        for (int j = 0; j < 4; ++j) { const v2u w = *(const GAS v2u*)(xinb + 4 * lane + 256 * j); R.x[j] = (f32x4){bflo(w.x), bfhi(w.x), bflo(w.y), bfhi(w.y)}; }
    } else {
#pragma unroll
        for (int j = 0; j < 4; ++j) R.x[j] = *(const GAS f32x4*)(xin + 4 * lane + 256 * j);
    }
    if (y) {
#pragma unroll
        for (int j = 0; j < 4; ++j) R.y[j] = *(const GAS v2u*)(y + 4 * lane + 256 * j);
    }
}
DI void row_compute(const RowData& R, bool hasy, GAS float* xout, GAS bf16* xoutb, GAS bf16* hout, const RowVecs& V, int lane, f32x4 (&hv)[4], GAS unsigned char* hout8 = nullptr, GAS unsigned char* hout_i8 = nullptr, GAS float* rs_out = nullptr) {
    f32x4 v[4];
#pragma unroll
    for (int j = 0; j < 4; ++j) v[j] = R.x[j];
    if (hasy) {
        f32x4 yv[4]; float ss = 0.f;
#pragma unroll
        for (int j = 0; j < 4; ++j) { const v2u w = R.y[j]; yv[j] = (f32x4){bflo(w.x), bfhi(w.x), bflo(w.y), bfhi(w.y)};
            ss += (yv[j].x * yv[j].x + yv[j].y * yv[j].y) + (yv[j].z * yv[j].z + yv[j].w * yv[j].w); }
        const float r = 1.0f / sqrtf(wave_sum(ss) * (1.0f / D) + EPS);
#pragma unroll
        for (int j = 0; j < 4; ++j) v[j] += V.a1[j] * (yv[j] * r);
    }
    if (xout) {
#pragma unroll
        for (int j = 0; j < 4; ++j) *(GAS f32x4*)(xout + 4 * lane + 256 * j) = v[j];
    }
    if (xoutb) {
#pragma unroll
        for (int j = 0; j < 4; ++j) { v2u w; w.x = pk2(v[j].x, v[j].y); w.y = pk2(v[j].z, v[j].w); *(GAS v2u*)(xoutb + 4 * lane + 256 * j) = w; }
    }
    if (hout || hout8 || hout_i8) {
        float ss = 0.f;
#pragma unroll
        for (int j = 0; j < 4; ++j) ss += (v[j].x * v[j].x + v[j].y * v[j].y) + (v[j].z * v[j].z + v[j].w * v[j].w);
        const float r = 1.0f / sqrtf(wave_sum(ss) * (1.0f / D) + EPS);
#pragma unroll
        for (int j = 0; j < 4; ++j) hv[j] = (v[j] * r) * V.a2[j] + V.a3[j];
        if (hout_i8) {
            float m = 0.f;
#pragma unroll
            for (int j = 0; j < 4; ++j) m = fmaxf(m, fmaxf(fmaxf(fabsf(hv[j].x), fabsf(hv[j].y)), fmaxf(fabsf(hv[j].z), fabsf(hv[j].w))));
            m = fmaxf(wave_max(m), 1e-30f); const float isc = 127.0f / m;
#pragma unroll
            for (int j = 0; j < 4; ++j) *(GAS unsigned*)(hout_i8 + 4 * lane + 256 * j) = pk4_i8(hv[j].x * isc, hv[j].y * isc, hv[j].z * isc, hv[j].w * isc);
            if (lane == 0) *rs_out = m * (1.0f / 127.0f);
        } else
#pragma unroll
        for (int j = 0; j < 4; ++j) {
            if (hout8) *(GAS unsigned*)(hout8 + 4 * lane + 256 * j) = pk4_fp8(hv[j].x, hv[j].y, hv[j].z, hv[j].w);
            else { v2u w; w.x = pk2(hv[j].x, hv[j].y); w.y = pk2(hv[j].z, hv[j].w); *(GAS v2u*)(hout + 4 * lane + 256 * j) = w; } }
    }
}
DI const GAS float* modp(const Frame& F, int l, int bb, int which) { return (const GAS float*)(F.ws + WS_MOD) + ((size_t)l * 33 + bb) * 6144 + which * 1024; }

DI void route_row(const Frame& F, const LAS float* RT, LAS unsigned* lcount, const f32x4 (&hv)[4], int r) {
                float lg[8];
#pragma unroll
                for (int e = 0; e < 8; ++e) lg[e] = 0.f;
#pragma unroll
                for (int j = 0; j < 4; ++j)
#pragma unroll
                    for (int i = 0; i < 4; ++i) { const LAS float* rp = RT + (4 * F.lane + 256 * j + i) * 8; const f32x4 ra = *(const LAS f32x4*)rp, rb = *(const LAS f32x4*)(rp + 4); const float hx = hv[j][i];
                        lg[0] += hx * ra.x; lg[1] += hx * ra.y; lg[2] += hx * ra.z; lg[3] += hx * ra.w; lg[4] += hx * rb.x; lg[5] += hx * rb.y; lg[6] += hx * rb.z; lg[7] += hx * rb.w; }
#pragma unroll
                for (int e = 0; e < 8; ++e) lg[e] = wave_sum(lg[e]);
                int e0 = 0; float v0 = lg[0];
#pragma unroll
                for (int e = 1; e < 8; ++e) if (lg[e] > v0) { v0 = lg[e]; e0 = e; }
                int e1 = -1; float v1 = -3.0e38f;
#pragma unroll
                for (int e = 0; e < 8; ++e) if (e != e0 && lg[e] > v1) { v1 = lg[e]; e1 = e; }
                if (F.lane == 0) {
                    const float p1 = 1.0f / (1.0f + expf(v0 - v1)), p0 = 1.0f - p1;
                    const int sl = slice_of(r);
                    const unsigned k0 = __hip_atomic_fetch_add(lcount + sl * 8 + e0, 1u, __ATOMIC_RELAXED, __HIP_MEMORY_SCOPE_WORKGROUP), k1 = __hip_atomic_fetch_add(lcount + sl * 8 + e1, 1u, __ATOMIC_RELAXED, __HIP_MEMORY_SCOPE_WORKGROUP);
                    ((GAS i32x2*)(F.ws + WS_RTOP))[r] = (i32x2){e0, e1};
                    ((GAS f32x2*)(F.ws + WS_RPROB))[r] = (f32x2){p0, p1};
                    ((GAS i32x2*)(F.ws + WS_RRANK))[r] = (i32x2){(int)k0, (int)k1};
                }
}
template <int MODE>
DI void rows_phase(const Frame& F0, const Args& A, int l, bool dry = false) {
    const Frame F = fresh(F0);
    GAS bf16* H = (GAS bf16*)(F.ws + WS_H); GAS bf16* CX = (GAS bf16*)(F.ws + WS_CX);
    const bool route = (MODE == 1 && l == 1) && (!dry || F.never);
    const bool st = !dry || F.never;
    LAS unsigned* lcount = (LAS unsigned*)(F.lds + 64);
    LAS unsigned* lbase = (LAS unsigned*)(F.lds + 256);
    LAS float* RT = (LAS float*)(F.lds + 1024);
    if (route) {
        if (F.tid < 32) lcount[F.tid] = 0u;
        for (int i = F.tid; i < 1024 * 8; i += NTHR) RT[i] = ((const GAS float*)A.in[I_ROUTER])[i];
        __syncthreads();
    }
    RowVecs V; f32x4 hv[4];
    for (int r0 = F.gw * 32; r0 < NX; r0 += F.NGW * 32) {
        const int b = r0 >> 11;
        if (MODE == 0) load_rowvecs(V, nullptr, nullptr, ((const GAS float*)A.in[I_MIXPRE]), modp(F, 0, b, 1), modp(F, 0, b, 0), F.lane);
        if (MODE == 1) load_rowvecs(V, modp(F, l, b, 2), ((const GAS float*)A.in[I_MIXPOST]) + l * D, ((const GAS float*)A.in[I_FFNPRE]) + l * D, modp(F, l, b, 4), modp(F, l, b, 3), F.lane);
        if (MODE == 2) load_rowvecs(V, modp(F, 0, b, 5), ((const GAS float*)A.in[I_FFNPOST]), ((const GAS float*)A.in[I_MIXPRE]) + D, modp(F, 1, b, 1), modp(F, 1, b, 0), F.lane);
        const bool toi = (MODE == 0 || MODE == 2 || (MODE == 1 && l == 0)); GAS float* RS = (GAS float*)(F.ws + WS_RS);
        const bool to8 = (MODE == 1 && l == 1); GAS unsigned char* H8 = F.ws + WS_H8;
        const bool xf32 = (MODE == 0 || (MODE == 1 && l == 0));
        const GAS float* xbase = (const GAS float*)A.in[I_X];
#define XIN_F(r) (xf32 ? xbase + (size_t)(r) * D : (const GAS float*)nullptr)
#define XIN_B(r) (xf32 ? (const GAS bf16*)nullptr : (const GAS bf16*)xb_row(F.out, (r)))
        RowData Ra, Rb;
        row_load(Ra, XIN_F(r0), XIN_B(r0), MODE == 0 ? nullptr : H + (size_t)r0 * D, F.lane);
        for (int r = r0; r < r0 + 32; r += 2) {
            row_load(Rb, XIN_F(r + 1), XIN_B(r + 1), MODE == 0 ? nullptr : H + (size_t)(r + 1) * D, F.lane);
            row_compute(Ra, MODE != 0, nullptr, (MODE == 0 || !st) ? nullptr : xb_row(F.out, r), (st && !to8 && !toi) ? H + (size_t)r * D : nullptr, V, F.lane, hv, (st && to8) ? H8 + (size_t)r * D : nullptr, (st && toi) ? (GAS unsigned char*)(H + (size_t)r * D) : nullptr, RS + r);
            if (route) route_row(F, RT, lcount, hv, r);
            if (r + 2 < r0 + 32) row_load(Ra, XIN_F(r + 2), XIN_B(r + 2), MODE == 0 ? nullptr : H + (size_t)(r + 2) * D, F.lane);
            row_compute(Rb, MODE != 0, nullptr, (MODE == 0 || !st) ? nullptr : xb_row(F.out, r + 1), (st && !to8 && !toi) ? H + (size_t)(r + 1) * D : nullptr, V, F.lane, hv, (st && to8) ? H8 + (size_t)(r + 1) * D : nullptr, (st && toi) ? (GAS unsigned char*)(H + (size_t)(r + 1) * D) : nullptr, RS + r + 1);
            if (route) route_row(F, RT, lcount, hv, r + 1);
        }
#undef XIN_F
#undef XIN_B
    }
    if (route) {
        __syncthreads();
        if (F.tid < 32) lbase[F.tid] = __hip_atomic_fetch_add((GAS unsigned*)(F.ws + WS_CTL) + CW_GCOUNT + 64 * F.tid, lcount[F.tid], __ATOMIC_RELAXED, __HIP_MEMORY_SCOPE_AGENT);
        __syncthreads();
        VM_WAIT();
        if (F.lane < 32) {
            for (int r0 = F.gw * 32; r0 < NX; r0 += F.NGW * 32) { const int r = r0 + F.lane; const int sl = slice_of(r); const i32x2 t = ((GAS i32x2*)(F.ws + WS_RTOP))[r]; i32x2 k = ((GAS i32x2*)(F.ws + WS_RRANK))[r];
                    k.x += (int)lbase[sl * 8 + t.x]; k.y += (int)lbase[sl * 8 + t.y]; ((GAS i32x2*)(F.ws + WS_RRANK))[r] = k; }
        }
    }
    if (MODE == 0 || MODE == 2 || (MODE == 1 && l == 0)) {
        if (MODE == 0) load_rowvecs(V, nullptr, nullptr, ((const GAS float*)A.in[I_MIXPRE]), modp(F, 0, 32, 1), modp(F, 0, 32, 0), F.lane);
        if (MODE == 1) load_rowvecs(V, modp(F, 0, 32, 2), ((const GAS float*)A.in[I_MIXPOST]), ((const GAS float*)A.in[I_FFNPRE]), modp(F, 0, 32, 4), modp(F, 0, 32, 3), F.lane);
        if (MODE == 2) load_rowvecs(V, modp(F, 0, 32, 5), ((const GAS float*)A.in[I_FFNPOST]), ((const GAS float*)A.in[I_MIXPRE]) + D, modp(F, 1, 32, 1), modp(F, 1, 32, 0), F.lane);
        const GAS float* cbase = (const GAS float*)A.in[I_CTX];
        for (int r0 = F.gw * 4; r0 < NC; r0 += F.NGW * 4) {
            RowData Rd[4];
#pragma unroll
            for (int i = 0; i < 4; ++i) row_load(Rd[i], cbase + (size_t)(r0 + i) * D, MODE == 2 ? (const GAS bf16*)CX + (size_t)(r0 + i) * D : (const GAS bf16*)nullptr, MODE == 0 ? nullptr : H + (size_t)(NX + r0 + i) * D, F.lane);
#pragma unroll
            for (int i = 0; i < 4; ++i) { const int r = r0 + i;
                row_compute(Rd[i], MODE != 0, nullptr, (MODE == 1 && st) ? CX + (size_t)r * D : nullptr, nullptr, V, F.lane, hv, nullptr,
                            st ? (GAS unsigned char*)(H + (size_t)(NX + r) * D) : nullptr, (GAS float*)(F.ws + WS_RS) + NX + r); }
        }
    }
}

constexpr int SC_CUM = 0, SC_TOT = 32768, SC_VT = 34816, SC_QM = 53248, SC_KM = 70656, SC_QD = 70656, SC_KDT = 88064, SC_AL = 114176, SC_ST = 123392, SC_DEC = 158208, SC_END = 158720;
constexpr int PQ = 272, PV = 144;
static_assert(SC_KDT + 128 * PV <= SC_AL && SC_QD + 64 * PQ <= SC_KDT && SC_KM + 160 * PQ <= SC_AL && SC_AL + 64 * PV <= SC_ST && SC_ST + 128 * PQ <= SC_DEC, "scan LDS map");
DI int scan_row(int b, int dir, int s) { return s < CTX ? NX + b * CTX + (dir ? CTX - 1 - s : s) : b * SEQ + (dir ? SEQ - 1 - (s - CTX) : (s - CTX)); }
DI float ex2(float x) { return __builtin_amdgcn_exp2f(x); }
DI void unpack8(const v4u w, float (&o)[8]) { o[0] = bflo(w.x); o[1] = bfhi(w.x); o[2] = bflo(w.y); o[3] = bfhi(w.y); o[4] = bflo(w.z); o[5] = bfhi(w.z); o[6] = bflo(w.w); o[7] = bfhi(w.w); }
DI v4u pack8(const float (&o)[8]) { v4u w; w.x = pk2(o[0], o[1]); w.y = pk2(o[2], o[3]); w.z = pk2(o[4], o[5]); w.w = pk2(o[6], o[7]); return w; }
DI void scan_phase(const Frame& F0, const Args& A, int l, bool dostore) {
    const Frame F = fresh(F0);
    (void)A;
    GAS bf16* P = (GAS bf16*)(F.ws + WS_P);
    LAS unsigned char* L = F.lds;
    const int tid = F.tid, lane = F.lane, w = F.wave, r = lane & 15, q4 = lane >> 4;
    const float L2E = 1.4426950408889634f;
    for (int ch = blockIdx.x; ch < 256; ch += F.G) {
        const int b = ch >> 3, h = (ch >> 1) & 3, dir = ch & 1;
        const int colq = C_Q + h * DK, colf = C_FF + dir * DH + h * DK, colv = C_V + h * DK;
        __syncthreads();
        for (int i = tid; i < (SC_DEC - SC_AL) / 16; i += NTHR) *(LAS v4u*)(L + SC_AL + 16 * i) = (v4u){0u, 0u, 0u, 0u};
        f32x4 accS[8];
#pragma unroll
        for (int t = 0; t < 8; ++t) accS[t] = (f32x4){0.f, 0.f, 0.f, 0.f};
        v4u qreg[2], lfreg[2]; unsigned vreg[8];
#pragma unroll
        for (int pi = 0; pi < 2; ++pi) { const int i = (tid >> 4) + 32 * pi, k0 = 8 * (tid & 15); const GAS bf16* rp = P + (size_t)scan_row(b, dir, i) * INC + k0;
            qreg[pi] = *(const GAS v4u*)(rp + colq); lfreg[pi] = *(const GAS v4u*)(rp + colf); }
#pragma unroll
        for (int e = 0; e < 8; ++e) vreg[e] = *(const GAS unsigned*)(P + (size_t)scan_row(b, dir, 8 * w + e) * INC + colv + 2 * lane);
        __syncthreads();
#pragma unroll 1
        for (int c = 0; c < (CTX + SEQ) / 64; ++c) {
            float qf[2][8], kk[2][8];
#pragma unroll
            for (int pi = 0; pi < 2; ++pi) { const int i = (tid >> 4) + 32 * pi, k0 = 8 * (tid & 15);
                float lf[8]; unpack8(lfreg[pi], lf); unpack8(qreg[pi], qf[pi]);
#pragma unroll
                for (int e = 0; e < 8; ++e) { lf[e] *= L2E; kk[pi][e] = 1.0f - ex2(lf[e]); }
                *(LAS f32x4*)(L + SC_CUM + (i * 128 + k0) * 4) = (f32x4){lf[0], lf[1], lf[2], lf[3]};
                *(LAS f32x4*)(L + SC_CUM + (i * 128 + k0) * 4 + 16) = (f32x4){lf[4], lf[5], lf[6], lf[7]}; }
            { v4u lo, hi;
              lo.x = (vreg[0] & 0xffffu) | (vreg[1] << 16); lo.y = (vreg[2] & 0xffffu) | (vreg[3] << 16); lo.z = (vreg[4] & 0xffffu) | (vreg[5] << 16); lo.w = (vreg[6] & 0xffffu) | (vreg[7] << 16);
              hi.x = (vreg[0] >> 16) | (vreg[1] & 0xffff0000u); hi.y = (vreg[2] >> 16) | (vreg[3] & 0xffff0000u); hi.z = (vreg[4] >> 16) | (vreg[5] & 0xffff0000u); hi.w = (vreg[6] >> 16) | (vreg[7] & 0xffff0000u);
              *(LAS v4u*)(L + SC_VT + (2 * lane) * PV + 16 * w) = lo; *(LAS v4u*)(L + SC_VT + (2 * lane + 1) * PV + 16 * w) = hi; }
            __syncthreads();
            { const int k = tid & 127, qd = tid >> 7; float run = 0.f;
#pragma unroll
              for (int s2 = 0; s2 < 16; ++s2) { LAS float* cp = (LAS float*)(L + SC_CUM) + (16 * qd + s2) * 128 + k; run += *cp; *cp = run; }
              ((LAS float*)(L + SC_TOT))[qd * 128 + k] = run; }
            __syncthreads();
            { const int k = tid & 127, I = tid >> 7; const LAS float* tp = (const LAS float*)(L + SC_TOT) + k; const LAS float* cm = (const LAS float*)(L + SC_CUM) + 7 * 128 + k;
              const float t0 = tp[0], t1 = tp[128], t2 = tp[256], t3 = tp[384];
              const float p1 = t0, p2 = t0 + t1, p3 = p2 + t2, tt = p3 + t3;
              const float R0 = cm[0], R1 = cm[16 * 128] + p1, R2 = cm[32 * 128] + p2, R3 = cm[48 * 128] + p3;
              const float RI = (I == 0) ? R0 : (I == 1) ? R1 : (I == 2) ? R2 : R3;
              LAS float* QF = (LAS float*)(L + SC_AL); LAS float* FT = QF + 512;
              QF[I * 128 + k] = ex2(RI);
              if (I == 0) { FT[0 * 128 + k] = ex2(R1 - R0); FT[1 * 128 + k] = ex2(R2 - R0); FT[3 * 128 + k] = ex2(R3 - R0); }
              if (I == 1) { FT[2 * 128 + k] = ex2(R2 - R1); FT[4 * 128 + k] = ex2(R3 - R1); }
              if (I == 2) { FT[5 * 128 + k] = ex2(R3 - R2); }
              if (I == 3) ((LAS float*)(L + SC_DEC))[k] = ex2(tt); }
            __syncthreads();
            v4u qdreg[2];
#pragma unroll
            for (int pi = 0; pi < 2; ++pi) { const int i = (tid >> 4) + 32 * pi, k0 = 8 * (tid & 15), I = i >> 4;
                float cl[8], cmid[8], qm[8], km[8], o8[8];
                { const f32x4 a = *(const LAS f32x4*)(L + SC_CUM + (i * 128 + k0) * 4), bq = *(const LAS f32x4*)(L + SC_CUM + (i * 128 + k0) * 4 + 16);
                  cl[0] = a.x; cl[1] = a.y; cl[2] = a.z; cl[3] = a.w; cl[4] = bq.x; cl[5] = bq.y; cl[6] = bq.z; cl[7] = bq.w; }
                { const f32x4 a = *(const LAS f32x4*)(L + SC_CUM + ((16 * I + 7) * 128 + k0) * 4), bq = *(const LAS f32x4*)(L + SC_CUM + ((16 * I + 7) * 128 + k0) * 4 + 16);
                  cmid[0] = a.x; cmid[1] = a.y; cmid[2] = a.z; cmid[3] = a.w; cmid[4] = bq.x; cmid[5] = bq.y; cmid[6] = bq.z; cmid[7] = bq.w; }
#pragma unroll
                for (int e = 0; e < 8; ++e) { const float dlt = cl[e] - cmid[e]; qm[e] = qf[pi][e] * ex2(fminf(dlt, 86.f)); km[e] = kk[pi][e] * ex2(fminf(-dlt, 86.f)); }
                *(LAS v4u*)(L + SC_QM + i * PQ + 2 * k0) = pack8(qm);
                *(LAS v4u*)(L + SC_KM + (8 * I * (I + 1) + i) * PQ + 2 * k0) = pack8(km);
                { const f32x4 a = *(const LAS f32x4*)(L + SC_AL + (I * 128 + k0) * 4), bq = *(const LAS f32x4*)(L + SC_AL + (I * 128 + k0) * 4 + 16);
                  o8[0] = qm[0] * a.x; o8[1] = qm[1] * a.y; o8[2] = qm[2] * a.z; o8[3] = qm[3] * a.w; o8[4] = qm[4] * bq.x; o8[5] = qm[5] * bq.y; o8[6] = qm[6] * bq.z; o8[7] = qm[7] * bq.w; }
                qdreg[pi] = pack8(o8);
#pragma unroll
                for (int Ip = 1; Ip < 4; ++Ip) if (Ip > I) { const int pr = Ip * (Ip - 1) / 2 + I;
                    const f32x4 a = *(const LAS f32x4*)(L + SC_AL + 2048 + (pr * 128 + k0) * 4), bq = *(const LAS f32x4*)(L + SC_AL + 2048 + (pr * 128 + k0) * 4 + 16);
                    o8[0] = km[0] * a.x; o8[1] = km[1] * a.y; o8[2] = km[2] * a.z; o8[3] = km[3] * a.w; o8[4] = km[4] * bq.x; o8[5] = km[5] * bq.y; o8[6] = km[6] * bq.z; o8[7] = km[7] * bq.w;
                    *(LAS v4u*)(L + SC_KM + (8 * Ip * (Ip + 1) + i) * PQ + 2 * k0) = pack8(o8); } }
            __syncthreads();
            if (c + 1 < (CTX + SEQ) / 64) {
#pragma unroll
                for (int pi = 0; pi < 2; ++pi) { const int i = (tid >> 4) + 32 * pi, k0 = 8 * (tid & 15); const GAS bf16* rp = P + (size_t)scan_row(b, dir, 64 * (c + 1) + i) * INC + k0;
                    qreg[pi] = *(const GAS v4u*)(rp + colq); lfreg[pi] = *(const GAS v4u*)(rp + colf); }
#pragma unroll
                for (int e = 0; e < 8; ++e) vreg[e] = *(const GAS unsigned*)(P + (size_t)scan_row(b, dir, 64 * (c + 1) + 8 * w + e) * INC + colv + 2 * lane);
            }
#pragma unroll 1
            for (int bl = w; bl < 10; bl += 8) {
                const int I = (bl >= 6) ? 3 : (bl >= 3) ? 2 : (bl >= 1) ? 1 : 0, J = bl - I * (I + 1) / 2;
                f32x4 acc = (f32x4){0.f, 0.f, 0.f, 0.f};
#pragma unroll
                for (int ks = 0; ks < 4; ++ks) { const bf16x8 a = *(const LAS bf16x8*)(L + SC_QM + (16 * I + r) * PQ + 64 * ks + 16 * q4);
                    const bf16x8 bb = *(const LAS bf16x8*)(L + SC_KM + (8 * I * (I + 1) + 16 * J + r) * PQ + 64 * ks + 16 * q4);
                    acc = __builtin_amdgcn_mfma_f32_16x16x32_bf16(a, bb, acc, 0, 0, 0); }
#pragma unroll
                for (int jj = 0; jj < 4; ++jj) { float x = acc[jj]; if (I == J && r > 4 * q4 + jj) x = 0.f;
                    *(LAS bf16*)(L + SC_AL + (16 * I + 4 * q4 + jj) * PV + 2 * (16 * J + r)) = (bf16)(pk2(x, 0.f) & 0xffffu); }
            }
            if (w == 2 || w == 3) { const int I = (w == 2) ? 0 : 2, J = I + 1;
#pragma unroll
                for (int jj = 0; jj < 4; ++jj) *(LAS bf16*)(L + SC_AL + (16 * I + 4 * q4 + jj) * PV + 2 * (16 * J + r)) = (bf16)0; }
            __syncthreads();
#pragma unroll
            for (int pi = 0; pi < 2; ++pi) { const int i = (tid >> 4) + 32 * pi, k0 = 8 * (tid & 15); *(LAS v4u*)(L + SC_QD + i * PQ + 2 * k0) = qdreg[pi]; }
            { const int k = tid & 127, qd = tid >> 7; const LAS float* tp = (const LAS float*)(L + SC_TOT) + k;
              const float t1 = tp[128], t2 = tp[256], t3 = tp[384];
              const float rest = (qd == 0) ? (t1 + t2) + t3 : (qd == 1) ? t2 + t3 : (qd == 2) ? t3 : 0.f;
              float cl[16], kd[16];
#pragma unroll
              for (int s2 = 0; s2 < 16; ++s2) cl[s2] = ((const LAS float*)(L + SC_CUM))[(16 * qd + s2) * 128 + k];
              float g = ex2(fminf(rest, 0.f));
#pragma unroll
              for (int s2 = 15; s2 >= 0; --s2) { const float f = ex2(cl[s2] - (s2 ? cl[s2 - 1] : 0.f)); kd[s2] = (1.0f - f) * g; g *= f; }
              v4u w0, w1; w0.x = pk2(kd[0], kd[1]); w0.y = pk2(kd[2], kd[3]); w0.z = pk2(kd[4], kd[5]); w0.w = pk2(kd[6], kd[7]);
              w1.x = pk2(kd[8], kd[9]); w1.y = pk2(kd[10], kd[11]); w1.z = pk2(kd[12], kd[13]); w1.w = pk2(kd[14], kd[15]);
              *(LAS v4u*)(L + SC_KDT + k * PV + 32 * qd) = w0; *(LAS v4u*)(L + SC_KDT + k * PV + 32 * qd + 16) = w1; }
            __syncthreads();
            { const int ip = w & 1, vp = w >> 1;
              f32x4 acc[2][2];
#pragma unroll
              for (int ii = 0; ii < 2; ++ii)
#pragma unroll
                  for (int tt = 0; tt < 2; ++tt) acc[ii][tt] = (f32x4){0.f, 0.f, 0.f, 0.f};
#pragma unroll
              for (int ks = 0; ks < 4; ++ks) { bf16x8 bq[2], a[2];
#pragma unroll
                  for (int ii = 0; ii < 2; ++ii) bq[ii] = *(const LAS bf16x8*)(L + SC_QD + (16 * (2 * ip + ii) + r) * PQ + 64 * ks + 16 * q4);
#pragma unroll
                  for (int tt = 0; tt < 2; ++tt) a[tt] = *(const LAS bf16x8*)(L + SC_ST + (16 * (2 * vp + tt) + r) * PQ + 64 * ks + 16 * q4);
#pragma unroll
                  for (int ii = 0; ii < 2; ++ii)
#pragma unroll
                      for (int tt = 0; tt < 2; ++tt) acc[ii][tt] = __builtin_amdgcn_mfma_f32_16x16x32_bf16(a[tt], bq[ii], acc[ii][tt], 0, 0, 0); }
#pragma unroll
              for (int js = 0; js < 2; ++js) if (js == 0 || ip == 1) { bf16x8 bA[2], a[2];
#pragma unroll
                  for (int ii = 0; ii < 2; ++ii) bA[ii] = *(const LAS bf16x8*)(L + SC_AL + (16 * (2 * ip + ii) + r) * PV + 64 * js + 16 * q4);
#pragma unroll
                  for (int tt = 0; tt < 2; ++tt) a[tt] = *(const LAS bf16x8*)(L + SC_VT + (16 * (2 * vp + tt) + r) * PV + 64 * js + 16 * q4);
#pragma unroll
                  for (int ii = 0; ii < 2; ++ii)
#pragma unroll
                      for (int tt = 0; tt < 2; ++tt) acc[ii][tt] = __builtin_amdgcn_mfma_f32_16x16x32_bf16(a[tt], bA[ii], acc[ii][tt], 0, 0, 0); }
              if (dostore && !(l == 1 && c < CTX / 64)) {
#pragma unroll
                  for (int ii = 0; ii < 2; ++ii) { GAS bf16* op = P + (size_t)scan_row(b, dir, 64 * c + 16 * (2 * ip + ii) + r) * INC + colf + 4 * q4;
#pragma unroll
                      for (int tt = 0; tt < 2; ++tt) { v2u o2; o2.x = pk2(acc[ii][tt][0], acc[ii][tt][1]); o2.y = pk2(acc[ii][tt][2], acc[ii][tt][3]); *(GAS v2u*)(op + 16 * (2 * vp + tt)) = o2; } }
              }
              const int kp = w >> 1, vh = w & 1;
#pragma unroll
              for (int kk = 0; kk < 2; ++kk) { const f32x4 dv = *(const LAS f32x4*)(L + SC_DEC + (16 * (2 * kp + kk) + 4 * q4) * 4);
#pragma unroll
                  for (int t4 = 0; t4 < 4; ++t4) accS[kk * 4 + t4] *= dv; }
#pragma unroll
              for (int js = 0; js < 2; ++js) { bf16x8 a[2], bv[4];
#pragma unroll
                  for (int kk = 0; kk < 2; ++kk) a[kk] = *(const LAS bf16x8*)(L + SC_KDT + (16 * (2 * kp + kk) + r) * PV + 64 * js + 16 * q4);
#pragma unroll
                  for (int t4 = 0; t4 < 4; ++t4) bv[t4] = *(const LAS bf16x8*)(L + SC_VT + (16 * (4 * vh + t4) + r) * PV + 64 * js + 16 * q4);
#pragma unroll
                  for (int kk = 0; kk < 2; ++kk)
#pragma unroll
                      for (int t4 = 0; t4 < 4; ++t4) accS[kk * 4 + t4] = __builtin_amdgcn_mfma_f32_16x16x32_bf16(a[kk], bv[t4], accS[kk * 4 + t4], 0, 0, 0); }
            }
            __syncthreads();
            { const int kp = w >> 1, vh = w & 1;
#pragma unroll
              for (int kk = 0; kk < 2; ++kk)
#pragma unroll
                  for (int t4 = 0; t4 < 4; ++t4) { const f32x4 sv = accS[kk * 4 + t4]; v2u s2; s2.x = pk2(sv[0], sv[1]); s2.y = pk2(sv[2], sv[3]);
                      *(LAS v2u*)(L + SC_ST + (16 * (4 * vh + t4) + r) * PQ + 2 * (16 * (2 * kp + kk) + 4 * q4)) = s2; } }
        }
    }
    __syncthreads();
}

DI void post_phase(const Frame& F0, const Args& A, int l, int part = 3, bool dry = false) {
    const Frame F = fresh(F0);
    GAS bf16* P = (GAS bf16*)(F.ws + WS_P);
    const int nrows = (l == 0) ? MALL : NX;
    if (part & 1) {
        const GAS float* gp = ((const GAS float*)A.in[I_GAIN]) + l * DH + 8 * F.lane;
        const f32x4 ga = *(const GAS f32x4*)gp, gb = *(const GAS f32x4*)(gp + 4);
        const float gn[8] = {ga.x, ga.y, ga.z, ga.w, gb.x, gb.y, gb.z, gb.w};
        v4u cur[6], nxt[6];
        if (F.gw < nrows) { const int r = F.gw; const bool two = (r + F.NGW) < nrows;
            const GAS bf16* q0 = P + (size_t)r * INC + 8 * F.lane; const GAS bf16* q1 = P + (size_t)(two ? r + F.NGW : r) * INC + 8 * F.lane;
            cur[0] = *(const GAS v4u*)(q0 + C_FF); cur[1] = *(const GAS v4u*)(q0 + C_FB); cur[2] = *(const GAS v4u*)(q0 + C_G);
            cur[3] = *(const GAS v4u*)(q1 + C_FF); cur[4] = *(const GAS v4u*)(q1 + C_FB); cur[5] = *(const GAS v4u*)(q1 + C_G); }
        for (int r = F.gw; r < nrows; r += 2 * F.NGW) {
            const bool two = (r + F.NGW) < nrows;
            GAS bf16* rp0 = P + (size_t)r * INC + 8 * F.lane; GAS bf16* rp1 = P + (size_t)(two ? r + F.NGW : r) * INC + 8 * F.lane;
            { const int rn = r + 2 * F.NGW;
              if (rn < nrows) { const bool twon = (rn + F.NGW) < nrows;
                  const GAS bf16* q0 = P + (size_t)rn * INC + 8 * F.lane; const GAS bf16* q1 = P + (size_t)(twon ? rn + F.NGW : rn) * INC + 8 * F.lane;
                  nxt[0] = *(const GAS v4u*)(q0 + C_FF); nxt[1] = *(const GAS v4u*)(q0 + C_FB); nxt[2] = *(const GAS v4u*)(q0 + C_G);
                  nxt[3] = *(const GAS v4u*)(q1 + C_FF); nxt[4] = *(const GAS v4u*)(q1 + C_FB); nxt[5] = *(const GAS v4u*)(q1 + C_G); } }
#pragma unroll
            for (int half = 0; half < 2; ++half) {
                if (half == 1 && !two) break;
                const v4u a = cur[3 * half], bq = cur[3 * half + 1], g = cur[3 * half + 2]; GAS bf16* rp = half ? rp1 : rp0;
                float o[8] = {bflo(a.x) + bflo(bq.x), bfhi(a.x) + bfhi(bq.x), bflo(a.y) + bflo(bq.y), bfhi(a.y) + bfhi(bq.y), bflo(a.z) + bflo(bq.z), bfhi(a.z) + bfhi(bq.z), bflo(a.w) + bflo(bq.w), bfhi(a.w) + bfhi(bq.w)};
                const float sg[8] = {bflo(g.x), bfhi(g.x), bflo(g.y), bfhi(g.y), bflo(g.z), bfhi(g.z), bflo(g.w), bfhi(g.w)};
                float ss = 0.f;
#pragma unroll
                for (int j = 0; j < 8; ++j) ss += o[j] * o[j];
                ss += __shfl_xor(ss, 1); ss += __shfl_xor(ss, 2); ss += __shfl_xor(ss, 4); ss += __shfl_xor(ss, 8);
                const float rr = 1.0f / sqrtf(ss * (1.0f / DK) + EPS);
#pragma unroll
                for (int j = 0; j < 8; ++j) o[j] = o[j] * rr * gn[j] * sg[j];
                v4u w; w.x = pk2(o[0], o[1]); w.y = pk2(o[2], o[3]); w.z = pk2(o[4], o[5]); w.w = pk2(o[6], o[7]);
                if (!dry || F.never) *(GAS v4u*)(rp + C_FF) = w;
            }
#pragma unroll
            for (int i = 0; i < 6; ++i) cur[i] = nxt[i];
        }
    }
    if (!(part & 2)) return;
    constexpr int PP = 520;
    LAS unsigned* U = (LAS unsigned*)F.lds;
    LAS unsigned* Vs = U + 32 * PP;
    v4u pre[8];
    { const int un = blockIdx.x;
      if (un < BATCH * 32) {
#pragma unroll
          for (int i = 0; i < 4; ++i) { const int t = F.tid + 512 * i; const GAS bf16* gp = P + (size_t)((un >> 5) * SEQ + t) * INC + C_U + (un & 31) * 16;
              pre[2 * i] = *(const GAS v4u*)gp; pre[2 * i + 1] = *(const GAS v4u*)(gp + 8); } } }
    REP(4) for (int un = blockIdx.x; un < BATCH * 32; un += F.G) {
        const int b = un >> 5, hx = un & 31, w = 2 << (hx >> 3), hw = w >> 1;
        __syncthreads();
#pragma unroll
        for (int i = 0; i < 4; ++i) { const int t = F.tid + 512 * i, gy = t >> 6, gx = t & 63;
            *(LAS v4u*)(U + gy * PP + gx * 8) = pre[2 * i]; *(LAS v4u*)(U + gy * PP + gx * 8 + 4) = pre[2 * i + 1]; }
        __syncthreads();
        { const int un2 = un + F.G;
          if (un2 < BATCH * 32) {
#pragma unroll
              for (int i = 0; i < 4; ++i) { const int t = F.tid + 512 * i; const GAS bf16* gp = P + (size_t)((un2 >> 5) * SEQ + t) * INC + C_U + (un2 & 31) * 16;
                  pre[2 * i] = *(const GAS v4u*)gp; pre[2 * i + 1] = *(const GAS v4u*)(gp + 8); } } }
        { float s0 = 0.f, s1 = 0.f;
          for (int y = 0; y < hw; ++y) { const unsigned u = U[y * PP + F.tid]; s0 += bflo(u); s1 += bfhi(u); }
#pragma unroll 4
          for (int gy = 0; gy < 32; ++gy) {
              Vs[gy * PP + F.tid] = pk2(s0, s1);
              if (gy + hw < 32) { const unsigned u = U[(gy + hw) * PP + F.tid]; s0 += bflo(u); s1 += bfhi(u); }
              if (gy - hw >= 0) { const unsigned u = U[(gy - hw) * PP + F.tid]; s0 -= bflo(u); s1 -= bfhi(u); }
          } }
        __syncthreads();
        { const int c4 = F.lane & 3, gy = (F.wave & 1) * 16 + (F.lane >> 2), x0 = (F.wave >> 1) * 16;
          const int cy = min(gy + hw, 32) - max(gy - hw, 0);
          const LAS unsigned* vr = Vs + gy * PP + c4 * 2; LAS unsigned* ur = U + gy * PP + c4 * 2;
          float s[4] = {0.f, 0.f, 0.f, 0.f};
          for (int x = max(x0 - hw, 0); x < min(x0 + hw, 64); ++x) { const v2u q = *(const LAS v2u*)(vr + x * 8); s[0] += bflo(q.x); s[1] += bfhi(q.x); s[2] += bflo(q.y); s[3] += bfhi(q.y); }
#pragma unroll 4
          for (int gx = x0; gx < x0 + 16; ++gx) {
              const int cx = min(gx + hw, 64) - max(gx - hw, 0);
              const float inv = __builtin_amdgcn_rcpf((float)(cy * cx));
              const v2u uc = *(const LAS v2u*)(ur + gx * 8);
              v2u o; o.x = pk2(s[0] * inv - bflo(uc.x), s[1] * inv - bfhi(uc.x)); o.y = pk2(s[2] * inv - bflo(uc.y), s[3] * inv - bfhi(uc.y));
              *(LAS v2u*)(ur + gx * 8) = o;
              if (gx + hw < 64) { const v2u q = *(const LAS v2u*)(vr + (gx + hw) * 8); s[0] += bflo(q.x); s[1] += bfhi(q.x); s[2] += bflo(q.y); s[3] += bfhi(q.y); }
              if (gx - hw >= 0) { const v2u q = *(const LAS v2u*)(vr + (gx - hw) * 8); s[0] -= bflo(q.x); s[1] -= bfhi(q.x); s[2] -= bflo(q.y); s[3] -= bfhi(q.y); }
          } }
        __syncthreads();
#pragma unroll
        for (int i = 0; i < 4; ++i) { const int t = F.tid + 512 * i, gy = t >> 6, gx = t & 63;
            const v4u q0 = *(const LAS v4u*)(U + gy * PP + gx * 8), q1 = *(const LAS v4u*)(U + gy * PP + gx * 8 + 4);
            GAS bf16* op = P + (size_t)(b * SEQ + t) * INC + C_Q + hx * 16;
            *(GAS v4u*)op = q0; *(GAS v4u*)(op + 8) = q1; }
    }
    __syncthreads();
    if (l == 0) { LAS unsigned char* Uc = F.lds;
        for (int un = blockIdx.x; un < BATCH * 32; un += F.G) {
            const int b = un >> 5, hx = un & 31, w = 2 << (hx >> 3), hw = w >> 1;
            __syncthreads();
            if (F.tid < CTX) { const GAS bf16* gp = P + (size_t)(NX + b * CTX + F.tid) * INC + C_U + hx * 16;
                const v4u q0 = *(const GAS v4u*)gp, q1 = *(const GAS v4u*)(gp + 8);
                *(LAS v4u*)(Uc + F.tid * 32) = q0; *(LAS v4u*)(Uc + F.tid * 32 + 16) = q1; }
            __syncthreads();
            if (F.tid < CTX) { const int t = F.tid, t0 = max(t - hw, 0), t1 = min(t - hw + w, CTX);
                float a[16];
#pragma unroll
                for (int j = 0; j < 16; ++j) a[j] = 0.f;
                for (int s2 = t0; s2 < t1; ++s2) { float v0[8], v1[8]; unpack8(*(const LAS v4u*)(Uc + s2 * 32), v0); unpack8(*(const LAS v4u*)(Uc + s2 * 32 + 16), v1);
#pragma unroll
                    for (int j = 0; j < 8; ++j) { a[j] += v0[j]; a[8 + j] += v1[j]; } }
                const float inv = 1.0f / (float)(t1 - t0);
                float u0[8], u1[8]; unpack8(*(const LAS v4u*)(Uc + t * 32), u0); unpack8(*(const LAS v4u*)(Uc + t * 32 + 16), u1);
                float lo[8], hi[8];
#pragma unroll
                for (int j = 0; j < 8; ++j) { lo[j] = a[j] * inv - u0[j]; hi[j] = a[8 + j] * inv - u1[j]; }
                GAS bf16* op = P + (size_t)(NX + b * CTX + t) * INC + C_Q + hx * 16;
                *(GAS v4u*)op = pack8(lo); *(GAS v4u*)(op + 8) = pack8(hi); }
        }
    }
    __syncthreads();
}

DI void slice_offsets(const Frame& F, int s, int (&toff)[9]) {
    const GAS unsigned* gc = (const GAS unsigned*)(F.ws + WS_CTL) + CW_GCOUNT;
    int acc = 0;
#pragma unroll
    for (int e = 0; e < 8; ++e) { toff[e] = acc; const unsigned c = __builtin_amdgcn_readfirstlane(__hip_atomic_load(gc + 64 * (s * 8 + e), __ATOMIC_RELAXED, __HIP_MEMORY_SCOPE_AGENT)); acc += (int)((c + 255u) >> 8); }
    toff[8] = acc < SLICE_ROWS / 256 ? acc : SLICE_ROWS / 256;
}
DI void gather_phase(const Frame& F0, const Args& A, int s) {
    const Frame F = fresh(F0);
    (void)A;
    int toff[9]; slice_offsets(F, s, toff);
    const GAS unsigned char* H8 = F.ws + WS_H8; GAS unsigned char* AS = F.ws + WS_AS; GAS float* RG = (GAS float*)(F.ws + WS_RGATE);
    const int rend = slice_start(s + 1);
    int r = slice_start(s) + F.gw;
    i32x2 t = {0, 0}, k = {0, 0}; v4u a = {0u, 0u, 0u, 0u};
    if (r < rend) { t = ((const GAS i32x2*)(F.ws + WS_RTOP))[r]; k = ((const GAS i32x2*)(F.ws + WS_RRANK))[r]; a = *(const GAS v4u*)(H8 + (size_t)r * D + 16 * F.lane); }
    for (; r < rend; r += F.NGW) {
        const int rn = r + F.NGW;
        i32x2 tn = t, kn = k; v4u an = a;
        if (rn < rend) { tn = ((const GAS i32x2*)(F.ws + WS_RTOP))[rn]; kn = ((const GAS i32x2*)(F.ws + WS_RRANK))[rn]; an = *(const GAS v4u*)(H8 + (size_t)rn * D + 16 * F.lane); }
        int p0 = k.x, p1 = k.y;
#pragma unroll
        for (int e = 0; e < 8; ++e) { if (t.x == e) p0 += toff[e] * 256; if (t.y == e) p1 += toff[e] * 256; }
        p0 = min(max(p0, 0), SLICE_ROWS - 1); p1 = min(max(p1, 0), SLICE_ROWS - 1);
        *(GAS v4u*)(AS + (size_t)p0 * D + 16 * F.lane) = a;
        *(GAS v4u*)(AS + (size_t)p1 * D + 16 * F.lane) = a;
        if (F.lane == 0) ((GAS i32x2*)(F.ws + WS_RPOS))[r] = (i32x2){p0, p1};
        t = tn; k = kn; a = an;
    }
    (void)RG;
}
DI void combine_phase(const Frame& F0, const Args& A, int s, bool dry = false) {
    const Frame F = fresh(F0);
    const GAS bf16* YS = (const GAS bf16*)(F.ws + WS_YS);
    RowVecs V; f32x4 hv[4];
    constexpr int CB = 4;
    for (int r0 = slice_start(s) + F.gw * CB; r0 < slice_start(s + 1); r0 += F.NGW * CB) {
        const int b = r0 >> 11;
        load_rowvecs(V, modp(F, 1, b, 5), ((const GAS float*)A.in[I_FFNPOST]) + D, nullptr, nullptr, nullptr, F.lane);
        i32x2 pp[CB]; f32x2 pr[CB];
#pragma unroll
        for (int k = 0; k < CB; ++k) { pp[k] = ((const GAS i32x2*)(F.ws + WS_RPOS))[r0 + k]; pr[k] = ((const GAS f32x2*)(F.ws + WS_RPROB))[r0 + k]; }
        v2u wa[4], wb[4], wx[4], na[4], nb[4], nx[4];
#pragma unroll
        for (int j = 0; j < 4; ++j) { wa[j] = *(const GAS v2u*)(YS + (size_t)pp[0].x * D + 4 * F.lane + 256 * j); wb[j] = *(const GAS v2u*)(YS + (size_t)pp[0].y * D + 4 * F.lane + 256 * j); wx[j] = *(const GAS v2u*)(xb_row(F.out, r0) + 4 * F.lane + 256 * j); }
#pragma unroll
        for (int k = 0; k < CB; ++k) { const int r = r0 + k;
            if (k < CB - 1) {
#pragma unroll
                for (int j = 0; j < 4; ++j) { na[j] = *(const GAS v2u*)(YS + (size_t)pp[k + 1 < CB ? k + 1 : CB - 1].x * D + 4 * F.lane + 256 * j); nb[j] = *(const GAS v2u*)(YS + (size_t)pp[k + 1 < CB ? k + 1 : CB - 1].y * D + 4 * F.lane + 256 * j); nx[j] = *(const GAS v2u*)(xb_row(F.out, r + 1) + 4 * F.lane + 256 * j); }
            }
            VM_WAIT();
            GAS float* xr = F.out + (size_t)r * D;
            f32x4 yv[4]; float ss = 0.f;
#pragma unroll
            for (int j = 0; j < 4; ++j) { const v2u w0 = wa[j], w1 = wb[j];
                yv[j] = (f32x4){bflo(w0.x) * pr[k].x + bflo(w1.x) * pr[k].y, bfhi(w0.x) * pr[k].x + bfhi(w1.x) * pr[k].y, bflo(w0.y) * pr[k].x + bflo(w1.y) * pr[k].y, bfhi(w0.y) * pr[k].x + bfhi(w1.y) * pr[k].y};
                ss += (yv[j].x * yv[j].x + yv[j].y * yv[j].y) + (yv[j].z * yv[j].z + yv[j].w * yv[j].w); }
            const float rr = 1.0f / sqrtf(wave_sum(ss) * (1.0f / D) + EPS);
#pragma unroll
            for (int j = 0; j < 4; ++j) { const v2u w = wx[j]; const f32x4 xv = (f32x4){bflo(w.x), bfhi(w.x), bflo(w.y), bfhi(w.y)};
                const f32x4 x = xv + V.a1[j] * (yv[j] * rr); if (!dry || F.never) *(GAS f32x4*)(xr + 4 * F.lane + 256 * j) = x; }
#pragma unroll
            for (int j = 0; j < 4; ++j) { wa[j] = na[j]; wb[j] = nb[j]; wx[j] = nx[j]; }
        }
    }
    (void)hv;
}

__global__ void __launch_bounds__(NTHR, 2) mk_fwd(Args args) {
    extern __shared__ __attribute__((aligned(16))) unsigned char lds_raw[];
    Frame F;
    F.lds = (LAS unsigned char*)lds_raw;
    F.tid = threadIdx.x; F.lane = F.tid & 63; F.wave = __builtin_amdgcn_readfirstlane(F.tid >> 6);
    F.G = gridDim.x; F.gw = blockIdx.x * NWAVES + F.wave; F.NGW = F.G * NWAVES; F.never = args.ph_lo < 0;
    F.out = (GAS float*)args.out; F.ws = (GAS unsigned char*)args.ws;
    volatile LAS unsigned* MISC = (volatile LAS unsigned*)(F.lds + MISC_OFF);
    if (F.tid < 16) MISC[F.tid] = 0u;
    __syncthreads();
    XcdBarrier bar; bar.bar = (unsigned*)(F.ws + WS_CTL) + CW_BAR; bar.x = 0; bar.st = nullptr;
    if (!MK_PER_PHASE) bar = xcd_barrier_post((unsigned*)(F.ws + WS_CTL) + CW_BAR, MISC + 8);
    const int lo = args.ph_lo, hi = args.ph_hi;
    int seq = 0;
#ifndef PHASE_MASK
#define PHASE_MASK 0xffff
#endif
#define EN(k) (((PHASE_MASK) >> (k)) & 1)
#define PH_ON() (lo <= seq && seq < hi)
#define PH_END() do { if (lo <= seq && seq + 1 < hi) { if (!MK_PER_PHASE) { xcd_barrier(bar); if (((DUP_MASK) >> 16) & 1) xcd_barrier(bar); } } ++seq; } while (0)
    LAS unsigned char* ring = F.lds;
#define SITE_PTRS() GAS unsigned char* ws = F.ws; asm volatile("" : "+s"(ws)); GAS bf16* P = (GAS bf16*)(ws + WS_P); GAS bf16* H = (GAS bf16*)(ws + WS_H); (void)P; (void)H

    if (PH_ON() && EN(0)) REP(0) p0_prologue(F, args);
    PH_END();
    if (PH_ON() && EN(1)) { REP(1) rows_phase<0>(F, args, 0); __syncthreads(); win_to_i8(F, args); }
    PH_END();
    for (int l = 0; l < 2; ++l) {
        const int nM = (l == 0) ? MALL / 256 : NX / 256;
        if (PH_ON() && EN(2)) { SITE_PTRS();
            pg8::Gemm g{H, (const GAS bf16*)(ws + WS_WIN + (size_t)l * INC * D), D, D / 2, D / 2};
            pg8::InSched S; S.G = F.G; S.c = (int)blockIdx.x; S.last = (l == 1);
            LAS float* cml = (LAS float*)(F.lds + 131072);
            { int t2 = F.tid; asm volatile("" : "+v"(t2)); const GAS float* cg = (const GAS float*)(ws + WS_CTL) + CW_CMAX_IN + l * INC; for (int i = t2; i < INC; i += NTHR) cml[i] = cg[i]; }
            __syncthreads();
            if (l == 0) { pg8::EpiIn<true> E{P, (const GAS float*)(ws + WS_LB), (const GAS float*)(ws + WS_RS), cml};
                REP(2) pg8::gemm_phase<pg8::EpiIn<true>, pg8::InSched, false, 127, true>(ring, g, S, E); }
            else { pg8::EpiIn<false> E{P, (const GAS float*)(ws + WS_LB) + 2 * DH, (const GAS float*)(ws + WS_RS), cml};
                REP(2) pg8::gemm_phase<pg8::EpiIn<false>, pg8::InSched, false, 127, true>(ring, g, S, E); }
            if (l == 0) moe_weight_convert(F, args, MOE_C1, MOE_C1 + MOE_C2, F.G / 2);
        }
        PH_END();
        if (PH_ON() && EN(3)) { if ((DUP_MASK >> 3) & 1) scan_phase(F, args, l, false); scan_phase(F, args, l, true); }
        PH_END();
        if (PH_ON() && EN(4)) { if ((DUP_MASK >> 17) & 1) post_phase(F, args, l, 1, true); post_phase(F, args, l); }
        PH_END();
        if (PH_ON() && EN(6)) { SITE_PTRS();
            { pg8::Gemm g{P + C_FF, (const GAS bf16*)(ws + WS_WR) + (size_t)l * D * DH, INC, DH, DH};
              pg8::StaticSched S; S.init(nM, D / 256, F.G, (int)blockIdx.x, 0);
              pg8::EpiRow<1> E{P + C_GA, INC, nullptr, 0};
              REP(6) pg8::gemm_phase(ring, g, S, E); }
            { pg8::Gemm g{P + C_Q, (const GAS bf16*)(ws + WS_WP) + (size_t)l * D * DH, INC, DH, DH};
              pg8::StaticSched S; S.init(nM, D / 256, F.G, (int)blockIdx.x, 0);
              pg8::EpiRow<2> E{P + C_GA, INC, nullptr, C_GB - C_GA};
              REP(6) pg8::gemm_phase(ring, g, S, E); }
        }
        PH_END();
        if (PH_ON() && EN(7)) { SITE_PTRS();
            pg8::Gemm g{P + C_GA, (const GAS bf16*)(ws + WS_WO) + (size_t)l * D * D, INC, D, D};
            pg8::StaticSched S; S.init(nM, D / 256, F.G, (int)blockIdx.x, 0);
            pg8::EpiRow<0> E{H, D, nullptr, 0};
            REP(7) pg8::gemm_phase(ring, g, S, E);
        }
        PH_END();
        if (PH_ON() && EN(8)) { if ((DUP_MASK >> 8) & 1) rows_phase<1>(F, args, l, true); rows_phase<1>(F, args, l); if (l == 1) { __syncthreads(); moe_weight_convert(F, args, MOE_C1 + MOE_C2, MOE_CONV_ITEMS, 0); } }
        PH_END();
        if (l == 0) {
            if (PH_ON() && EN(9)) { SITE_PTRS();
                pg8::Gemm g{H, (const GAS bf16*)(ws + WS_WGU), D, D / 2, D / 2};
                pg8::StaticSched S; S.init(MALL / 256, 2 * DFF / 256, F.G, (int)blockIdx.x, 0);
                LAS float* cmgl = (LAS float*)(F.lds + 131072); LAS float* cmul = cmgl + DFF;
                { int t2 = F.tid; asm volatile("" : "+v"(t2)); const GAS float* cg = (const GAS float*)(ws + WS_CTL) + CW_CMAX_FG; const GAS float* cu = (const GAS float*)(ws + WS_CTL) + CW_CMAX_FU;
                  for (int i = t2; i < DFF; i += NTHR) { cmgl[i] = cg[i]; cmul[i] = cu[i]; } }
                __syncthreads();
                pg8::EpiSwiGLU<true> E{(GAS bf16*)(ws + WS_HH0), DFF, nullptr, (const GAS float*)(ws + WS_RS), cmgl, cmul};
                REP(9) pg8::gemm_phase<pg8::EpiSwiGLU<true>, pg8::StaticSched, false, 127, true>(ring, g, S, E);
            }
            PH_END();
            if (PH_ON() && EN(10)) { SITE_PTRS();
                pg8::Gemm g{(const GAS bf16*)(ws + WS_HH0), (const GAS bf16*)(ws + WS_WD), DFF / 2, DFF / 2, DFF / 2};
                pg8::StaticSched S; S.init(MALL / 256, D / 256, F.G, (int)blockIdx.x, 0);
                pg8::EpiRow<0> E{H, D, nullptr, 0};
                REP(10) pg8::gemm_phase<pg8::EpiRow<0>, pg8::StaticSched, true, 121>(ring, g, S, E);
                moe_weight_convert(F, args, 0, MOE_C1, F.G / 2);
            }
            PH_END();
            if (PH_ON() && EN(11)) { if ((DUP_MASK >> 11) & 1) rows_phase<2>(F, args, 0, true); rows_phase<2>(F, args, 0); }
            PH_END();
        } else {
            if (PH_ON() && EN(12)) gather_phase(F, args, 0);
            PH_END();
            for (int s = 0; s < NSLICE; ++s) {
                if (PH_ON() && EN(13)) { SITE_PTRS();
                    pg8::MoeSched S; S.G = F.G; S.c = (int)blockIdx.x; S.nN = 2 * DEX / 256; S.nrow_e = 2 * DEX; slice_offsets(F, s, S.toff); S.nM = S.toff[8];
                    pg8::Gemm g{(const GAS bf16*)(ws + WS_AS), (const GAS bf16*)(ws + WS_MGU), D / 2, D / 2, D / 2};
                    pg8::EpiSwiGLU8 E{ws + WS_HHS, DEX, nullptr};
                    REP(13) pg8::gemm_phase<pg8::EpiSwiGLU8, pg8::MoeSched, true, 122>(ring, g, S, E);
                    if (s > 0) { if ((DUP_MASK >> 15) & 1) combine_phase(F, args, s - 1, true); combine_phase(F, args, s - 1); }
                }
                PH_END();
                if (PH_ON() && EN(14)) { SITE_PTRS();
                    pg8::MoeSched S; S.G = F.G; S.c = (int)blockIdx.x; S.nN = D / 256; S.nrow_e = D; slice_offsets(F, s, S.toff); S.nM = S.toff[8];
                    pg8::Gemm g{(const GAS bf16*)(ws + WS_HHS), (const GAS bf16*)(ws + WS_MD), DEX / 2, DEX / 2, DEX / 2};
                    pg8::EpiRow<0> E{(GAS bf16*)(ws + WS_YS), D, nullptr, 0};
                    REP(14) pg8::gemm_phase<pg8::EpiRow<0>, pg8::MoeSched, true, 121>(ring, g, S, E);
                    if (s + 1 < NSLICE) gather_phase(F, args, s + 1);
                }
                PH_END();
            }
            if (PH_ON() && EN(15)) { if ((DUP_MASK >> 15) & 1) combine_phase(F, args, NSLICE - 1, true); combine_phase(F, args, NSLICE - 1); }
            PH_END();
        }
    }
}
constexpr int N_PHASES = 2 + 6 + 3 + 6 + 1 + 2 * NSLICE + 1;

extern "C" void kernel_launch(void* const* d_in, const int* in_sizes, int n_in, void* d_out, int out_size, void* d_ws, size_t ws_size, hipStream_t stream) {
    static int grid = 0;
    if (grid == 0) {
        if (n_in != 25 || out_size != NX * D || ws_size < WS_END) { fprintf(stderr, "kernel_launch: unexpected problem (n_in %d, out %d, ws %zu < %zu)\n", n_in, out_size, ws_size, (size_t)WS_END); grid = -1; return; }
        int dev = 0, cus = 0, per_cu = 0;
        if (hipGetDevice(&dev) != hipSuccess || hipDeviceGetAttribute(&cus, hipDeviceAttributeMultiprocessorCount, dev) != hipSuccess) { grid = -1; return; }
        if (hipFuncSetAttribute((const void*)mk_fwd, hipFuncAttributeMaxDynamicSharedMemorySize, LDS_BYTES) != hipSuccess) { fprintf(stderr, "kernel_launch: hipFuncSetAttribute failed\n"); grid = -1; return; }
        if (hipOccupancyMaxActiveBlocksPerMultiprocessor(&per_cu, (const void*)mk_fwd, NTHR, LDS_BYTES) != hipSuccess || per_cu < 1) { fprintf(stderr, "kernel_launch: occupancy query says %d\n", per_cu); }
        (void)hipGetLastError();
        grid = cus;
    }
    if (grid < 0) return;
    (void)in_sizes;
    if (hipMemsetAsync((char*)d_ws + WS_CTL, 0, CTL_BYTES, stream) != hipSuccess) return;
    Args a{};
    for (int i = 0; i < 25; ++i) a.in[i] = (const float*)d_in[i];
    a.out = (float*)d_out; a.ws = (unsigned char*)d_ws;
#if MK_PER_PHASE
    for (int p = 0; p < N_PHASES; ++p) { a.ph_lo = p; a.ph_hi = p + 1; hipLaunchKernelGGL(mk_fwd, dim3(grid), dim3(NTHR), LDS_BYTES, stream, a); }
#else
    a.ph_lo = 0; a.ph_hi = N_PHASES;
    hipLaunchKernelGGL(mk_fwd, dim3(grid), dim3(NTHR), LDS_BYTES, stream, a);
#endif
}
```

```cpp
#include <hip/hip_runtime.h>
#include <cstdio>
#include <cstdint>

#ifndef MK_PER_PHASE
#define MK_PER_PHASE 0
#endif

#ifndef DUP_MASK
#define DUP_MASK 0
#endif
#define REP(k) for (int rep_ = 0; rep_ < 1 + (((DUP_MASK) >> (k)) & 1); ++rep_)
#define GAS __attribute__((address_space(1)))
#define LAS __attribute__((address_space(3)))
#define DI __device__ __forceinline__
typedef unsigned short bf16;
typedef unsigned v4u __attribute__((ext_vector_type(4)));
typedef unsigned v2u __attribute__((ext_vector_type(2)));
typedef float f32x4 __attribute__((ext_vector_type(4)));
typedef float f32x2 __attribute__((ext_vector_type(2)));
typedef float f32x16 __attribute__((ext_vector_type(16)));
typedef short bf16x8 __attribute__((ext_vector_type(8)));
typedef int i32x2 __attribute__((ext_vector_type(2)));

constexpr int D = 1024, BATCH = 32, SEQ = 2048, CTX = 256, GW = 64;
constexpr int NX = BATCH * SEQ, NC = BATCH * CTX, MALL = NX + NC;
constexpr int DH = 512, DK = 128, INC = 5120, DFF = 2816, NE = 8, DEX = 3584;
constexpr int C_Q = 0, C_FF = 512, C_FB = 1024, C_V = 1536, C_G = 2048, C_U = 2560, C_GA = 3072, C_GB = 4096;
constexpr float EPS = 1e-6f;
constexpr int NSLICE = 3, SL1 = 21848, SL2 = 43696, NGRP = NSLICE * NE;
constexpr int SLICE_ROWS = 45824;
DI int slice_of(int r) { return (r >= SL1 ? 1 : 0) + (r >= SL2 ? 1 : 0); }
DI int slice_start(int s) { return s == 0 ? 0 : s == 1 ? SL1 : s == 2 ? SL2 : NX; }
constexpr int NWAVES = 8, NTHR = 512;

constexpr size_t MiB = 1u << 20;
constexpr size_t al256(size_t x) { return (x + 255) & ~(size_t)255; }
constexpr size_t WS_CTL = 0, CTL_BYTES = 1 * MiB;
constexpr size_t WS_MOD = WS_CTL + CTL_BYTES;
constexpr size_t WS_LB = WS_MOD + al256((size_t)2 * 33 * 6144 * 4);
constexpr size_t WS_WIN = WS_LB + al256(2 * 2 * 512 * 4);
constexpr size_t WS_WR = WS_WIN + (size_t)2 * INC * D * 2;
constexpr size_t WS_WP = WS_WR + (size_t)2 * D * DH * 2;
constexpr size_t WS_WO = WS_WP + (size_t)2 * D * DH * 2;
constexpr size_t WS_WGU = WS_WO + (size_t)2 * D * D * 2;
constexpr size_t WS_WD = WS_WGU + (size_t)2 * DFF * D * 2;
constexpr size_t WS_H = WS_WD + (size_t)D * DFF * 2;
constexpr size_t WS_CX = WS_H + (size_t)MALL * D * 2;
constexpr size_t WS_RTOP = WS_CX + (size_t)NC * D * 2;
constexpr size_t WS_RPROB = WS_RTOP + (size_t)NX * 8;
constexpr size_t WS_RRANK = WS_RPROB + (size_t)NX * 8;
constexpr size_t WS_RPOS = WS_RRANK + (size_t)NX * 8;
constexpr size_t WS_RGATE = WS_RPOS + (size_t)NX * 8;
constexpr size_t WS_P = WS_RGATE + al256((size_t)SLICE_ROWS * 4);
constexpr size_t P_BYTES = (size_t)MALL * INC * 2;
constexpr size_t WS_MGU = WS_P + P_BYTES;
constexpr size_t WS_MD = WS_MGU + (size_t)NE * 2 * DEX * D;
constexpr size_t WS_END = WS_MD + (size_t)NE * D * DEX;
constexpr size_t WS_HH0 = WS_P;
constexpr size_t WS_H8 = WS_P;
constexpr size_t WS_AS = WS_H8 + (size_t)NX * D;
constexpr size_t WS_YS = WS_AS + (size_t)SLICE_ROWS * D;
constexpr size_t WS_HHS = WS_YS + (size_t)SLICE_ROWS * D * 2;
static_assert(WS_HHS + (size_t)SLICE_ROWS * DEX <= WS_P + P_BYTES, "moe overlay");
static_assert((size_t)MALL * DFF * 2 <= P_BYTES, "ffn overlay");
constexpr int CW_BAR = 0;
constexpr int CW_GCOUNT = 4096;
constexpr int CW_CMAX_FG = 18432, CW_CMAX_FU = 21248;
constexpr int CW_CMAX_IN = 8192;
constexpr size_t WS_RS = WS_CTL + 524288;
constexpr int LDS_BYTES = 159744, MISC_OFF = 158720;

typedef __bf16 bf16x2_t __attribute__((ext_vector_type(2)));
DI unsigned pk2(float lo, float hi) { bf16x2_t v = {(__bf16)lo, (__bf16)hi}; return __builtin_bit_cast(unsigned, v); }
DI float bflo(unsigned w) { return __uint_as_float(w << 16); }
DI float bfhi(unsigned w) { return __uint_as_float(w & 0xffff0000u); }
DI float wave_sum(float v) {
#pragma unroll
    for (int o = 1; o < 64; o <<= 1) v += __shfl_xor(v, o);
    return v;
}
DI float sat8(float x) { return __builtin_amdgcn_fmed3f(x, -448.f, 448.f); }
DI unsigned pk4_fp8(float a, float b, float c, float d) { int p = __builtin_amdgcn_cvt_pk_fp8_f32(sat8(a), sat8(b), 0, false); p = __builtin_amdgcn_cvt_pk_fp8_f32(sat8(c), sat8(d), p, true); return (unsigned)p; }
DI float wave_max(float v) {
#pragma unroll
    for (int o = 1; o < 64; o <<= 1) v = fmaxf(v, __shfl_xor(v, o));
    return v;
}
DI unsigned pk4_i8(float a, float b, float c, float d) {
    const int qa = (int)rintf(a), qb = (int)rintf(b), qc = (int)rintf(c), qd = (int)rintf(d);
    return (unsigned)(qa & 0xff) | ((unsigned)(qb & 0xff) << 8) | ((unsigned)(qc & 0xff) << 16) | ((unsigned)qd << 24);
}
DI float sigmoidf_(float a) { return __builtin_amdgcn_rcpf(1.0f + __builtin_amdgcn_exp2f(a * -1.4426950408889634f)); }
DI float siluf_(float a) { return a * sigmoidf_(a); }
#define LDS_WAIT() asm volatile("s_waitcnt lgkmcnt(0)" ::: "memory")
#define VM_WAIT() asm volatile("s_waitcnt vmcnt(0)" ::: "memory")

#define XB_TMO      128
#define XB_XCNT(j)  (256  + 64 * (j))
#define XB_XSUB(j)  (1280 + 64 * (j))
#define XB_XGEN(j)  (2304 + 64 * (j))
#define XB_TOP      3328
#define XB_TOPGEN   3392
#define XCD_BAR_WORDS 3456
#define XB_SPIN_CAP (1u << 20)

__device__ __forceinline__ unsigned xb_ld(unsigned* p)              { return __hip_atomic_load(p, __ATOMIC_RELAXED, __HIP_MEMORY_SCOPE_AGENT); }
__device__ __forceinline__ unsigned xb_add(unsigned* p, unsigned v) { return __hip_atomic_fetch_add(p, v, __ATOMIC_RELAXED, __HIP_MEMORY_SCOPE_AGENT); }
__device__ __forceinline__ unsigned xb_xcc_id() { return (unsigned)__builtin_amdgcn_s_getreg((3 << 11) | 20) & 0xFu; }
#define XB_SPIN(cond, bar) do { unsigned _sp = 0; while (cond) { __builtin_amdgcn_s_sleep(1); \
    if ((++_sp & 255u) == 0u) { if (xb_ld(&(bar)[XB_TMO])) break; if (_sp > XB_SPIN_CAP) { atomicAdd(&(bar)[XB_TMO], 1u); break; } } } } while (0)

struct XcdBarrier { unsigned* bar; unsigned x; volatile LAS unsigned* st; };

__device__ __forceinline__ XcdBarrier xcd_barrier_post(unsigned* bar, volatile LAS unsigned* st) {
    XcdBarrier b; b.bar = bar; b.x = xb_xcc_id(); b.st = st;
    if (threadIdx.x == 0) (void)xb_add(&bar[XB_XCNT(b.x)], 1u);
    return b;
}
__device__ __forceinline__ void xcd_barrier_complete(unsigned* bar, unsigned x, unsigned& nloc, unsigned& nx) {
    const unsigned G = gridDim.x * gridDim.y * gridDim.z;
    unsigned sum, cnt, mine, sp = 0u;
    for (;;) {
        sum = 0u; cnt = 0u; mine = 0u;
#pragma unroll
        for (unsigned j = 0; j < 16; ++j) { const unsigned c = xb_ld(&bar[XB_XCNT(j)]); sum += c; cnt += (c > 0u) ? 1u : 0u; mine = (j == x) ? c : mine; }
        if (sum == G) break;
        __builtin_amdgcn_s_sleep(1);
        if ((++sp & 255u) == 0u) { if (xb_ld(&bar[XB_TMO])) break; if (sp > XB_SPIN_CAP) { atomicAdd(&bar[XB_TMO], 1u); break; } }
    }
    nloc = mine > 0u ? mine : 1u; nx = cnt > 0u ? cnt : 1u;
}
__device__ __forceinline__ void xcd_barrier(const XcdBarrier& b) {
    asm volatile("s_waitcnt vmcnt(0)" ::: "memory");
    __syncthreads();
    if (threadIdx.x == 0) {
        unsigned* bar = b.bar;
        __builtin_amdgcn_s_waitcnt(0);
        unsigned nloc = b.st[0], nx = b.st[1];
        if (nloc == 0u) { xcd_barrier_complete(bar, b.x, nloc, nx); b.st[0] = nloc; b.st[1] = nx; }
        const unsigned old = xb_add(&bar[XB_XSUB(b.x)], 1u);
        const unsigned gen = old / nloc;
        if (old + 1u == (gen + 1u) * nloc) {
            __builtin_amdgcn_fence(__ATOMIC_RELEASE, "agent");
            asm volatile("s_waitcnt vmcnt(0)" ::: "memory");
            const unsigned og = xb_add(&bar[XB_TOP], 1u);
            const unsigned tg = og / nx;
            if (og + 1u == (tg + 1u) * nx) xb_add(&bar[XB_TOPGEN], 1u);
            else XB_SPIN(xb_ld(&bar[XB_TOPGEN]) == tg, bar);
            __builtin_amdgcn_fence(__ATOMIC_ACQUIRE, "agent");
            xb_add(&bar[XB_XGEN(b.x)], 1u);
            asm volatile("s_waitcnt vmcnt(0)" ::: "memory");
        } else {
            XB_SPIN(xb_ld(&bar[XB_XGEN(b.x)]) == gen, bar);
            __builtin_amdgcn_fence(__ATOMIC_ACQUIRE, "agent");
            asm volatile("s_waitcnt vmcnt(0)" ::: "memory");
        }
    }
    __syncthreads();
}

namespace pg8 {
constexpr int BM = 256, BK = 64, HALF = 128, HTB = HALF * BK * 2, STAGE_BYTES = 8 * HTB, NXCD = 8, WGM = 4;
__host__ __device__ __forceinline__ int lds_byte(int r, int c) { const int st = (r >> 4) * 2 + (c >> 5), rr = r & 15, cc = c & 31, ob = rr * 64 + cc * 2; return st * 1024 + (ob ^ (((ob >> 9) & 1) << 5)); }
__host__ __device__ __forceinline__ void stage_rc(int b, int& R, int& C) { const int st = b / 1024, sb = b % 1024, swz = sb ^ (((sb >> 9) & 1) << 5); R = (st >> 1) * 16 + swz / 64; C = (st & 1) * 32 + (swz % 64) / 2; }
__host__ __device__ __forceinline__ int perm32(int rho) { const int n = rho >> 4, i = rho & 15; return 8 * (i >> 2) + 4 * n + (i & 3); }

struct Unit { int arow, brow, pn, aux; };
struct Gemm { const GAS bf16* A; const GAS bf16* Bt; int lda, ldb, K; };
typedef int v8i __attribute__((ext_vector_type(8))); typedef int v4i __attribute__((ext_vector_type(4)));
DI v8i cat16(bf16x8 a, bf16x8 b) { const v4i x = __builtin_bit_cast(v4i, a), y = __builtin_bit_cast(v4i, b); return __builtin_shufflevector(x, y, 0, 1, 2, 3, 4, 5, 6, 7); }

DI void tile_order(int L, int nM, int nN, int& pm, int& pn) {
    const int nwg = nM * nN;
    int wgid = L; { const int q = nwg / NXCD, r = nwg % NXCD, xcd = wgid % NXCD, off = wgid / NXCD; wgid = (xcd < r ? xcd * (q + 1) : r * (q + 1) + (xcd - r) * q) + off; }
    const int nig = WGM * nN, gid = wgid / nig, fm = gid * WGM, gsz = (nM - fm) < WGM ? (nM - fm) : WGM;
    pm = fm + ((wgid % nig) % gsz); pn = (wgid % nig) / gsz;
}
struct StaticSched {
    int nM, nN, G, c, arow0;
    DI void init(int nM_, int nN_, int G_, int c_, int arow0_) { nM = nM_; nN = nN_; G = G_; c = c_; arow0 = arow0_; }
    DI bool next(int i, Unit& u) const {
        const long L = (long)i * G + c; if (L >= (long)nM * nN) return false;
        int pm, pn; tile_order((int)L, nM, nN, pm, pn);
        u.arow = arow0 + pm * BM; u.brow = pn * BM; u.pn = pn; u.aux = 0; return true;
    }
};
struct InSched {
    int G, c; bool last;
    DI bool next(int i, Unit& u) const {
        const int L = i * G + c; int pm, pn;
        if (!last) { if (L >= (MALL / 256) * (INC / 256)) return false; tile_order(L, MALL / 256, INC / 256, pm, pn); }
        else if (L < (NX / 256) * (INC / 256)) tile_order(L, NX / 256, INC / 256, pm, pn);
        else { const int L2 = L - (NX / 256) * (INC / 256); if (L2 >= (NC / 256) * 6) return false; pm = NX / 256 + L2 % (NC / 256); pn = 2 + L2 / (NC / 256); }
        u.arow = pm * BM; u.brow = pn * BM; u.pn = pn; u.aux = 0; return true;
    }
};
struct MoeSched {
    int nM, nN, G, c, nrow_e; int toff[9];
    DI bool next(int i, Unit& u) const {
        const long L = (long)i * G + c; if (L >= (long)nM * nN) return false;
        int pm, pn; tile_order((int)L, nM, nN, pm, pn);
        int e = 0;
#pragma unroll
        for (int j = 1; j < 8; ++j) e += (pm >= toff[j]) ? 1 : 0;
        u.arow = pm * BM; u.brow = e * nrow_e + pn * BM; u.pn = pn; u.aux = e; return true;
    }
};

template <class Epi, class Sched, bool FP8 = false, int WSC = 127, bool I8 = false>
DI void gemm_phase(LAS unsigned char* lds, const Gemm g, const Sched& S, const Epi& E) {
    int tid = threadIdx.x; asm volatile("" : "+v"(tid));
    const int wid = __builtin_amdgcn_readfirstlane(tid >> 6), lane = tid & 63, wr = wid >> 2, wc = wid & 3, fr = lane & 15, fq = lane >> 4;
    const int K = g.K, nt = K / BK;
    unsigned voffA[2], voffB[2];
#pragma unroll
    for (int i = 0; i < 2; ++i) { int R, C; stage_rc(tid * 16 + i * 8192, R, C); const int Rb = Epi::PERM ? ((R & ~31) + perm32(R & 31)) : R;
        voffA[i] = (unsigned)(R * g.lda + C) * 2u; voffB[i] = (unsigned)(Rb * g.ldb + C) * 2u; }
    const size_t kstep = (size_t)(BK * 2);
    const size_t hstepA = (size_t)HALF * g.lda * 2, hstepB = (size_t)HALF * g.ldb * 2;
    const size_t rowA = (size_t)g.lda * 2, rowB = (size_t)g.ldb * 2;
    const unsigned ldsw = (unsigned)wid * 1024u;
    const int aoff = lds_byte(wr * 64 + fr, fq * 8), boff = lds_byte(wc * 32 + fr, fq * 8);
#define PG8_SA(b, h) (((b) * 2 + (h)) * HTB)
#define PG8_SB(b, h) ((4 + (b) * 2 + (h)) * HTB)
#define PG8_STAGE(bufoff, gbase, voff) do { _Pragma("unroll") for (int _i = 0; _i < 2; ++_i) \
        __builtin_amdgcn_global_load_lds((const GAS unsigned*)((const GAS char*)(gbase) + (voff)[_i]), (LAS unsigned*)(lds + (bufoff) + ldsw + _i * 8192), 16, 0, 0); } while (0)
#define PG8_LDA(dst, b, h) do { _Pragma("unroll") for (int m = 0; m < 4; ++m) { if constexpr (FP8) dst##8[m] = cat16(*(const LAS bf16x8*)(lds + PG8_SA(b, h) + aoff + m * 2048), *(const LAS bf16x8*)(lds + PG8_SA(b, h) + aoff + m * 2048 + 1024)); \
        else { _Pragma("unroll") for (int k = 0; k < 2; ++k) dst[m][k] = *(const LAS bf16x8*)(lds + PG8_SA(b, h) + aoff + m * 2048 + k * 1024); } } } while (0)
#define PG8_LDB(dst, b, h) do { _Pragma("unroll") for (int n = 0; n < 2; ++n) { if constexpr (FP8) dst##8[n] = cat16(*(const LAS bf16x8*)(lds + PG8_SB(b, h) + boff + n * 2048), *(const LAS bf16x8*)(lds + PG8_SB(b, h) + boff + n * 2048 + 1024)); \
        else { _Pragma("unroll") for (int k = 0; k < 2; ++k) dst[n][k] = *(const LAS bf16x8*)(lds + PG8_SB(b, h) + boff + n * 2048 + k * 1024); } } } while (0)
#define PG8_MMA(ai, bj, At, Bt) do { __builtin_amdgcn_s_setprio(1); _Pragma("unroll") for (int m = 0; m < 4; ++m) _Pragma("unroll") for (int n = 0; n < 2; ++n) { \
        if constexpr (FP8) asm volatile("v_mfma_scale_f32_16x16x128_f8f6f4 %0, %1, %2, %0, %3, %4 op_sel_hi:[0,0,0]" : "+v"(acc[ai][bj][m][n]) : "v"(Bt##8[n]), "v"(At##8[m]), "v"(sc_w), "v"(sc_a)); \
        else if constexpr (I8) { _Pragma("unroll") for (int k = 0; k < 2; ++k) acc[ai][bj][m][n] = __builtin_bit_cast(f32x4, __builtin_amdgcn_mfma_i32_16x16x64_i8(__builtin_bit_cast(v4i, Bt[n][k]), __builtin_bit_cast(v4i, At[m][k]), __builtin_bit_cast(v4i, acc[ai][bj][m][n]), 0, 0, 0)); } \
        else { _Pragma("unroll") for (int k = 0; k < 2; ++k) acc[ai][bj][m][n] = __builtin_amdgcn_mfma_f32_16x16x32_bf16(Bt[n][k], At[m][k], acc[ai][bj][m][n], 0, 0, 0); } } \
        __builtin_amdgcn_s_setprio(0); } while (0)
#define PG8_WAIT_V(n) asm volatile("s_waitcnt vmcnt(" #n ")" ::: "memory")
#define PG8_WAIT_L(n) asm volatile("s_waitcnt lgkmcnt(" #n ")" ::: "memory")
#define PG8_BAR __builtin_amdgcn_s_barrier()
#define PG8_SCHED __builtin_amdgcn_sched_barrier(0)
    Unit cur, nxt; int ui = 0;
    if (!S.next(0, cur)) return;
    f32x4 acc[2][2][4][2];
#pragma unroll
    for (int a = 0; a < 2; ++a)
#pragma unroll
        for (int b = 0; b < 2; ++b)
#pragma unroll
            for (int m = 0; m < 4; ++m)
#pragma unroll
                for (int n = 0; n < 2; ++n) acc[a][b][m][n] = (f32x4){0.f, 0.f, 0.f, 0.f};
    const int sc_w = WSC * 0x01010101, sc_a = 0x7f7f7f7f;
    bf16x8 At[4][2], B0[2][2], B1[2][2]; v8i At8[4], B08[2], B18[2];
    const GAS char* cA = (const GAS char*)g.A + (size_t)cur.arow * rowA; const GAS char* cB = (const GAS char*)g.Bt + (size_t)cur.brow * rowB;
    PG8_STAGE(PG8_SB(0, 0), cB, voffB); PG8_STAGE(PG8_SB(0, 1), cB + hstepB, voffB); PG8_STAGE(PG8_SA(0, 0), cA, voffA); PG8_STAGE(PG8_SA(0, 1), cA + hstepA, voffA);
    if (wr == 1) PG8_BAR;
    PG8_WAIT_V(2); PG8_BAR;
    PG8_STAGE(PG8_SB(1, 0), cB + kstep, voffB); PG8_STAGE(PG8_SA(1, 0), cA + kstep, voffA); PG8_STAGE(PG8_SB(1, 1), cB + hstepB + kstep, voffB);
    PG8_WAIT_V(6); PG8_BAR;
    for (;;) {
        const bool has_next = S.next(ui + 1, nxt);
        const GAS char* nA = has_next ? (const GAS char*)g.A + (size_t)nxt.arow * rowA : cA; const GAS char* nB = has_next ? (const GAS char*)g.Bt + (size_t)nxt.brow * rowB : cB;
        for (int t = 0; t < nt; t += 2) {
            const bool last = (t == nt - 2);
            const GAS char* a1 = cA + (size_t)(t + 1) * kstep;
            const GAS char* a2 = last ? nA : cA + (size_t)(t + 2) * kstep; const GAS char* b2 = last ? nB : cB + (size_t)(t + 2) * kstep;
            const GAS char* a3 = a2 + kstep; const GAS char* b3 = b2 + kstep;
            PG8_LDB(B0, 0, 0); PG8_LDB(B1, 0, 1); PG8_SCHED; PG8_LDA(At, 0, 0); PG8_STAGE(PG8_SA(1, 1), a1 + hstepA, voffA);
            PG8_WAIT_V(8); PG8_WAIT_L(0); PG8_BAR; PG8_MMA(0, 0, At, B0); PG8_MMA(0, 1, At, B1); PG8_BAR; PG8_SCHED;
            PG8_LDA(At, 0, 1); PG8_STAGE(PG8_SB(0, 0), b2, voffB); PG8_STAGE(PG8_SB(0, 1), b2 + hstepB, voffB); PG8_STAGE(PG8_SA(0, 0), a2, voffA);
            PG8_WAIT_V(8); PG8_WAIT_L(0); PG8_BAR; PG8_MMA(1, 0, At, B0); PG8_MMA(1, 1, At, B1); PG8_BAR; PG8_SCHED;
            PG8_LDB(B0, 1, 0); PG8_LDB(B1, 1, 1); PG8_SCHED; PG8_LDA(At, 1, 0); PG8_STAGE(PG8_SA(0, 1), a2 + hstepA, voffA);
            PG8_WAIT_V(8); PG8_WAIT_L(0); PG8_BAR; PG8_MMA(0, 0, At, B0); PG8_MMA(0, 1, At, B1); PG8_BAR; PG8_SCHED;
            PG8_LDA(At, 1, 1); PG8_STAGE(PG8_SB(1, 0), b3, voffB); PG8_STAGE(PG8_SB(1, 1), b3 + hstepB, voffB); PG8_STAGE(PG8_SA(1, 0), a3, voffA);
            PG8_WAIT_V(8); PG8_WAIT_L(0); PG8_BAR; PG8_MMA(1, 0, At, B0); PG8_MMA(1, 1, At, B1); PG8_BAR; PG8_SCHED;
        }
        if (wr == 0) PG8_BAR;
        if constexpr (FP8) asm volatile("s_nop 15\n\ts_nop 15\n\ts_nop 15\n\ts_nop 15" ::: "memory");
        if constexpr (Epi::HAS_PRE) {
            const auto pre = E.preload(cur, wr, fr);
            if constexpr (I8) {
#pragma unroll
                for (int a = 0; a < 2; ++a)
#pragma unroll
                    for (int b = 0; b < 2; ++b)
#pragma unroll
                        for (int m = 0; m < 4; ++m)
#pragma unroll
                            for (int n = 0; n < 2; ++n) { const v4i t = __builtin_bit_cast(v4i, acc[a][b][m][n]); acc[a][b][m][n] = (f32x4){(float)t.x, (float)t.y, (float)t.z, (float)t.w}; } }
            E(acc, cur, wr, wc, fr, fq, pre);
        } else {
        if constexpr (I8) {
#pragma unroll
            for (int a = 0; a < 2; ++a)
#pragma unroll
                for (int b = 0; b < 2; ++b)
#pragma unroll
                    for (int m = 0; m < 4; ++m)
#pragma unroll
                        for (int n = 0; n < 2; ++n) { const v4i t = __builtin_bit_cast(v4i, acc[a][b][m][n]); acc[a][b][m][n] = (f32x4){(float)t.x, (float)t.y, (float)t.z, (float)t.w}; } }
        E(acc, cur, wr, wc, fr, fq);
        }
        if (!has_next) break;
#pragma unroll
        for (int a = 0; a < 2; ++a)
#pragma unroll
            for (int b = 0; b < 2; ++b)
#pragma unroll
                for (int m = 0; m < 4; ++m)
#pragma unroll
                    for (int n = 0; n < 2; ++n) acc[a][b][m][n] = (f32x4){0.f, 0.f, 0.f, 0.f};
        cur = nxt; cA = nA; cB = nB; ++ui;
        if (wr == 1) PG8_BAR;
    }
    PG8_WAIT_V(0);
    PG8_BAR;
#undef PG8_SA
#undef PG8_SB
#undef PG8_STAGE
#undef PG8_LDA
#undef PG8_LDB
#undef PG8_MMA
#undef PG8_WAIT_V
#undef PG8_WAIT_L
#undef PG8_BAR
#undef PG8_SCHED
}

DI f32x2 ex2p(f32x2 x) { return (f32x2){__builtin_amdgcn_exp2f(x.x), __builtin_amdgcn_exp2f(x.y)}; }
DI f32x2 rcpp(f32x2 x) { return (f32x2){__builtin_amdgcn_rcpf(x.x), __builtin_amdgcn_rcpf(x.y)}; }
DI f32x2 lo2(f32x4 v) { return __builtin_shufflevector(v, v, 0, 1); }
DI f32x2 hi2(f32x4 v) { return __builtin_shufflevector(v, v, 2, 3); }
DI v4u pack8p(const f32x2 (&o)[4]) { v4u w; w.x = pk2(o[0].x, o[0].y); w.y = pk2(o[1].x, o[1].y); w.z = pk2(o[2].x, o[2].y); w.w = pk2(o[3].x, o[3].y); return w; }
DI v4u pack8f(const float (&o)[8]) { v4u w; w.x = pk2(o[0], o[1]); w.y = pk2(o[2], o[3]); w.z = pk2(o[4], o[5]); w.w = pk2(o[6], o[7]); return w; }
template <bool LBZ> struct EpiIn {
    static constexpr bool PERM = true; static constexpr bool HAS_PRE = true;
    GAS bf16* P; const GAS float* LB;
    static constexpr bool lbz = LBZ;
    const GAS float* rs; const LAS float* cmax;
    template <int T> DI static void act8(float (&v)[8], const float (&lb)[8]) {
        const float L2E = 1.4426950408889634f, LN2 = 0.6931471805599453f;
        if (T == 2) return;
        if (T == 0 || T == 3 || T == 4) {
            f32x2 a2[4] = {{v[0], v[1]}, {v[2], v[3]}, {v[4], v[5]}, {v[6], v[7]}}, e2[4];
#pragma unroll
            for (int p = 0; p < 4; ++p) e2[p] = ex2p(a2[p] * (f32x2){-L2E, -L2E});
#pragma unroll
            for (int p = 0; p < 4; ++p) { e2[p] = e2[p] + (f32x2){1.0f, 1.0f}; if (T == 0) a2[p] = a2[p] * (f32x2){0.08838834764831845f, 0.08838834764831845f}; }
#pragma unroll
            for (int p = 0; p < 4; ++p) e2[p] = rcpp(e2[p]);
#pragma unroll
            for (int p = 0; p < 4; ++p) { const f32x2 o = (T == 4) ? e2[p] : a2[p] * e2[p]; v[2 * p] = o.x; v[2 * p + 1] = o.y; }
            return;
        }
        f32x2 a2[4] = {{v[0], v[1]}, {v[2], v[3]}, {v[4], v[5]}, {v[6], v[7]}}, t2[4], m2[4];
#pragma unroll
        for (int p = 0; p < 4; ++p) { m2[p] = __builtin_elementwise_min(a2[p], (f32x2){0.f, 0.f}); t2[p] = (a2[p] - m2[p] - m2[p]) * (f32x2){-L2E, -L2E}; }
#pragma unroll
        for (int p = 0; p < 4; ++p) t2[p] = ex2p(t2[p]);
        if constexpr (LBZ) {
#pragma unroll
            for (int p = 0; p < 4; ++p) t2[p] = t2[p] + (f32x2){1.0f, 1.0f};
#pragma unroll
            for (int p = 0; p < 4; ++p) t2[p] = (f32x2){__builtin_amdgcn_logf(t2[p].x), __builtin_amdgcn_logf(t2[p].y)};
#pragma unroll
            for (int p = 0; p < 4; ++p) { const f32x2 o = m2[p] - t2[p] * (f32x2){LN2, LN2}; v[2 * p] = o.x; v[2 * p + 1] = o.y; }
        } else {
            f32x2 r2[4];
#pragma unroll
            for (int p = 0; p < 4; ++p) r2[p] = rcpp(t2[p] + (f32x2){1.0f, 1.0f});
#pragma unroll
            for (int p = 0; p < 4; ++p) { const f32x2 num = (f32x2){a2[p].x >= 0.f ? 1.0f : t2[p].x, a2[p].y >= 0.f ? 1.0f : t2[p].y};
                const f32x2 lbp = (f32x2){lb[2 * p], lb[2 * p + 1]}; r2[p] = lbp + ((f32x2){1.0f, 1.0f} - lbp) * (num * r2[p]); }
#pragma unroll
            for (int p = 0; p < 4; ++p) { v[2 * p] = __builtin_amdgcn_logf(r2[p].x) * LN2; v[2 * p + 1] = __builtin_amdgcn_logf(r2[p].y) * LN2; }
        }
    }
    struct Pre { float r[2][4]; };
    DI Pre preload(const Unit& u, int wr, int fr) const { Pre p; asm volatile("" : "+v"(fr)); const int row0 = u.arow + wr * 64 + fr;
#pragma unroll
        for (int ai = 0; ai < 2; ++ai)
#pragma unroll
            for (int m = 0; m < 4; ++m) p.r[ai][m] = rs[row0 + ai * 128 + m * 16];
        return p; }
    template <int T> DI void run(const f32x4 (&acc)[2][2][4][2], const Unit& u, int wr, int wc, int fr, int fq, const Pre& pre) const {
        const int row0 = u.arow + wr * 64 + fr, colt = u.pn * 256 + wc * 32 + 8 * fq;
        float rsr[2][4];
#pragma unroll
        for (int ai = 0; ai < 2; ++ai)
#pragma unroll
            for (int m = 0; m < 4; ++m) rsr[ai][m] = pre.r[ai][m];
#pragma unroll
        for (int bj = 0; bj < 2; ++bj) {
            float lb[8];
#pragma unroll
            for (int j = 0; j < 8; ++j) lb[j] = (T == 1 && !lbz) ? LB[colt - 512 + bj * 128 + j] : 0.f;
            const f32x4 c0 = *(const LAS f32x4*)(cmax + colt + bj * 128) * (1.0f / 127.0f), c1 = *(const LAS f32x4*)(cmax + colt + bj * 128 + 4) * (1.0f / 127.0f);
#pragma unroll
            for (int ai = 0; ai < 2; ++ai)
#pragma unroll
                for (int m = 0; m < 4; ++m) { GAS bf16* rowp = P + (size_t)(row0 + ai * 128 + m * 16) * INC + colt;
                    const f32x4 w0 = acc[ai][bj][m][0] * (c0 * rsr[ai][m]), w1 = acc[ai][bj][m][1] * (c1 * rsr[ai][m]);
                    float v[8] = {w0[0], w0[1], w0[2], w0[3], w1[0], w1[1], w1[2], w1[3]};
                    act8<T>(v, lb);
                    *(GAS v4u*)(rowp + bj * 128) = pack8f(v);
                    __builtin_amdgcn_sched_barrier(0); }
        }
    }
    DI void operator()(const f32x4 (&acc)[2][2][4][2], const Unit& u, int wr, int wc, int fr, int fq, const Pre& pre) const {
        const int t = u.pn >> 1;
        if (t == 0) run<0>(acc, u, wr, wc, fr, fq, pre);
        else if (t == 1 || t == 2) run<1>(acc, u, wr, wc, fr, fq, pre);
        else if (t == 3 || t == 5) run<2>(acc, u, wr, wc, fr, fq, pre);
        else if (t == 4) run<3>(acc, u, wr, wc, fr, fq, pre);
        else run<4>(acc, u, wr, wc, fr, fq, pre);
    }
};
template <int MODE> struct EpiRow {
    static constexpr bool PERM = true; static constexpr bool HAS_PRE = false;
    GAS bf16* O; int ldc; const GAS float* colscale; int g2off;
    DI void operator()(const f32x4 (&acc)[2][2][4][2], const Unit& u, int wr, int wc, int fr, int fq) const {
        const int row0 = u.arow + wr * 64 + fr, colt = u.pn * 256 + wc * 32 + 8 * fq;
        if constexpr (MODE == 0) {
            float cs[2][8];
#pragma unroll
            for (int bj = 0; bj < 2; ++bj)
#pragma unroll
                for (int j = 0; j < 8; ++j) cs[bj][j] = colscale ? colscale[colt + bj * 128 + j] : 1.f;
#pragma unroll
            for (int ai = 0; ai < 2; ++ai)
#pragma unroll
                for (int m = 0; m < 4; ++m) { GAS bf16* rowp = O + (size_t)(row0 + ai * 128 + m * 16) * ldc + colt;
#pragma unroll
                    for (int bj = 0; bj < 2; ++bj) { const f32x4 v0 = acc[ai][bj][m][0], v1 = acc[ai][bj][m][1];
                        float o[8] = {v0[0], v0[1], v0[2], v0[3], v1[0], v1[1], v1[2], v1[3]};
#pragma unroll
                        for (int j = 0; j < 8; ++j) o[j] *= cs[bj][j];
                        v4u w; w.x = pk2(o[0], o[1]); w.y = pk2(o[2], o[3]); w.z = pk2(o[4], o[5]); w.w = pk2(o[6], o[7]);
                        *(GAS v4u*)(rowp + bj * 128) = w; } }
        } else if constexpr (MODE == 1) {
            v4u gq[2][4], r0[2][4];
#pragma unroll
            for (int ai = 0; ai < 2; ++ai)
#pragma unroll
                for (int m = 0; m < 4; ++m) gq[ai][m] = *(const GAS v4u*)(O + (size_t)(row0 + ai * 128 + m * 16) * ldc + colt);
#pragma unroll
            for (int ai = 0; ai < 2; ++ai)
#pragma unroll
                for (int m = 0; m < 4; ++m) { const f32x4 v0 = acc[ai][0][m][0], v1 = acc[ai][0][m][1]; const v4u g = gq[ai][m];
                    v4u w; w.x = pk2(v0[0] * bflo(g.x), v0[1] * bfhi(g.x)); w.y = pk2(v0[2] * bflo(g.y), v0[3] * bfhi(g.y)); w.z = pk2(v1[0] * bflo(g.z), v1[1] * bfhi(g.z)); w.w = pk2(v1[2] * bflo(g.w), v1[3] * bfhi(g.w));
                    r0[ai][m] = w; }
            __builtin_amdgcn_sched_barrier(0);
#pragma unroll
            for (int ai = 0; ai < 2; ++ai)
#pragma unroll
                for (int m = 0; m < 4; ++m) gq[ai][m] = *(const GAS v4u*)(O + (size_t)(row0 + ai * 128 + m * 16) * ldc + colt + 128);
            __builtin_amdgcn_sched_barrier(0);
#pragma unroll
            for (int ai = 0; ai < 2; ++ai)
#pragma unroll
                for (int m = 0; m < 4; ++m) *(GAS v4u*)(O + (size_t)(row0 + ai * 128 + m * 16) * ldc + colt) = r0[ai][m];
            __builtin_amdgcn_sched_barrier(0);
#pragma unroll
            for (int ai = 0; ai < 2; ++ai)
#pragma unroll
                for (int m = 0; m < 4; ++m) { const f32x4 v0 = acc[ai][1][m][0], v1 = acc[ai][1][m][1]; const v4u g = gq[ai][m];
                    v4u w; w.x = pk2(v0[0] * bflo(g.x), v0[1] * bfhi(g.x)); w.y = pk2(v0[2] * bflo(g.y), v0[3] * bfhi(g.y)); w.z = pk2(v1[0] * bflo(g.z), v1[1] * bfhi(g.z)); w.w = pk2(v1[2] * bflo(g.w), v1[3] * bfhi(g.w));
                    *(GAS v4u*)(O + (size_t)(row0 + ai * 128 + m * 16) * ldc + colt + 128) = w; }
        } else {
            v4u gq[2][4], pq[2][4], rq[4];
            auto LD = [&](int q, int slot) {
#pragma unroll
                for (int m = 0; m < 4; ++m) { const GAS bf16* rp = O + (size_t)(row0 + (q & 1) * 128 + m * 16) * ldc + colt + (q >> 1) * 128; gq[slot][m] = *(const GAS v4u*)(rp + g2off); pq[slot][m] = *(const GAS v4u*)rp; } };
            auto CP = [&](int q, int slot) {
#pragma unroll
                for (int m = 0; m < 4; ++m) { const f32x4 v0 = acc[q & 1][q >> 1][m][0], v1 = acc[q & 1][q >> 1][m][1]; const v4u g = gq[slot][m], t = pq[slot][m];
                    v4u w; w.x = pk2(bflo(t.x) + v0[0] * bflo(g.x), bfhi(t.x) + v0[1] * bfhi(g.x)); w.y = pk2(bflo(t.y) + v0[2] * bflo(g.y), bfhi(t.y) + v0[3] * bfhi(g.y));
                    w.z = pk2(bflo(t.z) + v1[0] * bflo(g.z), bfhi(t.z) + v1[1] * bfhi(g.z)); w.w = pk2(bflo(t.w) + v1[2] * bflo(g.w), bfhi(t.w) + v1[3] * bfhi(g.w));
                    rq[m] = w; } };
            auto ST = [&](int q) {
#pragma unroll
                for (int m = 0; m < 4; ++m) *(GAS v4u*)(O + (size_t)(row0 + (q & 1) * 128 + m * 16) * ldc + colt + (q >> 1) * 128) = rq[m]; };
            LD(0, 0); LD(1, 1); __builtin_amdgcn_sched_barrier(0);
            CP(0, 0); __builtin_amdgcn_sched_barrier(0); LD(2, 0); __builtin_amdgcn_sched_barrier(0); ST(0); __builtin_amdgcn_sched_barrier(0);
            CP(1, 1); __builtin_amdgcn_sched_barrier(0); LD(3, 1); __builtin_amdgcn_sched_barrier(0); ST(1); __builtin_amdgcn_sched_barrier(0);
            CP(2, 0); ST(2); __builtin_amdgcn_sched_barrier(0);
            CP(3, 1); ST(3);
        }
    }
};
template <bool OUT8> struct EpiSwiGLU {
    static constexpr bool PERM = true; static constexpr bool HAS_PRE = true;
    GAS bf16* Hh; int ldc; const GAS float* rowgate;
    const GAS float* rs; const LAS float* cmg; const LAS float* cmu;
    struct Pre { float r[2][4]; };
    DI Pre preload(const Unit& u, int wr, int fr) const { Pre p; asm volatile("" : "+v"(fr)); const int row0 = u.arow + wr * 64 + fr;
#pragma unroll
        for (int ai = 0; ai < 2; ++ai)
#pragma unroll
            for (int m = 0; m < 4; ++m) p.r[ai][m] = rs[row0 + ai * 128 + m * 16];
        return p; }
    DI void operator()(const f32x4 (&acc)[2][2][4][2], const Unit& u, int wr, int wc, int fr, int fq, const Pre& pre) const {
        const int row0 = u.arow + wr * 64 + fr, col0 = u.pn * 128 + wc * 32 + 8 * fq;
        const f32x4 sg4[2] = {*(const LAS f32x4*)(cmg + col0) * (1.0f / 127.0f), *(const LAS f32x4*)(cmg + col0 + 4) * (1.0f / 127.0f)}, su4[2] = {*(const LAS f32x4*)(cmu + col0) * (1.0f / 127.0f), *(const LAS f32x4*)(cmu + col0 + 4) * (1.0f / 127.0f)};
        float rsv[2][4], rgv[2][4];
#pragma unroll
        for (int ai = 0; ai < 2; ++ai)
#pragma unroll
            for (int m = 0; m < 4; ++m) { rsv[ai][m] = pre.r[ai][m]; rgv[ai][m] = rowgate ? rowgate[row0 + ai * 128 + m * 16] : 1.f; }
#pragma unroll
        for (int ai = 0; ai < 2; ++ai)
#pragma unroll
            for (int m = 0; m < 4; ++m) { const int row = row0 + ai * 128 + m * 16; const float rg = rgv[ai][m];
                const f32x4 g0 = acc[ai][0][m][0], g1 = acc[ai][0][m][1], u0 = acc[ai][1][m][0], u1 = acc[ai][1][m][1];
                const float rsr = rsv[ai][m];
                const f32x4 a0 = g0 * (sg4[0] * rsr), a1 = g1 * (sg4[1] * rsr), b0 = u0 * (su4[0] * (rsr * rg)), b1 = u1 * (su4[1] * (rsr * rg));
                f32x2 g2[4] = {lo2(a0), hi2(a0), lo2(a1), hi2(a1)}, u2[4] = {lo2(b0), hi2(b0), lo2(b1), hi2(b1)}, e2[4];
#pragma unroll
                for (int p = 0; p < 4; ++p) e2[p] = ex2p(g2[p] * (f32x2){-1.4426950408889634f, -1.4426950408889634f});
#pragma unroll
                for (int p = 0; p < 4; ++p) e2[p] = e2[p] + (f32x2){1.0f, 1.0f};
#pragma unroll
                for (int p = 0; p < 4; ++p) e2[p] = rcpp(e2[p]);
#pragma unroll
                for (int p = 0; p < 4; ++p) g2[p] = g2[p] * u2[p];
#pragma unroll
                for (int p = 0; p < 4; ++p) g2[p] = g2[p] * e2[p];
                if constexpr (OUT8) { v2u w; w.x = pk4_fp8(g2[0].x, g2[0].y, g2[1].x, g2[1].y); w.y = pk4_fp8(g2[2].x, g2[2].y, g2[3].x, g2[3].y);
                    *(GAS v2u*)((GAS unsigned char*)Hh + (size_t)row * ldc + col0) = w; }
                else *(GAS v4u*)(Hh + (size_t)row * ldc + col0) = pack8p(g2); }
    }
};
template <class E> struct EpiDry { static constexpr bool PERM = E::PERM; static constexpr bool HAS_PRE = false; E e; bool never;
    DI void operator()(const f32x4 (&acc)[2][2][4][2], const Unit& u, int wr, int wc, int fr, int fq) const { if (never) e(acc, u, wr, wc, fr, fq); } };
struct EpiSwiGLU8 {
    static constexpr bool PERM = true; static constexpr bool HAS_PRE = false;
    GAS unsigned char* Hh; int ldc; const GAS float* rowgate;
    DI void operator()(const f32x4 (&acc)[2][2][4][2], const Unit& u, int wr, int wc, int fr, int fq) const {
        const int row0 = u.arow + wr * 64 + fr, col0 = u.pn * 128 + wc * 32 + 8 * fq;
        float rgv[2][4];
#pragma unroll
        for (int ai = 0; ai < 2; ++ai)
#pragma unroll
            for (int m = 0; m < 4; ++m) rgv[ai][m] = rowgate ? rowgate[row0 + ai * 128 + m * 16] : 1.f;
#pragma unroll
        for (int ai = 0; ai < 2; ++ai)
#pragma unroll
            for (int m = 0; m < 4; ++m) { const int row = row0 + ai * 128 + m * 16; const float rg = rgv[ai][m];
                const f32x4 g0 = acc[ai][0][m][0], g1 = acc[ai][0][m][1], u0 = acc[ai][1][m][0], u1 = acc[ai][1][m][1];
                f32x2 g2[4] = {lo2(g0), hi2(g0), lo2(g1), hi2(g1)}, u2[4] = {lo2(u0), hi2(u0), lo2(u1), hi2(u1)}, e2[4];
#pragma unroll
                for (int p = 0; p < 4; ++p) e2[p] = ex2p(g2[p] * (f32x2){-1.4426950408889634f, -1.4426950408889634f});
#pragma unroll
                for (int p = 0; p < 4; ++p) { e2[p] = e2[p] + (f32x2){1.0f, 1.0f}; u2[p] = u2[p] * (f32x2){rg, rg}; }
#pragma unroll
                for (int p = 0; p < 4; ++p) e2[p] = rcpp(e2[p]);
#pragma unroll
                for (int p = 0; p < 4; ++p) g2[p] = g2[p] * u2[p];
#pragma unroll
                for (int p = 0; p < 4; ++p) g2[p] = g2[p] * e2[p];
                v2u w; w.x = pk4_fp8(g2[0].x, g2[0].y, g2[1].x, g2[1].y); w.y = pk4_fp8(g2[2].x, g2[2].y, g2[3].x, g2[3].y);
                *(GAS v2u*)(Hh + (size_t)row * ldc + col0) = w; }
    }
};
}

struct Args { const float* in[25]; float* out; unsigned char* ws; int ph_lo, ph_hi; };
struct Frame {
    LAS unsigned char* lds; int tid, lane, wave, G, gw, NGW; bool never;
    GAS float* out; GAS unsigned char* ws;
};
DI Frame fresh(const Frame& F0) { Frame F = F0; asm volatile("" : "+v"(F.tid)); F.lane = F.tid & 63; asm volatile("" : "+s"(F.ws), "+s"(F.out)); return F; }
enum { I_X = 0, I_C, I_CTX, I_CCTX, I_ADAW, I_ADAB, I_MIXPRE, I_MIXPOST, I_FFNPRE, I_FFNPOST, I_WIN, I_LB, I_GAIN, I_POOLW, I_POOLS, I_WBR, I_WBP, I_WOUT, I_FG, I_FU, I_FD, I_ROUTER, I_MG, I_MU, I_MD };

DI void tr_item(const GAS float* W, int K, int N, GAS bf16* WT, int ldk, int koff, int row_off, int nb, int nstride, LAS float* scr, int item, int lane) {
    const int nblk = N / 32, kb = item / nblk, nbi = item % nblk, k0 = 64 * kb, n0 = 32 * nbi;
    f32x4 ld[8];
#pragma unroll
    for (int i = 0; i < 8; ++i) ld[i] = *(const GAS f32x4*)(W + (size_t)(k0 + (lane >> 3) + 8 * i) * N + n0 + 4 * (lane & 7));
#pragma unroll
    for (int i = 0; i < 8; ++i) { LAS float* d = scr + ((lane >> 3) + 8 * i) * 33 + 4 * (lane & 7); d[0] = ld[i].x; d[1] = ld[i].y; d[2] = ld[i].z; d[3] = ld[i].w; }
    LDS_WAIT(); asm volatile("" ::: "memory");
    const int c = lane & 7;
#pragma unroll
    for (int j = 0; j < 4; ++j) { const int n = (lane >> 3) + 8 * j; const LAS float* s = scr + (8 * c) * 33 + n;
        v4u o; o.x = pk2(s[0 * 33], s[1 * 33]); o.y = pk2(s[2 * 33], s[3 * 33]); o.z = pk2(s[4 * 33], s[5 * 33]); o.w = pk2(s[6 * 33], s[7 * 33]);
        const int ng = n0 + n, drow = row_off + (ng / nb) * nstride + (ng % nb);
        *(GAS v4u*)(WT + (size_t)drow * ldk + koff + k0 + 8 * c) = o; }
    LDS_WAIT(); asm volatile("" ::: "memory");
}

DI void tr_item8(const GAS float* W, int K, int N, GAS unsigned char* WT, int ldk, int row_off, int nb, int nstride, float qs, LAS float* scr, int item, int lane) {
    const int nblk = N / 32, kb = item / nblk, nbi = item % nblk, k0 = 64 * kb, n0 = 32 * nbi;
    f32x4 ld[8];
#pragma unroll
    for (int i = 0; i < 8; ++i) ld[i] = *(const GAS f32x4*)(W + (size_t)(k0 + (lane >> 3) + 8 * i) * N + n0 + 4 * (lane & 7));
#pragma unroll
    for (int i = 0; i < 8; ++i) { LAS float* d = scr + ((lane >> 3) + 8 * i) * 33 + 4 * (lane & 7); d[0] = ld[i].x; d[1] = ld[i].y; d[2] = ld[i].z; d[3] = ld[i].w; }
    LDS_WAIT(); asm volatile("" ::: "memory");
    const int c = lane & 7;
#pragma unroll
    for (int j = 0; j < 4; ++j) { const int n = (lane >> 3) + 8 * j; const LAS float* sp = scr + (8 * c) * 33 + n;
        v2u o; o.x = pk4_fp8(sp[0 * 33] * qs, sp[1 * 33] * qs, sp[2 * 33] * qs, sp[3 * 33] * qs); o.y = pk4_fp8(sp[4 * 33] * qs, sp[5 * 33] * qs, sp[6 * 33] * qs, sp[7 * 33] * qs);
        const int ng = n0 + n, drow = row_off + (ng / nb) * nstride + (ng % nb);
        *(GAS v2u*)(WT + (size_t)drow * ldk + k0 + 8 * c) = o; }
    LDS_WAIT(); asm volatile("" ::: "memory");
}

DI void absmax_item(const GAS float* W, int N, GAS unsigned* cmaxbits, int item, int lane) {
    const int nblk = N / 256, kb = item / nblk, nbi = item % nblk;
    const GAS float* p = W + (size_t)(64 * kb) * N + 256 * nbi + 4 * lane;
    f32x4 m = (f32x4){0.f, 0.f, 0.f, 0.f};
#pragma unroll 8
    for (int k = 0; k < 64; ++k) { const f32x4 w = *(const GAS f32x4*)(p + (size_t)k * N); m.x = fmaxf(m.x, fabsf(w.x)); m.y = fmaxf(m.y, fabsf(w.y)); m.z = fmaxf(m.z, fabsf(w.z)); m.w = fmaxf(m.w, fabsf(w.w)); }
    GAS unsigned* c = cmaxbits + 256 * nbi + 4 * lane;
    __hip_atomic_fetch_max(c + 0, __float_as_uint(m.x), __ATOMIC_RELAXED, __HIP_MEMORY_SCOPE_AGENT); __hip_atomic_fetch_max(c + 1, __float_as_uint(m.y), __ATOMIC_RELAXED, __HIP_MEMORY_SCOPE_AGENT);
    __hip_atomic_fetch_max(c + 2, __float_as_uint(m.z), __ATOMIC_RELAXED, __HIP_MEMORY_SCOPE_AGENT); __hip_atomic_fetch_max(c + 3, __float_as_uint(m.w), __ATOMIC_RELAXED, __HIP_MEMORY_SCOPE_AGENT);
}
DI void tr_item_i8(const GAS float* W, int K, int N, GAS unsigned char* WT, int ldk, const GAS float* cmax, LAS float* scr, int item, int lane, int row_off = 0, int nb = 1 << 30, int nstride = 0) {
    const int nblk = N / 32, kb = item / nblk, nbi = item % nblk, k0 = 64 * kb, n0 = 32 * nbi;
    f32x4 ld[8];
#pragma unroll
    for (int i = 0; i < 8; ++i) ld[i] = *(const GAS f32x4*)(W + (size_t)(k0 + (lane >> 3) + 8 * i) * N + n0 + 4 * (lane & 7));
#pragma unroll
    for (int i = 0; i < 8; ++i) { LAS float* d = scr + ((lane >> 3) + 8 * i) * 33 + 4 * (lane & 7); d[0] = ld[i].x; d[1] = ld[i].y; d[2] = ld[i].z; d[3] = ld[i].w; }
    LDS_WAIT(); asm volatile("" ::: "memory");
    const int c = lane & 7;
#pragma unroll
    for (int j = 0; j < 4; ++j) { const int n = (lane >> 3) + 8 * j; const LAS float* sp = scr + (8 * c) * 33 + n;
        const float q = 127.0f / fmaxf(cmax[n0 + n], 1e-30f);
        v2u o; o.x = pk4_i8(sp[0 * 33] * q, sp[1 * 33] * q, sp[2 * 33] * q, sp[3 * 33] * q); o.y = pk4_i8(sp[4 * 33] * q, sp[5 * 33] * q, sp[6 * 33] * q, sp[7 * 33] * q);
        const int ng = n0 + n, drow = row_off + (ng / nb) * nstride + (ng % nb);
        *(GAS v2u*)(WT + (size_t)drow * ldk + k0 + 8 * c) = o; }
    LDS_WAIT(); asm volatile("" ::: "memory");
}

DI void p0_prologue(const Frame& F0, const Args& A) {
    const Frame F = fresh(F0);
    LAS float* scr = (LAS float*)(F.lds + F.wave * 16384);
    GAS unsigned char* ws = F.ws;
    constexpr int IT_IN = 16 * 160, IT_BR = 8 * 32, IT_O = 16 * 32, IT_F = 16 * 88, IT_FD = 44 * 32;
    constexpr int PER_L = IT_BR + IT_O;
    constexpr int NITEMS = 2 * PER_L + IT_FD;
    for (int it = F.gw; it < NITEMS; it += F.NGW) {
        int r = it;
        if (r < 2 * PER_L) { const int l = r / PER_L; r -= l * PER_L;
            if (r < IT_BR) { tr_item(((const GAS float*)A.in[I_WBR]) + (size_t)l * DH * D, DH, D, (GAS bf16*)(ws + WS_WR) + (size_t)l * D * DH, DH, 0, 0, 1 << 30, 0, scr, r, F.lane); continue; } r -= IT_BR;
            tr_item(((const GAS float*)A.in[I_WOUT]) + (size_t)l * D * D, D, D, (GAS bf16*)(ws + WS_WO) + (size_t)l * D * D, D, 0, 0, 1 << 30, 0, scr, r, F.lane); continue; }
        r -= 2 * PER_L;
        tr_item8(((const GAS float*)A.in[I_FD]), DFF, D, ws + WS_WD, DFF, 0, 1 << 30, 0, 64.f, scr, r, F.lane);
    }
    for (int it = F.NGW - 1 - F.gw; it < 2 * 16 * 20 + 2 * 16 * 11; it += F.NGW) {
        if (it < 640) { const int l = it / 320;
            absmax_item(((const GAS float*)A.in[I_WIN]) + (size_t)l * D * INC, INC, (GAS unsigned*)(ws + WS_CTL) + CW_CMAX_IN + l * INC, it % 320, F.lane); }
        else { const int i2 = it - 640, w = i2 / 176;
            absmax_item((const GAS float*)A.in[w ? I_FU : I_FG], DFF, (GAS unsigned*)(ws + WS_CTL) + (w ? CW_CMAX_FU : CW_CMAX_FG), i2 % 176, F.lane); }
    }
    for (int item = blockIdx.x; item < 2 * 4 * 16 * 2; item += F.G) {
        const int l = item >> 7, g = (item >> 5) & 3, cb = (item >> 1) & 15, n = (item & 1) * 512 + F.tid;
        const GAS float* pw = ((const GAS float*)A.in[I_POOLW]) + (((size_t)l * 4 + g) * 128 + cb * 8) * 128;
        const GAS float* ps = ((const GAS float*)A.in[I_POOLS]) + l * DH + g * 128;
        const GAS float* wp = ((const GAS float*)A.in[I_WBP]) + ((size_t)l * DH + g * 128) * D + n;
        float acc[8];
#pragma unroll
        for (int j = 0; j < 8; ++j) acc[j] = 0.f;
#pragma unroll 8
        for (int e = 0; e < 128; ++e) { const float w = wp[(size_t)e * D] * ps[e];
#pragma unroll
            for (int j = 0; j < 8; ++j) acc[j] += pw[j * 128 + e] * w; }
        v4u o; o.x = pk2(acc[0], acc[1]); o.y = pk2(acc[2], acc[3]); o.z = pk2(acc[4], acc[5]); o.w = pk2(acc[6], acc[7]);
        *(GAS v4u*)((GAS bf16*)(ws + WS_WP) + ((size_t)l * D + n) * DH + g * 128 + cb * 8) = o;
    }
    for (int i = blockIdx.x * NTHR + F.tid; i < 2 * 2 * DH; i += F.G * NTHR) {
        const int l = i / (2 * DH), rem = i % (2 * DH);
        float v = 0.f;
        if (l == 1) { const float h0 = ((const GAS float*)A.in[I_LB])[rem], h1 = ((const GAS float*)A.in[I_LB])[2 * DH + rem]; v = 1.f / (1.f + expf(h0 - h1)); }
        ((GAS float*)(ws + WS_LB))[i] = v;
    }
    __syncthreads();
    constexpr int TP = 1026;
    LAS float* T = (LAS float*)F.lds;
    for (int item = blockIdx.x; item < 2 * 96; item += F.G) {
        const int l = item / 96, e0 = (item % 96) * 64;
        for (int i = F.tid; i < 33 * 1024; i += NTHR) { const int bb = i >> 10, k = i & 1023; const float cv = bb < 32 ? ((const GAS float*)A.in[I_C])[bb * 1024 + k] : ((const GAS float*)A.in[I_CCTX])[k];
            T[bb * TP + k] = cv * __builtin_amdgcn_rcpf(1.0f + __builtin_amdgcn_exp2f(-1.4426950408889634f * cv)); }
        __syncthreads();
        const int kq = F.wave, j = F.lane & 31, kk = F.lane >> 5;
        const GAS float* wp = ((const GAS float*)A.in[I_ADAW]) + (size_t)l * D * 6144 + (size_t)(128 * kq + kk) * 6144 + e0 + 2 * j;
        const LAS float* tp = T + j * TP + 128 * kq + kk; const LAS float* t32 = T + 32 * TP + 128 * kq + kk;
        f32x16 acc0, acc1;
#pragma unroll
        for (int r = 0; r < 16; ++r) { acc0[r] = 0.f; acc1[r] = 0.f; }
        float c0 = 0.f, c1 = 0.f;
        f32x2 wb[8], wn[8];
#pragma unroll
        for (int u = 0; u < 8; ++u) wb[u] = *(const GAS f32x2*)(wp + (size_t)(2 * u) * 6144);
#pragma unroll 1
        for (int bt = 0; bt < 8; ++bt) {
            if (bt + 1 < 8) {
#pragma unroll
                for (int u = 0; u < 8; ++u) wn[u] = *(const GAS f32x2*)(wp + (size_t)(2 * (8 * (bt + 1) + u)) * 6144);
            }
#pragma unroll
            for (int u = 0; u < 8; ++u) { const int s2 = 8 * bt + u; const float a = tp[2 * s2], tc = t32[2 * s2]; const f32x2 w = wb[u];
                acc0 = __builtin_amdgcn_mfma_f32_32x32x2f32(a, w.x, acc0, 0, 0, 0);
                acc1 = __builtin_amdgcn_mfma_f32_32x32x2f32(a, w.y, acc1, 0, 0, 0);
                c0 += tc * w.x; c1 += tc * w.y; }
#pragma unroll
            for (int u = 0; u < 8; ++u) wb[u] = wn[u];
        }
        c0 += __shfl_xor(c0, 32); c1 += __shfl_xor(c1, 32);
        __syncthreads();
        LAS float* R = (LAS float*)F.lds;
#pragma unroll
        for (int r = 0; r < 16; ++r) { const int i = 8 * (r >> 2) + 4 * kk + (r & 3); R[(kq * 33 + i) * 64 + 2 * j] = acc0[r]; R[(kq * 33 + i) * 64 + 2 * j + 1] = acc1[r]; }
        if (kk == 0) { R[(kq * 33 + 32) * 64 + 2 * j] = c0; R[(kq * 33 + 32) * 64 + 2 * j + 1] = c1; }
        __syncthreads();
        for (int i = F.tid; i < 33 * 64; i += NTHR) { const int b = i >> 6, c = i & 63; float sm = 0.f;
#pragma unroll
            for (int q = 0; q < 8; ++q) sm += R[(q * 33 + b) * 64 + c];
            ((GAS float*)(ws + WS_MOD))[((size_t)l * 33 + b) * 6144 + e0 + c] = sm + ((const GAS float*)A.in[I_ADAB])[l * 6144 + e0 + c]; }
        __syncthreads();
    }
}

DI void win_to_i8(const Frame& F0, const Args& A) {
    const Frame F = fresh(F0);
    LAS float* scr = (LAS float*)(F.lds + F.wave * 16384);
    for (int it = F.gw; it < 2 * 16 * 160; it += F.NGW) { const int l = it / 2560;
        tr_item_i8(((const GAS float*)A.in[I_WIN]) + (size_t)l * D * INC, D, INC, F.ws + WS_WIN + (size_t)l * INC * D, D, (const GAS float*)(F.ws + WS_CTL) + CW_CMAX_IN + l * INC, scr, it % 2560, F.lane); }
    for (int it = F.gw; it < 2 * 16 * 88; it += F.NGW) { const int w = it / 1408;
        tr_item_i8((const GAS float*)A.in[w ? I_FU : I_FG], D, DFF, F.ws + WS_WGU, D, (const GAS float*)(F.ws + WS_CTL) + (w ? CW_CMAX_FU : CW_CMAX_FG), scr, it % 1408, F.lane, w ? 128 : 0, 128, 256); }
}
constexpr int MOE_CONV_ITEMS = NE * (2 * 16 * 112 + 56 * 32), MOE_C1 = 16000, MOE_C2 = 8000;
DI void moe_weight_convert(const Frame& F0, const Args& A, int it0, int it1, int wg0) {
    const Frame F = fresh(F0);
    if ((int)blockIdx.x < wg0) return;
    LAS float* scr = (LAS float*)(F.lds + F.wave * 16384);
    constexpr int IT_G = 16 * 112, IT_D = 56 * 32, PER_E = 2 * IT_G + IT_D;
    for (int it = it0 + ((int)blockIdx.x - wg0) * NWAVES + F.wave; it < it1; it += (F.G - wg0) * NWAVES) {
        const int e = it / PER_E; int r = it % PER_E;
        GAS unsigned char* gu = F.ws + WS_MGU + (size_t)e * 2 * DEX * D;
        if (r < IT_G) { tr_item8(((const GAS float*)A.in[I_MG]) + (size_t)e * D * DEX, D, DEX, gu, D, 0, 128, 256, 32.f, scr, r, F.lane); continue; } r -= IT_G;
        if (r < IT_G) { tr_item8(((const GAS float*)A.in[I_MU]) + (size_t)e * D * DEX, D, DEX, gu, D, 128, 128, 256, 32.f, scr, r, F.lane); continue; } r -= IT_G;
        tr_item8(((const GAS float*)A.in[I_MD]) + (size_t)e * DEX * D, DEX, D, F.ws + WS_MD + (size_t)e * D * DEX, DEX, 0, 1 << 30, 0, 64.f, scr, r, F.lane);
    }
}

struct RowVecs { f32x4 a1[4], a2[4], a3[4]; };
DI void load_rowvecs(RowVecs& V, const GAS float* gatev, const GAS float* postg, const GAS float* preg, const GAS float* sc, const GAS float* sh, int lane) {
#pragma unroll
    for (int j = 0; j < 4; ++j) { const int e = 4 * lane + 256 * j;
        if (gatev) { const f32x4 g = *(const GAS f32x4*)(gatev + e), p = *(const GAS f32x4*)(postg + e); V.a1[j] = g * p; } else V.a1[j] = (f32x4){0.f, 0.f, 0.f, 0.f};
        if (preg) { const f32x4 p = *(const GAS f32x4*)(preg + e), s = *(const GAS f32x4*)(sc + e); V.a2[j] = p * (s + 1.0f); V.a3[j] = *(const GAS f32x4*)(sh + e); }
        else { V.a2[j] = (f32x4){0.f, 0.f, 0.f, 0.f}; V.a3[j] = V.a2[j]; } }
}
struct RowData { f32x4 x[4]; v2u y[4]; };
DI GAS bf16* xb_row(GAS float* out, int r) { return (GAS bf16*)(out + (size_t)r * D) + D; }
DI void row_load(RowData& R, const GAS float* xin, const GAS bf16* xinb, const GAS bf16* y, int lane) {
    if (xinb) {
#pragma unroll
        for (int j = 0; j < 4; ++j) { const v2u w = *(const GAS v2u*)(xinb + 4 * lane + 256 * j); R.x[j] = (f32x4){bflo(w.x), bfhi(w.x), bflo(w.y), bfhi(w.y)}; }
    } else {
#pragma unroll
        for (int j = 0; j < 4; ++j) R.x[j] = *(const GAS f32x4*)(xin + 4 * lane + 256 * j);
    }
    if (y) {
#pragma unroll
        for (int j = 0; j < 4; ++j) R.y[j] = *(const GAS v2u*)(y + 4 * lane + 256 * j);
    }
}
DI void row_compute(const RowData& R, bool hasy, GAS float* xout, GAS bf16* xoutb, GAS bf16* hout, const RowVecs& V, int lane, f32x4 (&hv)[4], GAS unsigned char* hout8 = nullptr, GAS unsigned char* hout_i8 = nullptr, GAS float* rs_out = nullptr) {
    f32x4 v[4];
#pragma unroll
    for (int j = 0; j < 4; ++j) v[j] = R.x[j];
    if (hasy) {
        f32x4 yv[4]; float ss = 0.f;
#pragma unroll
        for (int j = 0; j < 4; ++j) { const v2u w = R.y[j]; yv[j] = (f32x4){bflo(w.x), bfhi(w.x), bflo(w.y), bfhi(w.y)};
            ss += (yv[j].x * yv[j].x + yv[j].y * yv[j].y) + (yv[j].z * yv[j].z + yv[j].w * yv[j].w); }
        const float r = 1.0f / sqrtf(wave_sum(ss) * (1.0f / D) + EPS);
#pragma unroll
        for (int j = 0; j < 4; ++j) v[j] += V.a1[j] * (yv[j] * r);
    }
    if (xout) {
#pragma unroll
        for (int j = 0; j < 4; ++j) *(GAS f32x4*)(xout + 4 * lane + 256 * j) = v[j];
    }
    if (xoutb) {
#pragma unroll
        for (int j = 0; j < 4; ++j) { v2u w; w.x = pk2(v[j].x, v[j].y); w.y = pk2(v[j].z, v[j].w); *(GAS v2u*)(xoutb + 4 * lane + 256 * j) = w; }
    }
    if (hout || hout8 || hout_i8) {
        float ss = 0.f;
#pragma unroll
        for (int j = 0; j < 4; ++j) ss += (v[j].x * v[j].x + v[j].y * v[j].y) + (v[j].z * v[j].z + v[j].w * v[j].w);
        const float r = 1.0f / sqrtf(wave_sum(ss) * (1.0f / D) + EPS);
#pragma unroll
        for (int j = 0; j < 4; ++j) hv[j] = (v[j] * r) * V.a2[j] + V.a3[j];
        if (hout_i8) {
            float m = 0.f;
#pragma unroll
            for (int j = 0; j < 4; ++j) m = fmaxf(m, fmaxf(fmaxf(fabsf(hv[j].x), fabsf(hv[j].y)), fmaxf(fabsf(hv[j].z), fabsf(hv[j].w))));
            m = fmaxf(wave_max(m), 1e-30f); const float isc = 127.0f / m;
#pragma unroll
            for (int j = 0; j < 4; ++j) *(GAS unsigned*)(hout_i8 + 4 * lane + 256 * j) = pk4_i8(hv[j].x * isc, hv[j].y * isc, hv[j].z * isc, hv[j].w * isc);
            if (lane == 0) *rs_out = m * (1.0f / 127.0f);
        } else
#pragma unroll
        for (int j = 0; j < 4; ++j) {
            if (hout8) *(GAS unsigned*)(hout8 + 4 * lane + 256 * j) = pk4_fp8(hv[j].x, hv[j].y, hv[j].z, hv[j].w);
            else { v2u w; w.x = pk2(hv[j].x, hv[j].y); w.y = pk2(hv[j].z, hv[j].w); *(GAS v2u*)(hout + 4 * lane + 256 * j) = w; } }
    }
}
DI const GAS float* modp(const Frame& F, int l, int bb, int which) { return (const GAS float*)(F.ws + WS_MOD) + ((size_t)l * 33 + bb) * 6144 + which * 1024; }

DI void route_row(const Frame& F, const LAS float* RT, LAS unsigned* lcount, const f32x4 (&hv)[4], int r) {
                float lg[8];
#pragma unroll
                for (int e = 0; e < 8; ++e) lg[e] = 0.f;
#pragma unroll
                for (int j = 0; j < 4; ++j)
#pragma unroll
                    for (int i = 0; i < 4; ++i) { const LAS float* rp = RT + (4 * F.lane + 256 * j + i) * 8; const f32x4 ra = *(const LAS f32x4*)rp, rb = *(const LAS f32x4*)(rp + 4); const float hx = hv[j][i];
                        lg[0] += hx * ra.x; lg[1] += hx * ra.y; lg[2] += hx * ra.z; lg[3] += hx * ra.w; lg[4] += hx * rb.x; lg[5] += hx * rb.y; lg[6] += hx * rb.z; lg[7] += hx * rb.w; }
#pragma unroll
                for (int e = 0; e < 8; ++e) lg[e] = wave_sum(lg[e]);
                int e0 = 0; float v0 = lg[0];
#pragma unroll
                for (int e = 1; e < 8; ++e) if (lg[e] > v0) { v0 = lg[e]; e0 = e; }
                int e1 = -1; float v1 = -3.0e38f;
#pragma unroll
                for (int e = 0; e < 8; ++e) if (e != e0 && lg[e] > v1) { v1 = lg[e]; e1 = e; }
                if (F.lane == 0) {
                    const float p1 = 1.0f / (1.0f + expf(v0 - v1)), p0 = 1.0f - p1;
                    const int sl = slice_of(r);
                    const unsigned k0 = __hip_atomic_fetch_add(lcount + sl * 8 + e0, 1u, __ATOMIC_RELAXED, __HIP_MEMORY_SCOPE_WORKGROUP), k1 = __hip_atomic_fetch_add(lcount + sl * 8 + e1, 1u, __ATOMIC_RELAXED, __HIP_MEMORY_SCOPE_WORKGROUP);
                    ((GAS i32x2*)(F.ws + WS_RTOP))[r] = (i32x2){e0, e1};
                    ((GAS f32x2*)(F.ws + WS_RPROB))[r] = (f32x2){p0, p1};
                    ((GAS i32x2*)(F.ws + WS_RRANK))[r] = (i32x2){(int)k0, (int)k1};
                }
}
template <int MODE>
DI void rows_phase(const Frame& F0, const Args& A, int l, bool dry = false) {
    const Frame F = fresh(F0);
    GAS bf16* H = (GAS bf16*)(F.ws + WS_H); GAS bf16* CX = (GAS bf16*)(F.ws + WS_CX);
    const bool route = (MODE == 1 && l == 1) && (!dry || F.never);
    const bool st = !dry || F.never;
    LAS unsigned* lcount = (LAS unsigned*)(F.lds + 64);
    LAS unsigned* lbase = (LAS unsigned*)(F.lds + 256);
    LAS float* RT = (LAS float*)(F.lds + 1024);
    if (route) {
        if (F.tid < 32) lcount[F.tid] = 0u;
        for (int i = F.tid; i < 1024 * 8; i += NTHR) RT[i] = ((const GAS float*)A.in[I_ROUTER])[i];
        __syncthreads();
    }
    RowVecs V; f32x4 hv[4];
    for (int r0 = F.gw * 32; r0 < NX; r0 += F.NGW * 32) {
        const int b = r0 >> 11;
        if (MODE == 0) load_rowvecs(V, nullptr, nullptr, ((const GAS float*)A.in[I_MIXPRE]), modp(F, 0, b, 1), modp(F, 0, b, 0), F.lane);
        if (MODE == 1) load_rowvecs(V, modp(F, l, b, 2), ((const GAS float*)A.in[I_MIXPOST]) + l * D, ((const GAS float*)A.in[I_FFNPRE]) + l * D, modp(F, l, b, 4), modp(F, l, b, 3), F.lane);
        if (MODE == 2) load_rowvecs(V, modp(F, 0, b, 5), ((const GAS float*)A.in[I_FFNPOST]), ((const GAS float*)A.in[I_MIXPRE]) + D, modp(F, 1, b, 1), modp(F, 1, b, 0), F.lane);
        const bool toi = (MODE == 0 || MODE == 2 || (MODE == 1 && l == 0)); GAS float* RS = (GAS float*)(F.ws + WS_RS);
        const bool to8 = (MODE == 1 && l == 1); GAS unsigned char* H8 = F.ws + WS_H8;
        const bool xf32 = (MODE == 0 || (MODE == 1 && l == 0));
        const GAS float* xbase = (const GAS float*)A.in[I_X];
#define XIN_F(r) (xf32 ? xbase + (size_t)(r) * D : (const GAS float*)nullptr)
#define XIN_B(r) (xf32 ? (const GAS bf16*)nullptr : (const GAS bf16*)xb_row(F.out, (r)))
        RowData Ra, Rb;
        row_load(Ra, XIN_F(r0), XIN_B(r0), MODE == 0 ? nullptr : H + (size_t)r0 * D, F.lane);
        for (int r = r0; r < r0 + 32; r += 2) {
            row_load(Rb, XIN_F(r + 1), XIN_B(r + 1), MODE == 0 ? nullptr : H + (size_t)(r + 1) * D, F.lane);
            row_compute(Ra, MODE != 0, nullptr, (MODE == 0 || !st) ? nullptr : xb_row(F.out, r), (st && !to8 && !toi) ? H + (size_t)r * D : nullptr, V, F.lane, hv, (st && to8) ? H8 + (size_t)r * D : nullptr, (st && toi) ? (GAS unsigned char*)(H + (size_t)r * D) : nullptr, RS + r);
            if (route) route_row(F, RT, lcount, hv, r);
            if (r + 2 < r0 + 32) row_load(Ra, XIN_F(r + 2), XIN_B(r + 2), MODE == 0 ? nullptr : H + (size_t)(r + 2) * D, F.lane);
            row_compute(Rb, MODE != 0, nullptr, (MODE == 0 || !st) ? nullptr : xb_row(F.out, r + 1), (st && !to8 && !toi) ? H + (size_t)(r + 1) * D : nullptr, V, F.lane, hv, (st && to8) ? H8 + (size_t)(r + 1) * D : nullptr, (st && toi) ? (GAS unsigned char*)(H + (size_t)(r + 1) * D) : nullptr, RS + r + 1);
            if (route) route_row(F, RT, lcount, hv, r + 1);
        }
#undef XIN_F
#undef XIN_B
    }
    if (route) {
        __syncthreads();
        if (F.tid < 32) lbase[F.tid] = __hip_atomic_fetch_add((GAS unsigned*)(F.ws + WS_CTL) + CW_GCOUNT + 64 * F.tid, lcount[F.tid], __ATOMIC_RELAXED, __HIP_MEMORY_SCOPE_AGENT);
        __syncthreads();
        VM_WAIT();
        if (F.lane < 32) {
            for (int r0 = F.gw * 32; r0 < NX; r0 += F.NGW * 32) { const int r = r0 + F.lane; const int sl = slice_of(r); const i32x2 t = ((GAS i32x2*)(F.ws + WS_RTOP))[r]; i32x2 k = ((GAS i32x2*)(F.ws + WS_RRANK))[r];
                    k.x += (int)lbase[sl * 8 + t.x]; k.y += (int)lbase[sl * 8 + t.y]; ((GAS i32x2*)(F.ws + WS_RRANK))[r] = k; }
        }
    }
    if (MODE == 0 || MODE == 2 || (MODE == 1 && l == 0)) {
        if (MODE == 0) load_rowvecs(V, nullptr, nullptr, ((const GAS float*)A.in[I_MIXPRE]), modp(F, 0, 32, 1), modp(F, 0, 32, 0), F.lane);
        if (MODE == 1) load_rowvecs(V, modp(F, 0, 32, 2), ((const GAS float*)A.in[I_MIXPOST]), ((const GAS float*)A.in[I_FFNPRE]), modp(F, 0, 32, 4), modp(F, 0, 32, 3), F.lane);
        if (MODE == 2) load_rowvecs(V, modp(F, 0, 32, 5), ((const GAS float*)A.in[I_FFNPOST]), ((const GAS float*)A.in[I_MIXPRE]) + D, modp(F, 1, 32, 1), modp(F, 1, 32, 0), F.lane);
        const GAS float* cbase = (const GAS float*)A.in[I_CTX];
        for (int r0 = F.gw * 4; r0 < NC; r0 += F.NGW * 4) {
            RowData Rd[4];
#pragma unroll
            for (int i = 0; i < 4; ++i) row_load(Rd[i], cbase + (size_t)(r0 + i) * D, MODE == 2 ? (const GAS bf16*)CX + (size_t)(r0 + i) * D : (const GAS bf16*)nullptr, MODE == 0 ? nullptr : H + (size_t)(NX + r0 + i) * D, F.lane);
#pragma unroll
            for (int i = 0; i < 4; ++i) { const int r = r0 + i;
                row_compute(Rd[i], MODE != 0, nullptr, (MODE == 1 && st) ? CX + (size_t)r * D : nullptr, nullptr, V, F.lane, hv, nullptr,
                            st ? (GAS unsigned char*)(H + (size_t)(NX + r) * D) : nullptr, (GAS float*)(F.ws + WS_RS) + NX + r); }
        }
    }
}

constexpr int SC_CUM = 0, SC_TOT = 32768, SC_VT = 34816, SC_QM = 53248, SC_KM = 70656, SC_QD = 70656, SC_KDT = 88064, SC_AL = 114176, SC_ST = 123392, SC_DEC = 158208, SC_END = 158720;
constexpr int PQ = 272, PV = 144;
static_assert(SC_KDT + 128 * PV <= SC_AL && SC_QD + 64 * PQ <= SC_KDT && SC_KM + 160 * PQ <= SC_AL && SC_AL + 64 * PV <= SC_ST && SC_ST + 128 * PQ <= SC_DEC, "scan LDS map");
DI int scan_row(int b, int dir, int s) { return s < CTX ? NX + b * CTX + (dir ? CTX - 1 - s : s) : b * SEQ + (dir ? SEQ - 1 - (s - CTX) : (s - CTX)); }
DI float ex2(float x) { return __builtin_amdgcn_exp2f(x); }
DI void unpack8(const v4u w, float (&o)[8]) { o[0] = bflo(w.x); o[1] = bfhi(w.x); o[2] = bflo(w.y); o[3] = bfhi(w.y); o[4] = bflo(w.z); o[5] = bfhi(w.z); o[6] = bflo(w.w); o[7] = bfhi(w.w); }
DI v4u pack8(const float (&o)[8]) { v4u w; w.x = pk2(o[0], o[1]); w.y = pk2(o[2], o[3]); w.z = pk2(o[4], o[5]); w.w = pk2(o[6], o[7]); return w; }
DI void scan_phase(const Frame& F0, const Args& A, int l, bool dostore) {
    const Frame F = fresh(F0);
    (void)A;
    GAS bf16* P = (GAS bf16*)(F.ws + WS_P);
    LAS unsigned char* L = F.lds;
    const int tid = F.tid, lane = F.lane, w = F.wave, r = lane & 15, q4 = lane >> 4;
    const float L2E = 1.4426950408889634f;
    for (int ch = blockIdx.x; ch < 256; ch += F.G) {
        const int b = ch >> 3, h = (ch >> 1) & 3, dir = ch & 1;
        const int colq = C_Q + h * DK, colf = C_FF + dir * DH + h * DK, colv = C_V + h * DK;
        __syncthreads();
        for (int i = tid; i < (SC_DEC - SC_AL) / 16; i += NTHR) *(LAS v4u*)(L + SC_AL + 16 * i) = (v4u){0u, 0u, 0u, 0u};
        f32x4 accS[8];
#pragma unroll
        for (int t = 0; t < 8; ++t) accS[t] = (f32x4){0.f, 0.f, 0.f, 0.f};
        v4u qreg[2], lfreg[2]; unsigned vreg[8];
#pragma unroll
        for (int pi = 0; pi < 2; ++pi) { const int i = (tid >> 4) + 32 * pi, k0 = 8 * (tid & 15); const GAS bf16* rp = P + (size_t)scan_row(b, dir, i) * INC + k0;
            qreg[pi] = *(const GAS v4u*)(rp + colq); lfreg[pi] = *(const GAS v4u*)(rp + colf); }
#pragma unroll
        for (int e = 0; e < 8; ++e) vreg[e] = *(const GAS unsigned*)(P + (size_t)scan_row(b, dir, 8 * w + e) * INC + colv + 2 * lane);
        __syncthreads();
#pragma unroll 1
        for (int c = 0; c < (CTX + SEQ) / 64; ++c) {
            float qf[2][8], kk[2][8];
#pragma unroll
            for (int pi = 0; pi < 2; ++pi) { const int i = (tid >> 4) + 32 * pi, k0 = 8 * (tid & 15);
                float lf[8]; unpack8(lfreg[pi], lf); unpack8(qreg[pi], qf[pi]);
#pragma unroll
                for (int e = 0; e < 8; ++e) { lf[e] *= L2E; kk[pi][e] = 1.0f - ex2(lf[e]); }
                *(LAS f32x4*)(L + SC_CUM + (i * 128 + k0) * 4) = (f32x4){lf[0], lf[1], lf[2], lf[3]};
                *(LAS f32x4*)(L + SC_CUM + (i * 128 + k0) * 4 + 16) = (f32x4){lf[4], lf[5], lf[6], lf[7]}; }
            { v4u lo, hi;
              lo.x = (vreg[0] & 0xffffu) | (vreg[1] << 16); lo.y = (vreg[2] & 0xffffu) | (vreg[3] << 16); lo.z = (vreg[4] & 0xffffu) | (vreg[5] << 16); lo.w = (vreg[6] & 0xffffu) | (vreg[7] << 16);
              hi.x = (vreg[0] >> 16) | (vreg[1] & 0xffff0000u); hi.y = (vreg[2] >> 16) | (vreg[3] & 0xffff0000u); hi.z = (vreg[4] >> 16) | (vreg[5] & 0xffff0000u); hi.w = (vreg[6] >> 16) | (vreg[7] & 0xffff0000u);
              *(LAS v4u*)(L + SC_VT + (2 * lane) * PV + 16 * w) = lo; *(LAS v4u*)(L + SC_VT + (2 * lane + 1) * PV + 16 * w) = hi; }
            __syncthreads();
            { const int k = tid & 127, qd = tid >> 7; float run = 0.f;
#pragma unroll
              for (int s2 = 0; s2 < 16; ++s2) { LAS float* cp = (LAS float*)(L + SC_CUM) + (16 * qd + s2) * 128 + k; run += *cp; *cp = run; }
              ((LAS float*)(L + SC_TOT))[qd * 128 + k] = run; }
            __syncthreads();
            { const int k = tid & 127, I = tid >> 7; const LAS float* tp = (const LAS float*)(L + SC_TOT) + k; const LAS float* cm = (const LAS float*)(L + SC_CUM) + 7 * 128 + k;
              const float t0 = tp[0], t1 = tp[128], t2 = tp[256], t3 = tp[384];
              const float p1 = t0, p2 = t0 + t1, p3 = p2 + t2, tt = p3 + t3;
              const float R0 = cm[0], R1 = cm[16 * 128] + p1, R2 = cm[32 * 128] + p2, R3 = cm[48 * 128] + p3;
              const float RI = (I == 0) ? R0 : (I == 1) ? R1 : (I == 2) ? R2 : R3;
              LAS float* QF = (LAS float*)(L + SC_AL); LAS float* FT = QF + 512;
              QF[I * 128 + k] = ex2(RI);
              if (I == 0) { FT[0 * 128 + k] = ex2(R1 - R0); FT[1 * 128 + k] = ex2(R2 - R0); FT[3 * 128 + k] = ex2(R3 - R0); }
              if (I == 1) { FT[2 * 128 + k] = ex2(R2 - R1); FT[4 * 128 + k] = ex2(R3 - R1); }
              if (I == 2) { FT[5 * 128 + k] = ex2(R3 - R2); }
              if (I == 3) ((LAS float*)(L + SC_DEC))[k] = ex2(tt); }
            __syncthreads();
            v4u qdreg[2];
#pragma unroll
            for (int pi = 0; pi < 2; ++pi) { const int i = (tid >> 4) + 32 * pi, k0 = 8 * (tid & 15), I = i >> 4;
                float cl[8], cmid[8], qm[8], km[8], o8[8];
                { const f32x4 a = *(const LAS f32x4*)(L + SC_CUM + (i * 128 + k0) * 4), bq = *(const LAS f32x4*)(L + SC_CUM + (i * 128 + k0) * 4 + 16);
                  cl[0] = a.x; cl[1] = a.y; cl[2] = a.z; cl[3] = a.w; cl[4] = bq.x; cl[5] = bq.y; cl[6] = bq.z; cl[7] = bq.w; }
                { const f32x4 a = *(const LAS f32x4*)(L + SC_CUM + ((16 * I + 7) * 128 + k0) * 4), bq = *(const LAS f32x4*)(L + SC_CUM + ((16 * I + 7) * 128 + k0) * 4 + 16);
                  cmid[0] = a.x; cmid[1] = a.y; cmid[2] = a.z; cmid[3] = a.w; cmid[4] = bq.x; cmid[5] = bq.y; cmid[6] = bq.z; cmid[7] = bq.w; }
#pragma unroll
                for (int e = 0; e < 8; ++e) { const float dlt = cl[e] - cmid[e]; qm[e] = qf[pi][e] * ex2(fminf(dlt, 86.f)); km[e] = kk[pi][e] * ex2(fminf(-dlt, 86.f)); }
                *(LAS v4u*)(L + SC_QM + i * PQ + 2 * k0) = pack8(qm);
                *(LAS v4u*)(L + SC_KM + (8 * I * (I + 1) + i) * PQ + 2 * k0) = pack8(km);
                { const f32x4 a = *(const LAS f32x4*)(L + SC_AL + (I * 128 + k0) * 4), bq = *(const LAS f32x4*)(L + SC_AL + (I * 128 + k0) * 4 + 16);
                  o8[0] = qm[0] * a.x; o8[1] = qm[1] * a.y; o8[2] = qm[2] * a.z; o8[3] = qm[3] * a.w; o8[4] = qm[4] * bq.x; o8[5] = qm[5] * bq.y; o8[6] = qm[6] * bq.z; o8[7] = qm[7] * bq.w; }
                qdreg[pi] = pack8(o8);
#pragma unroll
                for (int Ip = 1; Ip < 4; ++Ip) if (Ip > I) { const int pr = Ip * (Ip - 1) / 2 + I;
                    const f32x4 a = *(const LAS f32x4*)(L + SC_AL + 2048 + (pr * 128 + k0) * 4), bq = *(const LAS f32x4*)(L + SC_AL + 2048 + (pr * 128 + k0) * 4 + 16);
                    o8[0] = km[0] * a.x; o8[1] = km[1] * a.y; o8[2] = km[2] * a.z; o8[3] = km[3] * a.w; o8[4] = km[4] * bq.x; o8[5] = km[5] * bq.y; o8[6] = km[6] * bq.z; o8[7] = km[7] * bq.w;
                    *(LAS v4u*)(L + SC_KM + (8 * Ip * (Ip + 1) + i) * PQ + 2 * k0) = pack8(o8); } }
            __syncthreads();
            if (c + 1 < (CTX + SEQ) / 64) {
#pragma unroll
                for (int pi = 0; pi < 2; ++pi) { const int i = (tid >> 4) + 32 * pi, k0 = 8 * (tid & 15); const GAS bf16* rp = P + (size_t)scan_row(b, dir, 64 * (c + 1) + i) * INC + k0;
                    qreg[pi] = *(const GAS v4u*)(rp + colq); lfreg[pi] = *(const GAS v4u*)(rp + colf); }
#pragma unroll
                for (int e = 0; e < 8; ++e) vreg[e] = *(const GAS unsigned*)(P + (size_t)scan_row(b, dir, 64 * (c + 1) + 8 * w + e) * INC + colv + 2 * lane);
            }
#pragma unroll 1
            for (int bl = w; bl < 10; bl += 8) {
                const int I = (bl >= 6) ? 3 : (bl >= 3) ? 2 : (bl >= 1) ? 1 : 0, J = bl - I * (I + 1) / 2;
                f32x4 acc = (f32x4){0.f, 0.f, 0.f, 0.f};
#pragma unroll
                for (int ks = 0; ks < 4; ++ks) { const bf16x8 a = *(const LAS bf16x8*)(L + SC_QM + (16 * I + r) * PQ + 64 * ks + 16 * q4);
                    const bf16x8 bb = *(const LAS bf16x8*)(L + SC_KM + (8 * I * (I + 1) + 16 * J + r) * PQ + 64 * ks + 16 * q4);
                    acc = __builtin_amdgcn_mfma_f32_16x16x32_bf16(a, bb, acc, 0, 0, 0); }
#pragma unroll
                for (int jj = 0; jj < 4; ++jj) { float x = acc[jj]; if (I == J && r > 4 * q4 + jj) x = 0.f;
                    *(LAS bf16*)(L + SC_AL + (16 * I + 4 * q4 + jj) * PV + 2 * (16 * J + r)) = (bf16)(pk2(x, 0.f) & 0xffffu); }
            }
            if (w == 2 || w == 3) { const int I = (w == 2) ? 0 : 2, J = I + 1;
#pragma unroll
                for (int jj = 0; jj < 4; ++jj) *(LAS bf16*)(L + SC_AL + (16 * I + 4 * q4 + jj) * PV + 2 * (16 * J + r)) = (bf16)0; }
            __syncthreads();
#pragma unroll
            for (int pi = 0; pi < 2; ++pi) { const int i = (tid >> 4) + 32 * pi, k0 = 8 * (tid & 15); *(LAS v4u*)(L + SC_QD + i * PQ + 2 * k0) = qdreg[pi]; }
            { const int k = tid & 127, qd = tid >> 7; const LAS float* tp = (const LAS float*)(L + SC_TOT) + k;
              const float t1 = tp[128], t2 = tp[256], t3 = tp[384];
              const float rest = (qd == 0) ? (t1 + t2) + t3 : (qd == 1) ? t2 + t3 : (qd == 2) ? t3 : 0.f;
              float cl[16], kd[16];
#pragma unroll
              for (int s2 = 0; s2 < 16; ++s2) cl[s2] = ((const LAS float*)(L + SC_CUM))[(16 * qd + s2) * 128 + k];
              float g = ex2(fminf(rest, 0.f));
#pragma unroll
              for (int s2 = 15; s2 >= 0; --s2) { const float f = ex2(cl[s2] - (s2 ? cl[s2 - 1] : 0.f)); kd[s2] = (1.0f - f) * g; g *= f; }
              v4u w0, w1; w0.x = pk2(kd[0], kd[1]); w0.y = pk2(kd[2], kd[3]); w0.z = pk2(kd[4], kd[5]); w0.w = pk2(kd[6], kd[7]);
              w1.x = pk2(kd[8], kd[9]); w1.y = pk2(kd[10], kd[11]); w1.z = pk2(kd[12], kd[13]); w1.w = pk2(kd[14], kd[15]);
              *(LAS v4u*)(L + SC_KDT + k * PV + 32 * qd) = w0; *(LAS v4u*)(L + SC_KDT + k * PV + 32 * qd + 16) = w1; }
            __syncthreads();
            { const int ip = w & 1, vp = w >> 1;
              f32x4 acc[2][2];
#pragma unroll
              for (int ii = 0; ii < 2; ++ii)
#pragma unroll
                  for (int tt = 0; tt < 2; ++tt) acc[ii][tt] = (f32x4){0.f, 0.f, 0.f, 0.f};
#pragma unroll
              for (int ks = 0; ks < 4; ++ks) { bf16x8 bq[2], a[2];
#pragma unroll
                  for (int ii = 0; ii < 2; ++ii) bq[ii] = *(const LAS bf16x8*)(L + SC_QD + (16 * (2 * ip + ii) + r) * PQ + 64 * ks + 16 * q4);
#pragma unroll
                  for (int tt = 0; tt < 2; ++tt) a[tt] = *(const LAS bf16x8*)(L + SC_ST + (16 * (2 * vp + tt) + r) * PQ + 64 * ks + 16 * q4);
#pragma unroll
                  for (int ii = 0; ii < 2; ++ii)
#pragma unroll
                      for (int tt = 0; tt < 2; ++tt) acc[ii][tt] = __builtin_amdgcn_mfma_f32_16x16x32_bf16(a[tt], bq[ii], acc[ii][tt], 0, 0, 0); }
#pragma unroll
              for (int js = 0; js < 2; ++js) if (js == 0 || ip == 1) { bf16x8 bA[2], a[2];
#pragma unroll
                  for (int ii = 0; ii < 2; ++ii) bA[ii] = *(const LAS bf16x8*)(L + SC_AL + (16 * (2 * ip + ii) + r) * PV + 64 * js + 16 * q4);
#pragma unroll
                  for (int tt = 0; tt < 2; ++tt) a[tt] = *(const LAS bf16x8*)(L + SC_VT + (16 * (2 * vp + tt) + r) * PV + 64 * js + 16 * q4);
#pragma unroll
                  for (int ii = 0; ii < 2; ++ii)
#pragma unroll
                      for (int tt = 0; tt < 2; ++tt) acc[ii][tt] = __builtin_amdgcn_mfma_f32_16x16x32_bf16(a[tt], bA[ii], acc[ii][tt], 0, 0, 0); }
              if (dostore && !(l == 1 && c < CTX / 64)) {
#pragma unroll
                  for (int ii = 0; ii < 2; ++ii) { GAS bf16* op = P + (size_t)scan_row(b, dir, 64 * c + 16 * (2 * ip + ii) + r) * INC + colf + 4 * q4;
#pragma unroll
                      for (int tt = 0; tt < 2; ++tt) { v2u o2; o2.x = pk2(acc[ii][tt][0], acc[ii][tt][1]); o2.y = pk2(acc[ii][tt][2], acc[ii][tt][3]); *(GAS v2u*)(op + 16 * (2 * vp + tt)) = o2; } }
              }
              const int kp = w >> 1, vh = w & 1;
#pragma unroll
              for (int kk = 0; kk < 2; ++kk) { const f32x4 dv = *(const LAS f32x4*)(L + SC_DEC + (16 * (2 * kp + kk) + 4 * q4) * 4);
#pragma unroll
                  for (int t4 = 0; t4 < 4; ++t4) accS[kk * 4 + t4] *= dv; }
#pragma unroll
              for (int js = 0; js < 2; ++js) { bf16x8 a[2], bv[4];
#pragma unroll
                  for (int kk = 0; kk < 2; ++kk) a[kk] = *(const LAS bf16x8*)(L + SC_KDT + (16 * (2 * kp + kk) + r) * PV + 64 * js + 16 * q4);
#pragma unroll
                  for (int t4 = 0; t4 < 4; ++t4) bv[t4] = *(const LAS bf16x8*)(L + SC_VT + (16 * (4 * vh + t4) + r) * PV + 64 * js + 16 * q4);
#pragma unroll
                  for (int kk = 0; kk < 2; ++kk)
#pragma unroll
                      for (int t4 = 0; t4 < 4; ++t4) accS[kk * 4 + t4] = __builtin_amdgcn_mfma_f32_16x16x32_bf16(a[kk], bv[t4], accS[kk * 4 + t4], 0, 0, 0); }
            }
            __syncthreads();
            { const int kp = w >> 1, vh = w & 1;
#pragma unroll
              for (int kk = 0; kk < 2; ++kk)
#pragma unroll
                  for (int t4 = 0; t4 < 4; ++t4) { const f32x4 sv = accS[kk * 4 + t4]; v2u s2; s2.x = pk2(sv[0], sv[1]); s2.y = pk2(sv[2], sv[3]);
                      *(LAS v2u*)(L + SC_ST + (16 * (4 * vh + t4) + r) * PQ + 2 * (16 * (2 * kp + kk) + 4 * q4)) = s2; } }
        }
    }
    __syncthreads();
}

DI void post_phase(const Frame& F0, const Args& A, int l, int part = 3, bool dry = false) {
    const Frame F = fresh(F0);
    GAS bf16* P = (GAS bf16*)(F.ws + WS_P);
    const int nrows = (l == 0) ? MALL : NX;
    if (part & 1) {
        const GAS float* gp = ((const GAS float*)A.in[I_GAIN]) + l * DH + 8 * F.lane;
        const f32x4 ga = *(const GAS f32x4*)gp, gb = *(const GAS f32x4*)(gp + 4);
        const float gn[8] = {ga.x, ga.y, ga.z, ga.w, gb.x, gb.y, gb.z, gb.w};
        v4u cur[6], nxt[6];
        if (F.gw < nrows) { const int r = F.gw; const bool two = (r + F.NGW) < nrows;
            const GAS bf16* q0 = P + (size_t)r * INC + 8 * F.lane; const GAS bf16* q1 = P + (size_t)(two ? r + F.NGW : r) * INC + 8 * F.lane;
            cur[0] = *(const GAS v4u*)(q0 + C_FF); cur[1] = *(const GAS v4u*)(q0 + C_FB); cur[2] = *(const GAS v4u*)(q0 + C_G);
            cur[3] = *(const GAS v4u*)(q1 + C_FF); cur[4] = *(const GAS v4u*)(q1 + C_FB); cur[5] = *(const GAS v4u*)(q1 + C_G); }
        for (int r = F.gw; r < nrows; r += 2 * F.NGW) {
            const bool two = (r + F.NGW) < nrows;
            GAS bf16* rp0 = P + (size_t)r * INC + 8 * F.lane; GAS bf16* rp1 = P + (size_t)(two ? r + F.NGW : r) * INC + 8 * F.lane;
            { const int rn = r + 2 * F.NGW;
              if (rn < nrows) { const bool twon = (rn + F.NGW) < nrows;
                  const GAS bf16* q0 = P + (size_t)rn * INC + 8 * F.lane; const GAS bf16* q1 = P + (size_t)(twon ? rn + F.NGW : rn) * INC + 8 * F.lane;
                  nxt[0] = *(const GAS v4u*)(q0 + C_FF); nxt[1] = *(const GAS v4u*)(q0 + C_FB); nxt[2] = *(const GAS v4u*)(q0 + C_G);
                  nxt[3] = *(const GAS v4u*)(q1 + C_FF); nxt[4] = *(const GAS v4u*)(q1 + C_FB); nxt[5] = *(const GAS v4u*)(q1 + C_G); } }
#pragma unroll
            for (int half = 0; half < 2; ++half) {
                if (half == 1 && !two) break;
                const v4u a = cur[3 * half], bq = cur[3 * half + 1], g = cur[3 * half + 2]; GAS bf16* rp = half ? rp1 : rp0;
                float o[8] = {bflo(a.x) + bflo(bq.x), bfhi(a.x) + bfhi(bq.x), bflo(a.y) + bflo(bq.y), bfhi(a.y) + bfhi(bq.y), bflo(a.z) + bflo(bq.z), bfhi(a.z) + bfhi(bq.z), bflo(a.w) + bflo(bq.w), bfhi(a.w) + bfhi(bq.w)};
                const float sg[8] = {bflo(g.x), bfhi(g.x), bflo(g.y), bfhi(g.y), bflo(g.z), bfhi(g.z), bflo(g.w), bfhi(g.w)};
                float ss = 0.f;
#pragma unroll
                for (int j = 0; j < 8; ++j) ss += o[j] * o[j];
                ss += __shfl_xor(ss, 1); ss += __shfl_xor(ss, 2); ss += __shfl_xor(ss, 4); ss += __shfl_xor(ss, 8);
                const float rr = 1.0f / sqrtf(ss * (1.0f / DK) + EPS);
#pragma unroll
                for (int j = 0; j < 8; ++j) o[j] = o[j] * rr * gn[j] * sg[j];
                v4u w; w.x = pk2(o[0], o[1]); w.y = pk2(o[2], o[3]); w.z = pk2(o[4], o[5]); w.w = pk2(o[6], o[7]);
                if (!dry || F.never) *(GAS v4u*)(rp + C_FF) = w;
            }
#pragma unroll
            for (int i = 0; i < 6; ++i) cur[i] = nxt[i];
        }
    }
    if (!(part & 2)) return;
    constexpr int PP = 520;
    LAS unsigned* U = (LAS unsigned*)F.lds;
    LAS unsigned* Vs = U + 32 * PP;
    v4u pre[8];
    { const int un = blockIdx.x;
      if (un < BATCH * 32) {
#pragma unroll
          for (int i = 0; i < 4; ++i) { const int t = F.tid + 512 * i; const GAS bf16* gp = P + (size_t)((un >> 5) * SEQ + t) * INC + C_U + (un & 31) * 16;
              pre[2 * i] = *(const GAS v4u*)gp; pre[2 * i + 1] = *(const GAS v4u*)(gp + 8); } } }
    REP(4) for (int un = blockIdx.x; un < BATCH * 32; un += F.G) {
        const int b = un >> 5, hx = un & 31, w = 2 << (hx >> 3), hw = w >> 1;
        __syncthreads();
#pragma unroll
        for (int i = 0; i < 4; ++i) { const int t = F.tid + 512 * i, gy = t >> 6, gx = t & 63;
            *(LAS v4u*)(U + gy * PP + gx * 8) = pre[2 * i]; *(LAS v4u*)(U + gy * PP + gx * 8 + 4) = pre[2 * i + 1]; }
        __syncthreads();
        { const int un2 = un + F.G;
          if (un2 < BATCH * 32) {
#pragma unroll
              for (int i = 0; i < 4; ++i) { const int t = F.tid + 512 * i; const GAS bf16* gp = P + (size_t)((un2 >> 5) * SEQ + t) * INC + C_U + (un2 & 31) * 16;
                  pre[2 * i] = *(const GAS v4u*)gp; pre[2 * i + 1] = *(const GAS v4u*)(gp + 8); } } }
        { float s0 = 0.f, s1 = 0.f;
          for (int y = 0; y < hw; ++y) { const unsigned u = U[y * PP + F.tid]; s0 += bflo(u); s1 += bfhi(u); }
#pragma unroll 4
          for (int gy = 0; gy < 32; ++gy) {
              Vs[gy * PP + F.tid] = pk2(s0, s1);
              if (gy + hw < 32) { const unsigned u = U[(gy + hw) * PP + F.tid]; s0 += bflo(u); s1 += bfhi(u); }
              if (gy - hw >= 0) { const unsigned u = U[(gy - hw) * PP + F.tid]; s0 -= bflo(u); s1 -= bfhi(u); }
          } }
        __syncthreads();
        { const int c4 = F.lane & 3, gy = (F.wave & 1) * 16 + (F.lane >> 2), x0 = (F.wave >> 1) * 16;
          const int cy = min(gy + hw, 32) - max(gy - hw, 0);
          const LAS unsigned* vr = Vs + gy * PP + c4 * 2; LAS unsigned* ur = U + gy * PP + c4 * 2;
          float s[4] = {0.f, 0.f, 0.f, 0.f};
          for (int x = max(x0 - hw, 0); x < min(x0 + hw, 64); ++x) { const v2u q = *(const LAS v2u*)(vr + x * 8); s[0] += bflo(q.x); s[1] += bfhi(q.x); s[2] += bflo(q.y); s[3] += bfhi(q.y); }
#pragma unroll 4
          for (int gx = x0; gx < x0 + 16; ++gx) {
              const int cx = min(gx + hw, 64) - max(gx - hw, 0);
              const float inv = __builtin_amdgcn_rcpf((float)(cy * cx));
              const v2u uc = *(const LAS v2u*)(ur + gx * 8);
              v2u o; o.x = pk2(s[0] * inv - bflo(uc.x), s[1] * inv - bfhi(uc.x)); o.y = pk2(s[2] * inv - bflo(uc.y), s[3] * inv - bfhi(uc.y));
              *(LAS v2u*)(ur + gx * 8) = o;
              if (gx + hw < 64) { const v2u q = *(const LAS v2u*)(vr + (gx + hw) * 8); s[0] += bflo(q.x); s[1] += bfhi(q.x); s[2] += bflo(q.y); s[3] += bfhi(q.y); }
              if (gx - hw >= 0) { const v2u q = *(const LAS v2u*)(vr + (gx - hw) * 8); s[0] -= bflo(q.x); s[1] -= bfhi(q.x); s[2] -= bflo(q.y); s[3] -= bfhi(q.y); }
          } }
        __syncthreads();
#pragma unroll
        for (int i = 0; i < 4; ++i) { const int t = F.tid + 512 * i, gy = t >> 6, gx = t & 63;
            const v4u q0 = *(const LAS v4u*)(U + gy * PP + gx * 8), q1 = *(const LAS v4u*)(U + gy * PP + gx * 8 + 4);
            GAS bf16* op = P + (size_t)(b * SEQ + t) * INC + C_Q + hx * 16;
            *(GAS v4u*)op = q0; *(GAS v4u*)(op + 8) = q1; }
    }
    __syncthreads();
    if (l == 0) { LAS unsigned char* Uc = F.lds;
        for (int un = blockIdx.x; un < BATCH * 32; un += F.G) {
            const int b = un >> 5, hx = un & 31, w = 2 << (hx >> 3), hw = w >> 1;
            __syncthreads();
            if (F.tid < CTX) { const GAS bf16* gp = P + (size_t)(NX + b * CTX + F.tid) * INC + C_U + hx * 16;
                const v4u q0 = *(const GAS v4u*)gp, q1 = *(const GAS v4u*)(gp + 8);
                *(LAS v4u*)(Uc + F.tid * 32) = q0; *(LAS v4u*)(Uc + F.tid * 32 + 16) = q1; }
            __syncthreads();
            if (F.tid < CTX) { const int t = F.tid, t0 = max(t - hw, 0), t1 = min(t - hw + w, CTX);
                float a[16];
#pragma unroll
                for (int j = 0; j < 16; ++j) a[j] = 0.f;
                for (int s2 = t0; s2 < t1; ++s2) { float v0[8], v1[8]; unpack8(*(const LAS v4u*)(Uc + s2 * 32), v0); unpack8(*(const LAS v4u*)(Uc + s2 * 32 + 16), v1);
#pragma unroll
                    for (int j = 0; j < 8; ++j) { a[j] += v0[j]; a[8 + j] += v1[j]; } }
                const float inv = 1.0f / (float)(t1 - t0);
                float u0[8], u1[8]; unpack8(*(const LAS v4u*)(Uc + t * 32), u0); unpack8(*(const LAS v4u*)(Uc + t * 32 + 16), u1);
                float lo[8], hi[8];
#pragma unroll
                for (int j = 0; j < 8; ++j) { lo[j] = a[j] * inv - u0[j]; hi[j] = a[8 + j] * inv - u1[j]; }
                GAS bf16* op = P + (size_t)(NX + b * CTX + t) * INC + C_Q + hx * 16;
                *(GAS v4u*)op = pack8(lo); *(GAS v4u*)(op + 8) = pack8(hi); }
        }
    }
    __syncthreads();
}

DI void slice_offsets(const Frame& F, int s, int (&toff)[9]) {
    const GAS unsigned* gc = (const GAS unsigned*)(F.ws + WS_CTL) + CW_GCOUNT;
    int acc = 0;
#pragma unroll
    for (int e = 0; e < 8; ++e) { toff[e] = acc; const unsigned c = __builtin_amdgcn_readfirstlane(__hip_atomic_load(gc + 64 * (s * 8 + e), __ATOMIC_RELAXED, __HIP_MEMORY_SCOPE_AGENT)); acc += (int)((c + 255u) >> 8); }
    toff[8] = acc < SLICE_ROWS / 256 ? acc : SLICE_ROWS / 256;
}
DI void gather_phase(const Frame& F0, const Args& A, int s) {
    const Frame F = fresh(F0);
    (void)A;
    int toff[9]; slice_offsets(F, s, toff);
    const GAS unsigned char* H8 = F.ws + WS_H8; GAS unsigned char* AS = F.ws + WS_AS; GAS float* RG = (GAS float*)(F.ws + WS_RGATE);
    const int rend = slice_start(s + 1);
    int r = slice_start(s) + F.gw;
    i32x2 t = {0, 0}, k = {0, 0}; v4u a = {0u, 0u, 0u, 0u};
    if (r < rend) { t = ((const GAS i32x2*)(F.ws + WS_RTOP))[r]; k = ((const GAS i32x2*)(F.ws + WS_RRANK))[r]; a = *(const GAS v4u*)(H8 + (size_t)r * D + 16 * F.lane); }
    for (; r < rend; r += F.NGW) {
        const int rn = r + F.NGW;
        i32x2 tn = t, kn = k; v4u an = a;
        if (rn < rend) { tn = ((const GAS i32x2*)(F.ws + WS_RTOP))[rn]; kn = ((const GAS i32x2*)(F.ws + WS_RRANK))[rn]; an = *(const GAS v4u*)(H8 + (size_t)rn * D + 16 * F.lane); }
        int p0 = k.x, p1 = k.y;
#pragma unroll
        for (int e = 0; e < 8; ++e) { if (t.x == e) p0 += toff[e] * 256; if (t.y == e) p1 += toff[e] * 256; }
        p0 = min(max(p0, 0), SLICE_ROWS - 1); p1 = min(max(p1, 0), SLICE_ROWS - 1);
        *(GAS v4u*)(AS + (size_t)p0 * D + 16 * F.lane) = a;
        *(GAS v4u*)(AS + (size_t)p1 * D + 16 * F.lane) = a;
        if (F.lane == 0) ((GAS i32x2*)(F.ws + WS_RPOS))[r] = (i32x2){p0, p1};
        t = tn; k = kn; a = an;
    }
    (void)RG;
}
DI void combine_phase(const Frame& F0, const Args& A, int s, bool dry = false) {
    const Frame F = fresh(F0);
    const GAS bf16* YS = (const GAS bf16*)(F.ws + WS_YS);
    RowVecs V; f32x4 hv[4];
    constexpr int CB = 4;
    for (int r0 = slice_start(s) + F.gw * CB; r0 < slice_start(s + 1); r0 += F.NGW * CB) {
        const int b = r0 >> 11;
        load_rowvecs(V, modp(F, 1, b, 5), ((const GAS float*)A.in[I_FFNPOST]) + D, nullptr, nullptr, nullptr, F.lane);
        i32x2 pp[CB]; f32x2 pr[CB];
#pragma unroll
        for (int k = 0; k < CB; ++k) { pp[k] = ((const GAS i32x2*)(F.ws + WS_RPOS))[r0 + k]; pr[k] = ((const GAS f32x2*)(F.ws + WS_RPROB))[r0 + k]; }
        v2u wa[4], wb[4], wx[4], na[4], nb[4], nx[4];
#pragma unroll
        for (int j = 0; j < 4; ++j) { wa[j] = *(const GAS v2u*)(YS + (size_t)pp[0].x * D + 4 * F.lane + 256 * j); wb[j] = *(const GAS v2u*)(YS + (size_t)pp[0].y * D + 4 * F.lane + 256 * j); wx[j] = *(const GAS v2u*)(xb_row(F.out, r0) + 4 * F.lane + 256 * j); }
#pragma unroll
        for (int k = 0; k < CB; ++k) { const int r = r0 + k;
            if (k < CB - 1) {
#pragma unroll
                for (int j = 0; j < 4; ++j) { na[j] = *(const GAS v2u*)(YS + (size_t)pp[k + 1 < CB ? k + 1 : CB - 1].x * D + 4 * F.lane + 256 * j); nb[j] = *(const GAS v2u*)(YS + (size_t)pp[k + 1 < CB ? k + 1 : CB - 1].y * D + 4 * F.lane + 256 * j); nx[j] = *(const GAS v2u*)(xb_row(F.out, r + 1) + 4 * F.lane + 256 * j); }
            }
            VM_WAIT();
            GAS float* xr = F.out + (size_t)r * D;
            f32x4 yv[4]; float ss = 0.f;
#pragma unroll
            for (int j = 0; j < 4; ++j) { const v2u w0 = wa[j], w1 = wb[j];
                yv[j] = (f32x4){bflo(w0.x) * pr[k].x + bflo(w1.x) * pr[k].y, bfhi(w0.x) * pr[k].x + bfhi(w1.x) * pr[k].y, bflo(w0.y) * pr[k].x + bflo(w1.y) * pr[k].y, bfhi(w0.y) * pr[k].x + bfhi(w1.y) * pr[k].y};
                ss += (yv[j].x * yv[j].x + yv[j].y * yv[j].y) + (yv[j].z * yv[j].z + yv[j].w * yv[j].w); }
            const float rr = 1.0f / sqrtf(wave_sum(ss) * (1.0f / D) + EPS);
#pragma unroll
            for (int j = 0; j < 4; ++j) { const v2u w = wx[j]; const f32x4 xv = (f32x4){bflo(w.x), bfhi(w.x), bflo(w.y), bfhi(w.y)};
                const f32x4 x = xv + V.a1[j] * (yv[j] * rr); if (!dry || F.never) *(GAS f32x4*)(xr + 4 * F.lane + 256 * j) = x; }
#pragma unroll
            for (int j = 0; j < 4; ++j) { wa[j] = na[j]; wb[j] = nb[j]; wx[j] = nx[j]; }
        }
    }
    (void)hv;
}

__global__ void __launch_bounds__(NTHR, 2) mk_fwd(Args args) {
    extern __shared__ __attribute__((aligned(16))) unsigned char lds_raw[];
    Frame F;
    F.lds = (LAS unsigned char*)lds_raw;
    F.tid = threadIdx.x; F.lane = F.tid & 63; F.wave = __builtin_amdgcn_readfirstlane(F.tid >> 6);
    F.G = gridDim.x; F.gw = blockIdx.x * NWAVES + F.wave; F.NGW = F.G * NWAVES; F.never = args.ph_lo < 0;
    F.out = (GAS float*)args.out; F.ws = (GAS unsigned char*)args.ws;
    volatile LAS unsigned* MISC = (volatile LAS unsigned*)(F.lds + MISC_OFF);
    if (F.tid < 16) MISC[F.tid] = 0u;
    __syncthreads();
    XcdBarrier bar; bar.bar = (unsigned*)(F.ws + WS_CTL) + CW_BAR; bar.x = 0; bar.st = nullptr;
    if (!MK_PER_PHASE) bar = xcd_barrier_post((unsigned*)(F.ws + WS_CTL) + CW_BAR, MISC + 8);
    const int lo = args.ph_lo, hi = args.ph_hi;
    int seq = 0;
#ifndef PHASE_MASK
#define PHASE_MASK 0xffff
#endif
#define EN(k) (((PHASE_MASK) >> (k)) & 1)
#define PH_ON() (lo <= seq && seq < hi)
#define PH_END() do { if (lo <= seq && seq + 1 < hi) { if (!MK_PER_PHASE) { xcd_barrier(bar); if (((DUP_MASK) >> 16) & 1) xcd_barrier(bar); } } ++seq; } while (0)
    LAS unsigned char* ring = F.lds;
#define SITE_PTRS() GAS unsigned char* ws = F.ws; asm volatile("" : "+s"(ws)); GAS bf16* P = (GAS bf16*)(ws + WS_P); GAS bf16* H = (GAS bf16*)(ws + WS_H); (void)P; (void)H

    if (PH_ON() && EN(0)) REP(0) p0_prologue(F, args);
    PH_END();
    if (PH_ON() && EN(1)) { REP(1) rows_phase<0>(F, args, 0); __syncthreads(); win_to_i8(F, args); }
    PH_END();
    for (int l = 0; l < 2; ++l) {
        const int nM = (l == 0) ? MALL / 256 : NX / 256;
        if (PH_ON() && EN(2)) { SITE_PTRS();
            pg8::Gemm g{H, (const GAS bf16*)(ws + WS_WIN + (size_t)l * INC * D), D, D / 2, D / 2};
            pg8::InSched S; S.G = F.G; S.c = (int)blockIdx.x; S.last = (l == 1);
            LAS float* cml = (LAS float*)(F.lds + 131072);
            { int t2 = F.tid; asm volatile("" : "+v"(t2)); const GAS float* cg = (const GAS float*)(ws + WS_CTL) + CW_CMAX_IN + l * INC; for (int i = t2; i < INC; i += NTHR) cml[i] = cg[i]; }
            __syncthreads();
            if (l == 0) { pg8::EpiIn<true> E{P, (const GAS float*)(ws + WS_LB), (const GAS float*)(ws + WS_RS), cml};
                REP(2) pg8::gemm_phase<pg8::EpiIn<true>, pg8::InSched, false, 127, true>(ring, g, S, E); }
            else { pg8::EpiIn<false> E{P, (const GAS float*)(ws + WS_LB) + 2 * DH, (const GAS float*)(ws + WS_RS), cml};
                REP(2) pg8::gemm_phase<pg8::EpiIn<false>, pg8::InSched, false, 127, true>(ring, g, S, E); }
            if (l == 0) moe_weight_convert(F, args, MOE_C1, MOE_C1 + MOE_C2, F.G / 2);
        }
        PH_END();
        if (PH_ON() && EN(3)) { if ((DUP_MASK >> 3) & 1) scan_phase(F, args, l, false); scan_phase(F, args, l, true); }
        PH_END();
        if (PH_ON() && EN(4)) { if ((DUP_MASK >> 17) & 1) post_phase(F, args, l, 1, true); post_phase(F, args, l); }
        PH_END();
        if (PH_ON() && EN(6)) { SITE_PTRS();
            { pg8::Gemm g{P + C_FF, (const GAS bf16*)(ws + WS_WR) + (size_t)l * D * DH, INC, DH, DH};
              pg8::StaticSched S; S.init(nM, D / 256, F.G, (int)blockIdx.x, 0);
              pg8::EpiRow<1> E{P + C_GA, INC, nullptr, 0};
              REP(6) pg8::gemm_phase(ring, g, S, E); }
            { pg8::Gemm g{P + C_Q, (const GAS bf16*)(ws + WS_WP) + (size_t)l * D * DH, INC, DH, DH};
              pg8::StaticSched S; S.init(nM, D / 256, F.G, (int)blockIdx.x, 0);
              pg8::EpiRow<2> E{P + C_GA, INC, nullptr, C_GB - C_GA};
              REP(6) pg8::gemm_phase(ring, g, S, E); }
        }
        PH_END();
        if (PH_ON() && EN(7)) { SITE_PTRS();
            pg8::Gemm g{P + C_GA, (const GAS bf16*)(ws + WS_WO) + (size_t)l * D * D, INC, D, D};
            pg8::StaticSched S; S.init(nM, D / 256, F.G, (int)blockIdx.x, 0);
            pg8::EpiRow<0> E{H, D, nullptr, 0};
            REP(7) pg8::gemm_phase(ring, g, S, E);
        }
        PH_END();
        if (PH_ON() && EN(8)) { if ((DUP_MASK >> 8) & 1) rows_phase<1>(F, args, l, true); rows_phase<1>(F, args, l); if (l == 1) { __syncthreads(); moe_weight_convert(F, args, MOE_C1 + MOE_C2, MOE_CONV_ITEMS, 0); } }
        PH_END();
        if (l == 0) {
            if (PH_ON() && EN(9)) { SITE_PTRS();
                pg8::Gemm g{H, (const GAS bf16*)(ws + WS_WGU), D, D / 2, D / 2};
                pg8::StaticSched S; S.init(MALL / 256, 2 * DFF / 256, F.G, (int)blockIdx.x, 0);
                LAS float* cmgl = (LAS float*)(F.lds + 131072); LAS float* cmul = cmgl + DFF;
                { int t2 = F.tid; asm volatile("" : "+v"(t2)); const GAS float* cg = (const GAS float*)(ws + WS_CTL) + CW_CMAX_FG; const GAS float* cu = (const GAS float*)(ws + WS_CTL) + CW_CMAX_FU;
                  for (int i = t2; i < DFF; i += NTHR) { cmgl[i] = cg[i]; cmul[i] = cu[i]; } }
                __syncthreads();
                pg8::EpiSwiGLU<true> E{(GAS bf16*)(ws + WS_HH0), DFF, nullptr, (const GAS float*)(ws + WS_RS), cmgl, cmul};
                REP(9) pg8::gemm_phase<pg8::EpiSwiGLU<true>, pg8::StaticSched, false, 127, true>(ring, g, S, E);
            }
            PH_END();
            if (PH_ON() && EN(10)) { SITE_PTRS();
                pg8::Gemm g{(const GAS bf16*)(ws + WS_HH0), (const GAS bf16*)(ws + WS_WD), DFF / 2, DFF / 2, DFF / 2};
                pg8::StaticSched S; S.init(MALL / 256, D / 256, F.G, (int)blockIdx.x, 0);
                pg8::EpiRow<0> E{H, D, nullptr, 0};
                REP(10) pg8::gemm_phase<pg8::EpiRow<0>, pg8::StaticSched, true, 121>(ring, g, S, E);
                moe_weight_convert(F, args, 0, MOE_C1, F.G / 2);
            }
            PH_END();
            if (PH_ON() && EN(11)) { if ((DUP_MASK >> 11) & 1) rows_phase<2>(F, args, 0, true); rows_phase<2>(F, args, 0); }
            PH_END();
        } else {
            if (PH_ON() && EN(12)) gather_phase(F, args, 0);
            PH_END();
            for (int s = 0; s < NSLICE; ++s) {
                if (PH_ON() && EN(13)) { SITE_PTRS();
                    pg8::MoeSched S; S.G = F.G; S.c = (int)blockIdx.x; S.nN = 2 * DEX / 256; S.nrow_e = 2 * DEX; slice_offsets(F, s, S.toff); S.nM = S.toff[8];
                    pg8::Gemm g{(const GAS bf16*)(ws + WS_AS), (const GAS bf16*)(ws + WS_MGU), D / 2, D / 2, D / 2};
                    pg8::EpiSwiGLU8 E{ws + WS_HHS, DEX, nullptr};
                    REP(13) pg8::gemm_phase<pg8::EpiSwiGLU8, pg8::MoeSched, true, 122>(ring, g, S, E);
                    if (s > 0) { if ((DUP_MASK >> 15) & 1) combine_phase(F, args, s - 1, true); combine_phase(F, args, s - 1); }
                }
                PH_END();
                if (PH_ON() && EN(14)) { SITE_PTRS();
                    pg8::MoeSched S; S.G = F.G; S.c = (int)blockIdx.x; S.nN = D / 256; S.nrow_e = D; slice_offsets(F, s, S.toff); S.nM = S.toff[8];
                    pg8::Gemm g{(const GAS bf16*)(ws + WS_HHS), (const GAS bf16*)(ws + WS_MD), DEX / 2, DEX / 2, DEX / 2};
                    pg8::EpiRow<0> E{(GAS bf16*)(ws + WS_YS), D, nullptr, 0};
                    REP(14) pg8::gemm_phase<pg8::EpiRow<0>, pg8::MoeSched, true, 121>(ring, g, S, E);
                    if (s + 1 < NSLICE) gather_phase(F, args, s + 1);
                }
                PH_END();
            }
            if (PH_ON() && EN(15)) { if ((DUP_MASK >> 15) & 1) combine_phase(F, args, NSLICE - 1, true); combine_phase(F, args, NSLICE - 1); }
            PH_END();
        }
    }
}
constexpr int N_PHASES = 2 + 6 + 3 + 6 + 1 + 2 * NSLICE + 1;

extern "C" void kernel_launch(void* const* d_in, const int* in_sizes, int n_in, void* d_out, int out_size, void* d_ws, size_t ws_size, hipStream_t stream) {
    static int grid = 0;
    if (grid == 0) {
        if (n_in != 25 || out_size != NX * D || ws_size < WS_END) { fprintf(stderr, "kernel_launch: unexpected problem (n_in %d, out %d, ws %zu < %zu)\n", n_in, out_size, ws_size, (size_t)WS_END); grid = -1; return; }
        int dev = 0, cus = 0, per_cu = 0;
        if (hipGetDevice(&dev) != hipSuccess || hipDeviceGetAttribute(&cus, hipDeviceAttributeMultiprocessorCount, dev) != hipSuccess) { grid = -1; return; }
        if (hipFuncSetAttribute((const void*)mk_fwd, hipFuncAttributeMaxDynamicSharedMemorySize, LDS_BYTES) != hipSuccess) { fprintf(stderr, "kernel_launch: hipFuncSetAttribute failed\n"); grid = -1; return; }
        if (hipOccupancyMaxActiveBlocksPerMultiprocessor(&per_cu, (const void*)mk_fwd, NTHR, LDS_BYTES) != hipSuccess || per_cu < 1) { fprintf(stderr, "kernel_launch: occupancy query says %d\n", per_cu); }
        (void)hipGetLastError();
        grid = cus;
    }
    if (grid < 0) return;
    (void)in_sizes;
    if (hipMemsetAsync((char*)d_ws + WS_CTL, 0, CTL_BYTES, stream) != hipSuccess) return;
    Args a{};
    for (int i = 0; i < 25; ++i) a.in[i] = (const float*)d_in[i];
    a.out = (float*)d_out; a.ws = (unsigned char*)d_ws;
#if MK_PER_PHASE
    for (int p = 0; p < N_PHASES; ++p) { a.ph_lo = p; a.ph_hi = p + 1; hipLaunchKernelGGL(mk_fwd, dim3(grid), dim3(NTHR), LDS_BYTES, stream, a); }
#else
    a.ph_lo = 0; a.ph_hi = N_PHASES;
    hipLaunchKernelGGL(mk_fwd, dim3(grid), dim3(NTHR), LDS_BYTES, stream, a);
#endif
}
```
